# Optimizing an MI355X kernel written in HIP

```python
import math
import jax, jax.numpy as jnp
from jax import lax
import numpy as np

D_MODEL = 1024
BATCH = 1
SEQ = 16384
DEPTH = 2

CTX_LEN = 256
GRID_W = 64
N_MIXERS = 2
N_HYENA_LAYERS = (DEPTH + 1) // 2
N_ATTN_LAYERS = DEPTH // 2
N_MOD = 6
NORM_EPS = 1e-6
HY_ORDER = 2
HY_SHORT = 3
HY_EMB_BANDS = 16
HY_EMB_DIM = 1 + 2 * HY_EMB_BANDS
HY_FILTER_HIDDEN = 64
HY_DECAY_FAST = 0.3
HY_DECAY_SLOW = 1.5
HY_DECAY_TARGET = 1e-2
HY_FILTER_EPS = 1e-6
DA_HEADS = 8
DA_HEAD_DIM = D_MODEL // DA_HEADS // 2
DA_V_DIM = 2 * DA_HEAD_DIM
ROPE_AXIS_DIM = DA_HEAD_DIM // 2
ROPE_THETA = 10000.0
Q_BLOCK = 128
SUBLN_EPS = 1e-5
N_EXPERTS = 16
EC_CAPACITY = 2
D_EXPERT = 1024

kernel_name = "hyena_diffattn_ec_moe_diffusion_trunk"


def rms_norm(x, g, eps=NORM_EPS):
    xf = x.astype(jnp.float32)
    y = xf * lax.rsqrt(jnp.mean(xf * xf, axis=-1, keepdims=True) + eps) * g.astype(jnp.float32)
    return y.astype(x.dtype)


def adaln(cond, w, b):
    return (jax.nn.silu(cond) @ w + b).reshape(cond.shape[0], N_MOD, 1, D_MODEL)


def modulate(h, shift, scale):
    return h * (1.0 + scale) + shift


def short_conv(u, w, b):
    L = u.shape[1]
    pad = HY_SHORT // 2
    up = jnp.pad(u, ((0, 0), (pad, pad), (0, 0)))
    out = b
    for k in range(HY_SHORT):
        out = out + up[:, k:k + L] * w[k]
    return out


def hyena_filter_spectrum(L, w1, b1, w2, b2, w3, b3, w4, freq):
    f32 = jnp.float32
    t = jnp.linspace(0.0, 1.0, L, dtype=f32)[:, None]
    w = 2.0 * math.pi * jnp.arange(L, dtype=f32)[:, None] / L
    bands = jnp.linspace(1e-4, HY_EMB_BANDS - 1, HY_EMB_BANDS, dtype=f32)[None]
    z = jnp.concatenate([t, jnp.cos(w * bands), -jnp.sin(w * bands)], axis=-1)
    fr = freq.astype(f32)
    hid = jnp.sin(fr * (z @ w1.astype(f32) + b1.astype(f32)))
    hid = jnp.sin(fr * (hid @ w2.astype(f32) + b2.astype(f32)))
    hid = jnp.sin(fr * (hid @ w3.astype(f32) + b3.astype(f32)))
    h = (hid @ w4.astype(f32)).reshape(L, HY_ORDER, 2, D_MODEL)
    max_decay = math.log(HY_DECAY_TARGET) / HY_DECAY_FAST
    min_decay = math.log(HY_DECAY_TARGET) / HY_DECAY_SLOW
    deltas = jnp.linspace(min_decay, max_decay, D_MODEL, dtype=f32)
    decay = jnp.exp(-t * jnp.abs(deltas))
    h = h * decay[:, None, None, :]
    k = jnp.concatenate([h[:, :, 0], jnp.zeros((1, HY_ORDER, D_MODEL), f32), h[:0:-1, :, 1]], axis=0)
    k = k / (jnp.sum(jnp.abs(k), axis=0, keepdims=True) + HY_FILTER_EPS)
    return jnp.fft.rfft(k, axis=0)


def long_conv(z, K):
    L = z.shape[1]
    Z = jnp.fft.rfft(z.astype(jnp.float32), n=2 * L, axis=1)
    y = jnp.fft.irfft(Z * K[None], n=2 * L, axis=1)[:, :L]
    return y.astype(z.dtype)


def hyena_mix(h, w_in, b_in, conv_w, conv_b, f_w1, f_b1, f_w2, f_b2, f_w3, f_b3, f_w4, f_freq,
              skip, w_out, b_out):
    L = h.shape[1]
    u = short_conv(h @ w_in + b_in, conv_w, conv_b)
    v, x1, x2 = jnp.split(u, 3, axis=-1)
    K = hyena_filter_spectrum(L, f_w1, f_b1, f_w2, f_b2, f_w3, f_b3, f_w4, f_freq)
    z = v
    for o, gate in enumerate((x1, x2)):
        z = gate * (long_conv(z, K[:, o]) + skip[o] * z)
    return z @ w_out + b_out


def axial_rope(x, row, col):
    f32 = jnp.float32
    inv = ROPE_THETA ** (-jnp.arange(0, ROPE_AXIS_DIM, 2, dtype=f32) / ROPE_AXIS_DIM)

    def rot(xa, pos):
        ang = pos.astype(f32)[:, None] * inv[None]
        cos = jnp.cos(ang)[None, :, None, :]
        sin = jnp.sin(ang)[None, :, None, :]
        a1, a2 = jnp.split(xa.astype(f32), 2, axis=-1)
        return jnp.concatenate([a1 * cos - a2 * sin, a2 * cos + a1 * sin], axis=-1)

    xr, xc = jnp.split(x, 2, axis=-1)
    return jnp.concatenate([rot(xr, row), rot(xc, col)], axis=-1).astype(x.dtype)


def diff_core(q, k, v, lam):
    B, Q = q.shape[0], q.shape[1]
    s = jnp.einsum("bqcd,bkcd->bcqk", q, k).astype(jnp.float32) * (DA_HEAD_DIM ** -0.5)
    p = jax.nn.softmax(s, axis=-1).reshape(B, DA_HEADS, 2, Q, k.shape[1])
    a = p[:, :, 0] - lam * p[:, :, 1]
    return jnp.einsum("bhqk,bkhe->bqhe", a.astype(v.dtype), v)


def diff_attention(hx, hc, row, col, lam_init, need_ctx_out, w_qkv, q_norm, k_norm,
                   lam_q1, lam_k1, lam_q2, lam_k2, subln, w_out):
    B, N, _ = hx.shape
    f32 = jnp.float32
    lam = (jnp.exp(jnp.sum(lam_q1.astype(f32) * lam_k1.astype(f32)))
           - jnp.exp(jnp.sum(lam_q2.astype(f32) * lam_k2.astype(f32))) + lam_init)

    def heads_q(q):
        return rms_norm(q.reshape(q.shape[0], q.shape[1], 2 * DA_HEADS, DA_HEAD_DIM), q_norm)

    def heads_k(k):
        return rms_norm(k.reshape(k.shape[0], k.shape[1], 2 * DA_HEADS, DA_HEAD_DIM), k_norm)

    def heads_v(v):
        return v.reshape(v.shape[0], v.shape[1], DA_HEADS, DA_V_DIM)

    def finish(o):
        o = rms_norm(o, subln, SUBLN_EPS) * (1.0 - lam_init)
        return o.reshape(o.shape[0], o.shape[1], D_MODEL) @ w_out

    qx, kx, vx = jnp.split(hx @ w_qkv, 3, axis=-1)
    qx = axial_rope(heads_q(qx), row, col)
    kx = axial_rope(heads_k(kx), row, col)
    vx = heads_v(vx)
    kc, vc = jnp.split(hc @ w_qkv[:, D_MODEL:], 2, axis=-1)
    kc = heads_k(kc)
    vc = heads_v(vc)
    k_all = jnp.concatenate([kc, kx], axis=1)
    v_all = jnp.concatenate([vc, vx], axis=1)
    n_blk = N // Q_BLOCK
    qb = qx.reshape(B, n_blk, Q_BLOCK, 2 * DA_HEADS, DA_HEAD_DIM).swapaxes(0, 1)
    ob = lax.map(lambda qq: diff_core(qq, k_all, v_all, lam), qb)
    yx = finish(ob.swapaxes(0, 1).reshape(B, N, DA_HEADS, DA_V_DIM))
    yc = None
    if need_ctx_out:
        qc = heads_q(hc @ w_qkv[:, :D_MODEL])
        yc = finish(diff_core(qc, kc, vc, lam))
    return yx, yc


def ec_moe(h, w_router, w_gate, w_up, w_down):
    B, N, _ = h.shape
    cap = EC_CAPACITY * N // N_EXPERTS
    aff = jax.nn.softmax((h @ w_router).astype(jnp.float32), axis=-1)
    g, idx = lax.top_k(aff.swapaxes(1, 2), cap)
    bidx = jnp.arange(B)[:, None]
    xe = h[bidx, idx.reshape(B, -1)].reshape(B, N_EXPERTS, cap, D_MODEL)
    a = jax.nn.silu(jnp.einsum("becd,edf->becf", xe, w_gate)) * jnp.einsum("becd,edf->becf", xe, w_up)
    y = jnp.einsum("becf,efd->becd", a, w_down) * g[..., None].astype(h.dtype)
    return jnp.zeros_like(h).at[jnp.arange(B)[:, None, None], idx].add(y)


def setup_inputs(seed: int = 0) -> dict:
    key = jax.random.key(seed)
    ks = jax.random.split(key, 40)
    D, F, E = D_MODEL, D_EXPERT, N_EXPERTS
    NHy, NA = N_HYENA_LAYERS, N_ATTN_LAYERS

    def nrm(i, shape, scale):
        return jax.random.normal(ks[i], shape, jnp.float32) * scale

    return {
        "x": nrm(0, (BATCH, SEQ, D), 1.0),
        "c": nrm(1, (BATCH, D), 1.0),
        "ctx": nrm(2, (BATCH, CTX_LEN, D), 1.0),
        "c_ctx": nrm(3, (D,), 1.0),
        "ada_w": nrm(4, (DEPTH, D, N_MOD * D), 0.5 * D ** -0.5),
        "ada_b": nrm(5, (DEPTH, N_MOD * D), 0.02),
        "norm_mix": 1.0 + nrm(6, (DEPTH, D), 0.02),
        "norm_ffn": 1.0 + nrm(7, (DEPTH, D), 0.02),
        "hy_w_in": nrm(8, (NHy, D, 3 * D), D ** -0.5),
        "hy_b_in": nrm(9, (NHy, 3 * D), 0.02),
        "hy_conv_w": nrm(10, (NHy, HY_SHORT, 3 * D), HY_SHORT ** -0.5),
        "hy_conv_b": nrm(11, (NHy, 3 * D), 0.02),
        "hy_f_w1": nrm(12, (NHy, HY_EMB_DIM, HY_FILTER_HIDDEN), HY_EMB_DIM ** -0.5),
        "hy_f_b1": nrm(13, (NHy, HY_FILTER_HIDDEN), 0.1),
        "hy_f_w2": nrm(14, (NHy, HY_FILTER_HIDDEN, HY_FILTER_HIDDEN), HY_FILTER_HIDDEN ** -0.5),
        "hy_f_b2": nrm(15, (NHy, HY_FILTER_HIDDEN), 0.1),
        "hy_f_w3": nrm(16, (NHy, HY_FILTER_HIDDEN, HY_FILTER_HIDDEN), HY_FILTER_HIDDEN ** -0.5),
        "hy_f_b3": nrm(17, (NHy, HY_FILTER_HIDDEN), 0.1),
        "hy_f_w4": nrm(18, (NHy, HY_FILTER_HIDDEN, HY_ORDER * 2 * D), HY_FILTER_HIDDEN ** -0.5),
        "hy_f_freq": 1.0 + nrm(19, (NHy, HY_FILTER_HIDDEN), 0.02),
        "hy_skip": nrm(20, (NHy, HY_ORDER, D), 0.5),
        "hy_w_out": nrm(21, (NHy, D, D), D ** -0.5),
        "hy_b_out": nrm(22, (NHy, D), 0.02),
        "da_w_qkv": nrm(23, (NA, D, 3 * D), D ** -0.5),
        "da_q_norm": 1.0 + nrm(24, (NA, DA_HEAD_DIM), 0.02),
        "da_k_norm": 1.0 + nrm(25, (NA, DA_HEAD_DIM), 0.02),
        "da_lam_q1": nrm(26, (NA, DA_HEAD_DIM), 0.1),
        "da_lam_k1": nrm(27, (NA, DA_HEAD_DIM), 0.1),
        "da_lam_q2": nrm(28, (NA, DA_HEAD_DIM), 0.1),
        "da_lam_k2": nrm(29, (NA, DA_HEAD_DIM), 0.1),
        "da_subln": 1.0 + nrm(30, (NA, DA_V_DIM), 0.02),
        "da_w_out": nrm(31, (NA, D, D), D ** -0.5),
        "moe_router": nrm(32, (DEPTH, D, E), D ** -0.5),
        "moe_w_gate": nrm(33, (DEPTH, E, D, F), D ** -0.5),
        "moe_w_up": nrm(34, (DEPTH, E, D, F), D ** -0.5),
        "moe_w_down": nrm(35, (DEPTH, E, F, D), F ** -0.5),
    }


def reference(x, c, ctx, c_ctx, ada_w, ada_b, norm_mix, norm_ffn,
              hy_w_in, hy_b_in, hy_conv_w, hy_conv_b, hy_f_w1, hy_f_b1, hy_f_w2, hy_f_b2,
              hy_f_w3, hy_f_b3, hy_f_w4, hy_f_freq, hy_skip, hy_w_out, hy_b_out,
              da_w_qkv, da_q_norm, da_k_norm, da_lam_q1, da_lam_k1, da_lam_q2, da_lam_k2,
              da_subln, da_w_out, moe_router, moe_w_gate, moe_w_up, moe_w_down):
    n_lat = x.shape[1]
    rows = n_lat // GRID_W
    row = jnp.repeat(jnp.arange(rows, dtype=jnp.int32), GRID_W)
    col = jnp.tile(jnp.arange(GRID_W, dtype=jnp.int32), rows)
    for i in range(DEPTH):
        last = i == DEPTH - 1
        j = i // N_MIXERS
        mx = adaln(c, ada_w[i], ada_b[i])
        mc = adaln(c_ctx[None], ada_w[i], ada_b[i])
        hx = modulate(rms_norm(x, norm_mix[i]), mx[:, 0], mx[:, 1])
        hc = modulate(rms_norm(ctx, norm_mix[i]), mc[:, 0], mc[:, 1])
        if i % N_MIXERS == 0:
            hp = (hy_w_in[j], hy_b_in[j], hy_conv_w[j], hy_conv_b[j], hy_f_w1[j], hy_f_b1[j],
                  hy_f_w2[j], hy_f_b2[j], hy_f_w3[j], hy_f_b3[j], hy_f_w4[j], hy_f_freq[j],
                  hy_skip[j], hy_w_out[j], hy_b_out[j])
            yx = hyena_mix(hx, *hp)
            yc = None if last else hyena_mix(hc, *hp)
        else:
            lam_init = 0.8 - 0.6 * math.exp(-0.3 * i)
            yx, yc = diff_attention(hx, hc, row, col, lam_init, not last, da_w_qkv[j],
                                    da_q_norm[j], da_k_norm[j], da_lam_q1[j], da_lam_k1[j],
                                    da_lam_q2[j], da_lam_k2[j], da_subln[j], da_w_out[j])
        x = x + mx[:, 2] * yx
        mp = (moe_router[i], moe_w_gate[i], moe_w_up[i], moe_w_down[i])
        if not last:
            ctx = ctx + mc[:, 2] * yc
            ctx = ctx + mc[:, 5] * ec_moe(modulate(rms_norm(ctx, norm_ffn[i]), mc[:, 3], mc[:, 4]), *mp)
        x = x + mx[:, 5] * ec_moe(modulate(rms_norm(x, norm_ffn[i]), mx[:, 3], mx[:, 4]), *mp)
    return x
```

```cpp
#include <hip/hip_runtime.h>
#include <hip/hip_cooperative_groups.h>
#include <cstdio>
#include <cstdint>
namespace cg = cooperative_groups;

#ifndef PH_MASK
#define PH_MASK 0xffffffffu
#endif
#ifdef DIAG_NOCONV
#define DIAG_Y(y) y = cmk(0.f, 0.f)
#else
#define DIAG_Y(y)
#endif
#ifndef STOP_STAGE
#define STOP_STAGE 99
#endif

#define LAS __attribute__((address_space(3)))
typedef LAS unsigned char* ldsp;
typedef unsigned short bf16_t;
typedef short bf16x8 __attribute__((ext_vector_type(8)));
typedef short s16x4 __attribute__((ext_vector_type(4)));
typedef float f32x4 __attribute__((ext_vector_type(4)));
typedef float f32x2 __attribute__((ext_vector_type(2)));
typedef float f32x16 __attribute__((ext_vector_type(16)));
typedef unsigned u32x4 __attribute__((ext_vector_type(4)));
typedef unsigned u32x2 __attribute__((ext_vector_type(2)));
typedef __bf16 bf16x2_t __attribute__((ext_vector_type(2)));
typedef _Float16 h16;
typedef _Float16 h16x2 __attribute__((ext_vector_type(2)));

constexpr int NT = 512;
constexpr int LDS_BYTES = 147456;
constexpr int SEQ = 16384, CTX = 256, DM = 1024, NKEY = SEQ + CTX;
constexpr size_t MiB = 1u << 20;
constexpr size_t OFF_MODS = 0;
constexpr size_t OFF_ROPE = 160 * 1024;
constexpr size_t OFF_HIDX = 1 * MiB;
constexpr size_t OFF_HIDC = 3 * MiB;
constexpr size_t OFF_W4T = 3 * MiB + 512 * 1024;
constexpr size_t OFF_WIN = 4 * MiB;
constexpr size_t OFF_WHO = 10 * MiB;
constexpr size_t OFF_WQKV = 12 * MiB;
constexpr size_t OFF_WDO = 18 * MiB;
constexpr size_t OFF_KCTX = 20 * MiB;
constexpr size_t OFF_AFF = 24 * MiB;
constexpr size_t OFF_SELI = 26 * MiB;
constexpr size_t OFF_SELG = 26 * MiB + 256 * 1024;
constexpr size_t OFF_SLOT = 26 * MiB + 512 * 1024;
constexpr size_t OFF_CTXMID = 28 * MiB;
constexpr size_t OFF_HC = 30 * MiB;
constexpr size_t OFF_UCT = 31 * MiB;
constexpr size_t OFF_HCT = 33 * MiB;
constexpr size_t OFF_ZC2T = 35 * MiB;
constexpr size_t OFF_ZC2 = 35 * MiB + 512 * 1024;
constexpr size_t OFF_ACTC = 36 * MiB;
constexpr size_t OFF_YBC = 44 * MiB;
constexpr size_t OFF_HX = 56 * MiB;
constexpr size_t OFF_HT = 88 * MiB;
constexpr size_t OFF_WGU = 88 * MiB, OFF_WD = 152 * MiB;
constexpr size_t OFF_KSPEC = 216 * MiB;
constexpr size_t OFF_ACT = 216 * MiB, OFF_YB = 280 * MiB, OFF_O = 216 * MiB;
constexpr size_t OFF_UT = 344 * MiB;
constexpr size_t OFF_X1 = 344 * MiB;
constexpr size_t OFF_Q = 408 * MiB;
constexpr size_t OFF_Z2T = 440 * MiB;
constexpr size_t OFF_KALL = 440 * MiB;
constexpr size_t OFF_VT = 473 * MiB;
constexpr size_t WS_END = 506 * MiB;

struct Params { const float* in[36]; float* out; unsigned char* ws; };
enum { I_X = 0, I_C, I_CTX, I_CCTX, I_ADAW, I_ADAB, I_NMIX, I_NFFN, I_HWIN, I_HBIN, I_HCW, I_HCB, I_FW1, I_FB1, I_FW2, I_FB2, I_FW3, I_FB3, I_FW4, I_FFREQ,
       I_HSKIP, I_HWOUT, I_HBOUT, I_DWQKV, I_DQN, I_DKN, I_LQ1, I_LK1, I_LQ2, I_LK2, I_SUBLN, I_DWOUT, I_ROUTER, I_WG, I_WU, I_WDN };

__device__ __forceinline__ unsigned f2bf(float f) { unsigned u = __builtin_bit_cast(unsigned, f); return (u + 0x7fffu + ((u >> 16) & 1u)) >> 16; }
__device__ __forceinline__ float bf2f(unsigned b) { return __builtin_bit_cast(float, b << 16); }
__device__ __forceinline__ unsigned pk2(float lo, float hi) { f32x2 v = {lo, hi}; bf16x2_t b = __builtin_convertvector(v, bf16x2_t); return __builtin_bit_cast(unsigned, b); }
__device__ __forceinline__ float wave_sum(float v) {
#pragma unroll
  for (int o = 1; o < 64; o <<= 1) v += __shfl_xor(v, o);
  return v;
}
__device__ __forceinline__ float siluf(float x) { return x / (1.f + __expf(-x)); }

#define FFT_HD __device__ __forceinline__
#define FFT_LDS LAS
#define EPI_FENCE(v) asm volatile("" : "+v"(v) :: "memory")
#define FFT_OPAQUE(v) asm volatile("" : "+v"(v))
__device__ __forceinline__ float fft_sin_rev(float x) { return __builtin_amdgcn_sinf(x); }
__device__ __forceinline__ float fft_cos_rev(float x) { return __builtin_amdgcn_cosf(x); }
#ifdef FFT_HOST_TEST
struct cf { float x, y; };
FFT_HD cf cmk(float a, float b) { cf r; r.x = a; r.y = b; return r; }
#else
typedef float cf __attribute__((ext_vector_type(2)));
FFT_HD cf cmk(float a, float b) { cf r; r.x = a; r.y = b; return r; }
#endif
FFT_HD cf cadd(cf a, cf b) { return cmk(a.x + b.x, a.y + b.y); }
FFT_HD cf csub(cf a, cf b) { return cmk(a.x - b.x, a.y - b.y); }
FFT_HD cf cmul(cf a, cf b) { return cmk(a.x * b.x - a.y * b.y, a.x * b.y + a.y * b.x); }
FFT_HD cf cconj(cf a) { return cmk(a.x, -a.y); }
constexpr int FFT_M = 16384;
FFT_HD int fft_pad(int i) { return i + ((i >> 6) << 2); }
constexpr int FFT_LDS_ELEMS = FFT_M + (FFT_M >> 6) * 4;

template <bool INV> FFT_HD void dft4(cf& a, cf& b, cf& c, cf& d) {
  cf s0 = cadd(a, c), s1 = csub(a, c), s2 = cadd(b, d), s3 = csub(b, d);
  cf r = INV ? cmk(-s3.y, s3.x) : cmk(s3.y, -s3.x);
  a = cadd(s0, s2); c = csub(s0, s2); b = cadd(s1, r); d = csub(s1, r);
}
template <bool INV> FFT_HD void dft16(cf (&x)[16]) {
#pragma unroll
  for (int n2 = 0; n2 < 4; ++n2) dft4<INV>(x[n2], x[4 + n2], x[8 + n2], x[12 + n2]);
  const float C1 = 0.92387953251128674f, S1 = 0.38268343236508977f, C2 = 0.70710678118654752f;
#define TW(i, cr, ci) x[i] = cmul(x[i], cmk(cr, INV ? -(ci) : (ci)))
  TW(4 + 1, C1, -S1); TW(4 + 2, C2, -C2); TW(4 + 3, S1, -C1);
  TW(8 + 1, C2, -C2); TW(8 + 2, 0.f, -1.f); TW(8 + 3, -C2, -C2);
  TW(12 + 1, S1, -C1); TW(12 + 2, -C2, -C2); TW(12 + 3, -C1, S1);
#undef TW
#pragma unroll
  for (int k1 = 0; k1 < 4; ++k1) dft4<INV>(x[4 * k1], x[4 * k1 + 1], x[4 * k1 + 2], x[4 * k1 + 3]);
}
template <bool INV, int NP> FFT_HD void fft_bfly16(FFT_LDS cf* a, int b) {
  constexpr int S = NP / 16;
  FFT_OPAQUE(b);
  const int blk = b / S, j = b % S, base = blk * NP + j;
  cf x[16];
  if (!INV) {
#pragma unroll
    for (int q = 0; q < 16; ++q) x[q] = a[fft_pad(base + q * S)];
    dft16<false>(x);
#pragma unroll
    for (int q = 0; q < 16; ++q) {
      cf v = x[4 * (q & 3) + (q >> 2)];
      if (q > 0 && S > 1) { const float fr = (float)((j * q) & (NP - 1)) * (1.0f / NP); v = cmul(v, cmk(fft_cos_rev(fr), -fft_sin_rev(fr))); }
      a[fft_pad(base + q * S)] = v;
    }
  } else {
#pragma unroll
    for (int q = 0; q < 16; ++q) {
      cf v = a[fft_pad(base + q * S)];
      if (q > 0 && S > 1) { const float fr = (float)((j * q) & (NP - 1)) * (1.0f / NP); v = cmul(v, cmk(fft_cos_rev(fr), fft_sin_rev(fr))); }
      x[q] = v;
    }
    dft16<true>(x);
#pragma unroll
    for (int q = 0; q < 16; ++q) a[fft_pad(base + q * S)] = x[4 * (q & 3) + (q >> 2)];
  }
}
template <bool INV> FFT_HD void fft_bfly4(FFT_LDS cf* a, int b) {
  const int p = fft_pad(4 * b);
  cf x0 = a[p], x1 = a[p + 1], x2 = a[p + 2], x3 = a[p + 3];
  dft4<INV>(x0, x1, x2, x3);
  a[p] = x0; a[p + 1] = x1; a[p + 2] = x2; a[p + 3] = x3;
}
FFT_HD int fft_pos_of_k(int k) { return ((k & 15) << 10) | (((k >> 4) & 15) << 6) | (((k >> 8) & 15) << 2) | (k >> 12); }
FFT_HD int fft_kbase_of_group(int g) { return (g >> 8) | (((g >> 4) & 15) << 4) | ((g & 15) << 8); }
FFT_HD void rfft_unpack(cf Ck, cf Cm, float wr, float wi, cf& Ak, cf& Am) {
  cf E = cmk(0.5f * (Ck.x + Cm.x), 0.5f * (Ck.y - Cm.y));
  cf T = cmk(0.5f * (Ck.x - Cm.x), 0.5f * (Ck.y + Cm.y));
  cf O = cmk(T.y, -T.x);
  cf wO = cmul(cmk(wr, wi), O);
  Ak = cadd(E, wO); Am = cconj(csub(E, wO));
}
FFT_HD void rfft_pack(cf Yk, cf Ym, float wr, float wi, cf& Ck, cf& Cm) {
  cf E = cmk(0.5f * (Yk.x + Ym.x), 0.5f * (Yk.y - Ym.y));
  cf D = cmk(0.5f * (Yk.x - Ym.x), 0.5f * (Yk.y + Ym.y));
  cf O = cmul(cmk(wr, -wi), D);
  Ck = cmk(E.x - O.y, E.y + O.x);
  Cm = cmk(E.x + O.y, -E.y + O.x);
}
template <class ST> FFT_HD void fft_filter_group(FFT_LDS cf* a, int g, float scale, ST st) {
  FFT_OPAQUE(g);
  const int ka = fft_kbase_of_group(g), kb = ka + 4096;
  const int pa = 4 * g, pb = 4 * g + 1;
  {
    const int km = FFT_M - kb, pm = fft_pos_of_k(km);
    const float fr = (float)kb * (1.0f / (2 * FFT_M));
    cf Ak, Am; rfft_unpack(a[fft_pad(pb)], a[fft_pad(pm)], fft_cos_rev(fr), -fft_sin_rev(fr), Ak, Am);
    st(pb, cmk(Ak.x * scale, Ak.y * scale)); st(pm, cmk(Am.x * scale, Am.y * scale));
  }
  if (g == 0) {
    cf C0 = a[fft_pad(0)]; st(0, cmk((C0.x + C0.y) * scale, (C0.x - C0.y) * scale));
    cf C2 = a[fft_pad(2)]; st(2, cmk(C2.x * scale, -C2.y * scale));
  } else {
    const int km = FFT_M - ka, pm = fft_pos_of_k(km);
    const float fr = (float)ka * (1.0f / (2 * FFT_M));
    cf Ak, Am; rfft_unpack(a[fft_pad(pa)], a[fft_pad(pm)], fft_cos_rev(fr), -fft_sin_rev(fr), Ak, Am);
    st(pa, cmk(Ak.x * scale, Ak.y * scale)); st(pm, cmk(Am.x * scale, Am.y * scale));
  }
}
template <class LD> FFT_HD void fft_conv_group(FFT_LDS cf* a, int g, LD ld) {
  FFT_OPAQUE(g);
  const int ka = fft_kbase_of_group(g), kb = ka + 4096;
  const int pa = 4 * g, pb = 4 * g + 1;
  {
    const int km = FFT_M - kb, pm = fft_pos_of_k(km);
    const float fr = (float)kb * (1.0f / (2 * FFT_M));
    const float wr = fft_cos_rev(fr), wi = -fft_sin_rev(fr);
    cf Ak, Am; rfft_unpack(a[fft_pad(pb)], a[fft_pad(pm)], wr, wi, Ak, Am);
    cf Yk = cmul(Ak, ld(pb)), Ym = cmul(Am, ld(pm));
    cf Ck, Cm; rfft_pack(Yk, Ym, wr, wi, Ck, Cm);
    a[fft_pad(pb)] = Ck; a[fft_pad(pm)] = Cm;
  }
  if (g == 0) {
    cf C0 = a[fft_pad(0)]; cf K0 = ld(0);
    const float Y0 = (C0.x + C0.y) * K0.x, YM = (C0.x - C0.y) * K0.y;
    a[fft_pad(0)] = cmk(0.5f * (Y0 + YM), 0.5f * (Y0 - YM));
    cf C2 = a[fft_pad(2)]; cf Y = cmul(cconj(C2), ld(2)); a[fft_pad(2)] = cconj(Y);
  } else {
    const int km = FFT_M - ka, pm = fft_pos_of_k(km);
    const float fr = (float)ka * (1.0f / (2 * FFT_M));
    const float wr = fft_cos_rev(fr), wi = -fft_sin_rev(fr);
    cf Ak, Am; rfft_unpack(a[fft_pad(pa)], a[fft_pad(pm)], wr, wi, Ak, Am);
    cf Yk = cmul(Ak, ld(pa)), Ym = cmul(Am, ld(pm));
    cf Ck, Cm; rfft_pack(Yk, Ym, wr, wi, Ck, Cm);
    a[fft_pad(pa)] = Ck; a[fft_pad(pm)] = Cm;
  }
}


__device__ __forceinline__ int lds_byte2(int r, int c) { int st = (r >> 4) * 2 + (c >> 5), ob = (r & 15) * 64 + (c & 31) * 2; return st * 1024 + (ob ^ (((ob >> 9) & 1) << 5)); }
__device__ __forceinline__ void stage_rc2(int b, int& R, int& C) { int st = b >> 10, sb = b & 1023, swz = sb ^ (((sb >> 9) & 1) << 5); R = (st >> 1) * 16 + swz / 64; C = (st & 1) * 32 + (swz % 64) / 2; }

template <class AR, class BR, class EP>
__device__ __forceinline__ void gemm_tile(ldsp shm, const bf16_t* __restrict__ A, const bf16_t* __restrict__ Bt, int K, AR arow, BR brow, EP epi) {
  constexpr int TILE_B = 32768, STAGE_B = 65536, GL = 4;
  const int tid = threadIdx.x, wid = __builtin_amdgcn_readfirstlane(tid >> 6), lane = tid & 63, wr = wid >> 2, wc = wid & 3, fr = lane & 15, fq = lane >> 4;
  unsigned oa[GL], ob[GL];
#pragma unroll
  for (int i = 0; i < GL; ++i) { int R, C; stage_rc2(wid * 1024 + i * 8192 + lane * 16, R, C); oa[i] = (unsigned)(arow(R) + C) * 2u; ob[i] = (unsigned)(brow(R) + C) * 2u; }
  f32x4 acc[8][4];
#pragma unroll
  for (int m = 0; m < 8; ++m)
#pragma unroll
    for (int n = 0; n < 4; ++n) acc[m][n] = (f32x4){0.f, 0.f, 0.f, 0.f};
  const int aoff = lds_byte2(wr * 128 + fr, fq * 8), boff = TILE_B + lds_byte2(wc * 64 + fr, fq * 8);
#define G_STAGE(buf, kt) do { const char* ga = (const char*)(A + (kt) * 64); const char* gb = (const char*)(Bt + (kt) * 64); _Pragma("unroll") for (int i = 0; i < GL; ++i) { \
    __builtin_amdgcn_global_load_lds((const unsigned*)(ga + oa[i]), (LAS unsigned*)(shm + (buf) * STAGE_B + wid * 1024 + i * 8192), 16, 0, 0); \
    __builtin_amdgcn_global_load_lds((const unsigned*)(gb + ob[i]), (LAS unsigned*)(shm + (buf) * STAGE_B + TILE_B + wid * 1024 + i * 8192), 16, 0, 0); } } while (0)
  const int nt = K / 64;
  G_STAGE(0, 0);
  asm volatile("s_waitcnt vmcnt(0)" ::: "memory"); __syncthreads();
  for (int t = 0; t < nt; ++t) {
    const int cur = t & 1;
    if (t + 1 < nt) G_STAGE(cur ^ 1, t + 1);
    ldsp sa = shm + cur * STAGE_B;
#pragma unroll
    for (int ks = 0; ks < 2; ++ks) {
      bf16x8 At[8], Bf[4];
#pragma unroll
      for (int m = 0; m < 8; ++m) At[m] = *(const LAS bf16x8*)(sa + aoff + m * 2048 + ks * 1024);
#pragma unroll
      for (int n = 0; n < 4; ++n) Bf[n] = *(const LAS bf16x8*)(sa + boff + n * 2048 + ks * 1024);
#pragma unroll
      for (int m = 0; m < 8; ++m)
#pragma unroll
        for (int n = 0; n < 4; ++n) acc[m][n] = __builtin_amdgcn_mfma_f32_16x16x32_bf16(At[m], Bf[n], acc[m][n], 0, 0, 0);
      __builtin_amdgcn_sched_barrier(0);
    }
    asm volatile("s_waitcnt vmcnt(0)" ::: "memory"); __syncthreads();
  }
#undef G_STAGE
  epi(acc, wr, wc, fr, fq);
}

__device__ __forceinline__ void transpose_item(const float* __restrict__ W, int ldw, int k0, int n0, bf16_t* __restrict__ dst, int ldd, int drow0, LAS float* scr, int lane) {
#pragma unroll 8
  for (int i = 0; i < 32; ++i) { const int kk = 2 * i + (lane >> 5); scr[kk * 33 + (lane & 31)] = W[(size_t)(k0 + kk) * ldw + n0 + (lane & 31)]; }
  asm volatile("s_waitcnt lgkmcnt(0)" ::: "memory");
  const int c = lane & 7;
#pragma unroll
  for (int j = 0; j < 4; ++j) {
    const int n = (lane >> 3) + 8 * j; const LAS float* s = scr + (8 * c) * 33 + n;
    u32x4 o; o.x = pk2(s[0], s[33]); o.y = pk2(s[2 * 33], s[3 * 33]); o.z = pk2(s[4 * 33], s[5 * 33]); o.w = pk2(s[6 * 33], s[7 * 33]);
    *(u32x4*)(dst + (size_t)(drow0 + n) * ldd + k0 + 8 * c) = o;
  }
  asm volatile("s_waitcnt lgkmcnt(0)" ::: "memory");
}
__device__ __forceinline__ void transpose_weight(const float* W, int K, int N, bf16_t* dst, int gw, int ngw, LAS float* scr, int lane) {
  const int nblk = N / 32, items = (K / 64) * nblk;
  for (int it = gw; it < items; it += ngw) { const int kb = it / nblk, nb = it % nblk; transpose_item(W, N, kb * 64, nb * 32, dst, K, nb * 32, scr, lane); }
}
__device__ __forceinline__ void convert_moe(const float* wg, const float* wu, const float* wd, bf16_t* Wgu, bf16_t* Wd, int gw, int ngw, LAS float* scr, int lane) {
  const int total = 16 * 1536;
  for (int it = gw; it < total; it += ngw) {
    const int e = it / 1536, r = it % 1536;
    if (r < 1024) {
      const int up = r >> 9, q = r & 511, kb = q >> 5, nb = q & 31;
      const float* W = (up ? wu : wg) + (size_t)e * 1024 * 1024;
      const int f0 = nb * 32, pn = f0 >> 7, wcx = (f0 & 127) >> 5;
      transpose_item(W, 1024, kb * 64, f0, Wgu + (size_t)e * 2048 * 1024, 1024, pn * 256 + wcx * 64 + up * 32, scr, lane);
    } else {
      const int q = r - 1024, kb = q >> 5, nb = q & 31;
      transpose_item(wd + (size_t)e * 1024 * 1024, 1024, kb * 64, nb * 32, Wd + (size_t)e * 1024 * 1024, 1024, nb * 32, scr, lane);
    }
  }
}

__device__ __forceinline__ float norm_mod_regs(const f32x4 (&v)[4], const float* g, const float* shift, const float* scale, bf16_t* orow, int lane) {
  float ss = 0.f;
#pragma unroll
  for (int j = 0; j < 4; ++j) ss += v[j].x * v[j].x + v[j].y * v[j].y + v[j].z * v[j].z + v[j].w * v[j].w;
  const float rstd = 1.0f / sqrtf(wave_sum(ss) * (1.f / 1024.f) + 1e-6f);
#pragma unroll
  for (int j = 0; j < 4; ++j) {
    const f32x4 gg = ((const f32x4*)g)[lane + 64 * j], sh = ((const f32x4*)shift)[lane + 64 * j], sc = ((const f32x4*)scale)[lane + 64 * j];
    const f32x4 y = v[j] * rstd * gg * (1.f + sc) + sh;
    u32x2 o; o.x = pk2(y.x, y.y); o.y = pk2(y.z, y.w);
    ((u32x2*)orow)[lane + 64 * j] = o;
  }
  return rstd;
}
__device__ __forceinline__ float norm_mod_row(const float* xrow, const float* g, const float* shift, const float* scale, bf16_t* orow, int lane) {
  f32x4 v[4];
#pragma unroll
  for (int j = 0; j < 4; ++j) v[j] = ((const f32x4*)xrow)[lane + 64 * j];
  return norm_mod_regs(v, g, shift, scale, orow, lane);
}
template <int NPT>
__device__ __forceinline__ void topk_block(ldsp lds, const float* aff, int e, int N, int cap, int* sel_idx, float* sel_g, int* slot_of) {
  LAS int* hist = (LAS int*)lds; LAS int* misc = hist + 256; LAS int* wtot = misc + 8;
  const int tid = threadIdx.x, lane = tid & 63, wid = tid >> 6;
  unsigned key[NPT];
#pragma unroll
  for (int i = 0; i < NPT; ++i) { const int idx = tid * NPT + i; key[i] = idx < N ? __builtin_bit_cast(unsigned, aff[(size_t)idx * 16 + e]) : 0u; }
  unsigned prefix = 0u, mask = 0u; int rem = cap;
#pragma unroll 1
  for (int pass = 0; pass < 4; ++pass) {
    const int shift = 24 - 8 * pass;
    if (tid < 256) hist[tid] = 0;
    __syncthreads();
#pragma unroll
    for (int i = 0; i < NPT; ++i) { const int idx = tid * NPT + i; if (idx < N && (key[i] & mask) == prefix) atomicAdd((int*)&hist[(key[i] >> shift) & 255u], 1); }
    __syncthreads();
    if (wid == 0) {
      const int h0 = hist[4 * lane], h1 = hist[4 * lane + 1], h2 = hist[4 * lane + 2], h3 = hist[4 * lane + 3];
      const int s = h0 + h1 + h2 + h3; int suf = s;
#pragma unroll
      for (int off = 1; off < 64; off <<= 1) { const int t = __shfl_down(suf, off); if (lane + off < 64) suf += t; }
      int c = suf - s;
      if (c < rem && c + h3 >= rem) { misc[0] = 4 * lane + 3; misc[1] = rem - c; } c += h3;
      if (c < rem && c + h2 >= rem) { misc[0] = 4 * lane + 2; misc[1] = rem - c; } c += h2;
      if (c < rem && c + h1 >= rem) { misc[0] = 4 * lane + 1; misc[1] = rem - c; } c += h1;
      if (c < rem && c + h0 >= rem) { misc[0] = 4 * lane + 0; misc[1] = rem - c; }
    }
    __syncthreads();
    const int bin = misc[0]; rem = misc[1];
    prefix |= (unsigned)bin << shift; mask |= 0xFFu << shift;
    __syncthreads();
  }
  const unsigned T = prefix;
  int cgt = 0, ceq = 0;
#pragma unroll
  for (int i = 0; i < NPT; ++i) { const int idx = tid * NPT + i; if (idx < N) { cgt += key[i] > T ? 1 : 0; ceq += key[i] == T ? 1 : 0; } }
  int igt = cgt, ieq = ceq;
#pragma unroll
  for (int off = 1; off < 64; off <<= 1) { const int a = __shfl_up(igt, off), b = __shfl_up(ieq, off); if (lane >= off) { igt += a; ieq += b; } }
  if (lane == 63) { wtot[wid * 2] = igt; wtot[wid * 2 + 1] = ieq; }
  __syncthreads();
  int bgt = 0, beq = 0, tgt = 0;
#pragma unroll
  for (int w = 0; w < 8; ++w) { const int a = wtot[2 * w], b = wtot[2 * w + 1]; if (w < wid) { bgt += a; beq += b; } tgt += a; }
  int pgt = bgt + igt - cgt, peq = beq + ieq - ceq;
#pragma unroll
  for (int i = 0; i < NPT; ++i) {
    const int idx = tid * NPT + i;
    if (idx < N) {
      int slot = -1;
      if (key[i] > T) slot = pgt++;
      else if (key[i] == T) { if (peq < rem) slot = tgt + peq; ++peq; }
      slot_of[(size_t)idx * 16 + e] = slot;
      if (slot >= 0) { sel_idx[slot] = idx; sel_g[slot] = __builtin_bit_cast(float, key[i]); }
    }
  }
  __syncthreads();
}

__global__ void __launch_bounds__(NT) mega(Params p) {
  extern __shared__ __attribute__((aligned(16))) unsigned char lds_raw[];
  cg::grid_group grid = cg::this_grid();
  ldsp lds = (ldsp)lds_raw;
  const int tid = threadIdx.x, lane = tid & 63, wid = tid >> 6;
  const int G = gridDim.x, bid = blockIdx.x;
  const int gw = bid * 8 + wid, ngw = G * 8;
  unsigned char* ws = p.ws;
  float* mods = (float*)(ws + OFF_MODS);
#define MODP(layer, set, m) (mods + (((layer) * 2 + (set)) * 6 + (m)) * 1024)
  LAS float* lf = (LAS float*)lds;

#if (PH_MASK >> 0) & 1
  {
    { for (int i = tid; i < 1024; i += NT) { lf[i] = siluf(p.in[I_C][i]); lf[1024 + i] = siluf(p.in[I_CCTX][i]); }
      __syncthreads();
      for (int task = bid; task < 192; task += G) {
        const int l = task / 96, n0 = (task % 96) * 64, kq = tid >> 6, n = tid & 63;
        const float* W = p.in[I_ADAW] + (size_t)l * 1024 * 6144 + n0 + n;
        float s0 = 0.f, s1 = 0.f;
        for (int k = kq; k < 1024; k += 8) { const float w = W[(size_t)k * 6144]; s0 += lf[k] * w; s1 += lf[1024 + k] * w; }
        lf[2048 + (kq * 64 + n) * 2] = s0; lf[2048 + (kq * 64 + n) * 2 + 1] = s1;
        __syncthreads();
        if (tid < 64) { float a = 0.f, b = 0.f;
#pragma unroll
          for (int q = 0; q < 8; ++q) { a += lf[2048 + (q * 64 + tid) * 2]; b += lf[2048 + (q * 64 + tid) * 2 + 1]; }
          const float bb = p.in[I_ADAB][l * 6144 + n0 + tid];
          mods[(l * 2 + 0) * 6144 + n0 + tid] = a + bb; mods[(l * 2 + 1) * 6144 + n0 + tid] = b + bb; }
        __syncthreads();
      }
    }
    __syncthreads();
    { LAS float* w1 = lf; LAS float* w2 = lf + 33 * 64; LAS float* w3 = w2 + 4096; LAS float* bz = w3 + 4096;   LAS float* scr = bz + 256 + wid * 64;
      for (int i = tid; i < 33 * 64; i += NT) w1[i] = p.in[I_FW1][i];
      for (int i = tid; i < 4096; i += NT) { w2[i] = p.in[I_FW2][i]; w3[i] = p.in[I_FW3][i]; }
      if (tid < 64) { bz[tid] = p.in[I_FB1][tid]; bz[64 + tid] = p.in[I_FB2][tid]; bz[128 + tid] = p.in[I_FB3][tid]; bz[192 + tid] = p.in[I_FFREQ][tid]; }
      __syncthreads();
      const float fq_ = bz[192 + lane];
      for (int rg = bid; rg < NKEY / 8; rg += G) {
        const int row = rg * 8 + wid; const bool isx = row < SEQ; const int l = isx ? row : row - SEQ; const int L = isx ? SEQ : CTX;
        const float t = (float)l / (float)(L - 1); const float w = 6.283185307179586f * (float)l / (float)L;
        float zv;
        if (lane == 0) zv = t;
        else if (lane <= 32) { const int b = (lane - 1) & 15; const float band = 1e-4f + (float)b * ((15.f - 1e-4f) / 15.f); const float a = w * band; zv = (lane <= 16) ? cosf(a) : -sinf(a); }
        else zv = 0.f;
        scr[lane] = zv;
        __syncthreads();
        float a = bz[lane];
        for (int i = 0; i < 33; ++i) a += scr[i] * w1[i * 64 + lane];
        float h = sinf(fq_ * a);
        __syncthreads(); scr[lane] = h; __syncthreads();
        a = bz[64 + lane];
        for (int i = 0; i < 64; ++i) a += scr[i] * w2[i * 64 + lane];
        h = sinf(fq_ * a);
        __syncthreads(); scr[lane] = h; __syncthreads();
        a = bz[128 + lane];
        for (int i = 0; i < 64; ++i) a += scr[i] * w3[i * 64 + lane];
        h = sinf(fq_ * a);
        bf16_t* hid = isx ? (bf16_t*)(ws + OFF_HIDX) + (size_t)l * 64 : (bf16_t*)(ws + OFF_HIDC) + (size_t)l * 64;
        hid[lane] = (bf16_t)f2bf(h);
        __syncthreads();
      }
    }
    __syncthreads();
    { LAS float* scr = lf + wid * (64 * 33);
      transpose_weight(p.in[I_FW4], 64, 4096, (bf16_t*)(ws + OFF_W4T), gw, ngw, scr, lane);
      transpose_weight(p.in[I_HWIN], 1024, 3072, (bf16_t*)(ws + OFF_WIN), gw, ngw, scr, lane);
      transpose_weight(p.in[I_HWOUT], 1024, 1024, (bf16_t*)(ws + OFF_WHO), gw, ngw, scr, lane);
      transpose_weight(p.in[I_DWQKV], 1024, 3072, (bf16_t*)(ws + OFF_WQKV), gw, ngw, scr, lane);
      transpose_weight(p.in[I_DWOUT], 1024, 1024, (bf16_t*)(ws + OFF_WDO), gw, ngw, scr, lane);
    }
    { f32x2* rope = (f32x2*)(ws + OFF_ROPE);
      for (int i = bid * NT + tid; i < 4096; i += G * NT) { const int pos = i >> 4, k = i & 15; const float inv = powf(10000.f, -(float)(2 * k) / 32.f); const float a = (float)pos * inv; rope[i] = (f32x2){cosf(a), sinf(a)}; }
    }
  }
#endif
  grid.sync();
#if (PH_MASK >> 1) & 1
  {
    for (int tile = bid; tile < 1024 + 16; tile += G) {
      const bool isx = tile < 1024; const int tt = isx ? tile : tile - 1024;
      const int pm = isx ? (tt >> 6) : tt, pn = isx ? (tt & 63) : 0;
      const bf16_t* A = (const bf16_t*)(ws + OFF_W4T) + (size_t)pm * 256 * 64;
      const bf16_t* B = isx ? (const bf16_t*)(ws + OFF_HIDX) + (size_t)pn * 256 * 64 : (const bf16_t*)(ws + OFF_HIDC);
      h16* HT = isx ? (h16*)(ws + OFF_HT) : (h16*)(ws + OFF_HCT); const int ld = isx ? SEQ : CTX;
      gemm_tile(lds, A, B, 64, [](int r) { return r * 64; }, [](int r) { return r * 64; },
        [&](f32x4 (&acc)[8][4], int wr, int wc, int fr, int fq) {
#pragma unroll
          for (int m = 0; m < 8; ++m) {
            int r0 = pm * 256 + wr * 128 + m * 16 + fq * 4; EPI_FENCE(r0);
            h16* rp = HT + (size_t)r0 * ld + pn * 256 + wc * 64 + fr;
#pragma unroll
            for (int j = 0; j < 4; ++j)
#pragma unroll
              for (int n = 0; n < 4; ++n) rp[(size_t)j * ld + n * 16] = (h16)acc[m][n][j];
          }
        });
    }
    for (int row = gw; row < NKEY; row += ngw) {
      const bool isx = row < SEQ; const int r = isx ? row : row - SEQ; const int set = isx ? 0 : 1;
      const float* xr = isx ? p.in[I_X] + (size_t)r * 1024 : p.in[I_CTX] + (size_t)r * 1024;
      bf16_t* o = isx ? (bf16_t*)(ws + OFF_HX) + (size_t)r * 1024 : (bf16_t*)(ws + OFF_HC) + (size_t)r * 1024;
      norm_mod_row(xr, p.in[I_NMIX], MODP(0, set, 0), MODP(0, set, 1), o, lane);
    }
  }
#endif
  grid.sync();
#if (PH_MASK >> 2) & 1
  {
    for (int tile = bid; tile < 768 + 12; tile += G) {
      const bool isx = tile < 768; const int tt = isx ? tile : tile - 768;
      const int pm = isx ? tt / 64 : tt, pn = isx ? tt % 64 : 0;
      const bf16_t* A = (const bf16_t*)(ws + OFF_WIN) + (size_t)pm * 256 * 1024;
      const bf16_t* B = isx ? (const bf16_t*)(ws + OFF_HX) + (size_t)pn * 256 * 1024 : (const bf16_t*)(ws + OFF_HC);
      h16* UT = isx ? (h16*)(ws + OFF_UT) : (h16*)(ws + OFF_UCT); const int ld = isx ? SEQ : CTX;
      const float* bin = p.in[I_HBIN];
      gemm_tile(lds, A, B, 1024, [](int r) { return r * 1024; }, [](int r) { return r * 1024; },
        [&](f32x4 (&acc)[8][4], int wr, int wc, int fr, int fq) {
#pragma unroll
          for (int m = 0; m < 8; ++m) {
            int r0 = pm * 256 + wr * 128 + m * 16 + fq * 4; EPI_FENCE(r0);
            const f32x4 bv = *(const f32x4*)(bin + r0);
            h16* rp = UT + (size_t)r0 * ld + pn * 256 + wc * 64 + fr;
#pragma unroll
            for (int j = 0; j < 4; ++j)
#pragma unroll
              for (int n = 0; n < 4; ++n) rp[(size_t)j * ld + n * 16] = (h16)(acc[m][n][j] + bv[j]);
          }
        });
    }
    LAS cf* a = (LAS cf*)lds; LAS float* red = (LAS float*)(lds + FFT_LDS_ELEMS * 8);
    for (int task = bid; task < 2048; task += G) {
      const int o = task >> 10, c = task & 1023;
      const h16* hf_ = (const h16*)(ws + OFF_HT) + (size_t)((o * 2 + 0) * 1024 + c) * SEQ;
      const h16* hb_ = (const h16*)(ws + OFF_HT) + (size_t)((o * 2 + 1) * 1024 + c) * SEQ;
      const float adl = 3.0701134573253945f + (15.350567286626973f - 3.0701134573253945f) * (float)c * (1.f / 1023.f);
      const float kdec = -adl * (1.f / 16383.f) * 1.4426950408889634f;
      float sabs = 0.f;
      _Pragma("unroll 2") for (int n = tid; n < FFT_M; n += NT) {
        float re, im;
        if (n < 8192) { const h16x2 v = *(const h16x2*)(hf_ + 2 * n); re = (float)v.x * exp2f(kdec * (float)(2 * n)); im = (float)v.y * exp2f(kdec * (float)(2 * n + 1)); }
        else if (n == 8192) { re = 0.f; im = (float)hb_[16383] * exp2f(kdec * 16383.f); }
        else { const int l0 = 32768 - 2 * n; re = (float)hb_[l0] * exp2f(kdec * (float)l0); im = (float)hb_[l0 - 1] * exp2f(kdec * (float)(l0 - 1)); }
        sabs += fabsf(re) + fabsf(im);
        a[fft_pad(n)] = cmk(re, im);
      }
      sabs = wave_sum(sabs); if (lane == 0) red[wid] = sabs;
      __syncthreads();
      float S = 1e-6f;
#pragma unroll
      for (int q = 0; q < 8; ++q) S += red[q];
      const float scale = 1.0f / S;
      _Pragma("unroll 1") for (int b = tid; b < 1024; b += NT) fft_bfly16<false, 16384>(a, b);
      __syncthreads();
      _Pragma("unroll 1") for (int b = tid; b < 1024; b += NT) fft_bfly16<false, 1024>(a, b);
      __syncthreads();
      _Pragma("unroll 1") for (int b = tid; b < 1024; b += NT) fft_bfly16<false, 64>(a, b);
      __syncthreads();
      _Pragma("unroll 1") for (int b = tid; b < 4096; b += NT) fft_bfly4<false>(a, b);
      __syncthreads();
      h16x2* ks = (h16x2*)(ws + OFF_KSPEC) + (size_t)task * FFT_M;
      _Pragma("unroll 1") for (int g = tid; g < 4096; g += NT) fft_filter_group(a, g, scale, [&](int pos, cf v) { h16x2 hv; hv.x = (h16)v.x; hv.y = (h16)v.y; ks[pos] = hv; });
      __syncthreads();
    }
    for (int task = gw; task < 2048; task += ngw) {
      const int o = task >> 10, c = task & 1023;
      const h16* hf_ = (const h16*)(ws + OFF_HCT) + (size_t)((o * 2 + 0) * 1024 + c) * CTX;
      const h16* hb_ = (const h16*)(ws + OFF_HCT) + (size_t)((o * 2 + 1) * 1024 + c) * CTX;
      const float adl = 3.0701134573253945f + (15.350567286626973f - 3.0701134573253945f) * (float)c * (1.f / 1023.f);
      const float kdec = -adl * (1.f / 255.f) * 1.4426950408889634f;
      float f[4], b[4], s = 0.f;
#pragma unroll
      for (int i = 0; i < 4; ++i) { const int l = lane + 64 * i; const float d = exp2f(kdec * (float)l); f[i] = (float)hf_[l] * d; b[i] = (float)hb_[l] * d; s += fabsf(f[i]) + (l > 0 ? fabsf(b[i]) : 0.f); }
      const float inv = 1.f / (wave_sum(s) + 1e-6f);
      float* kc = (float*)(ws + OFF_KCTX) + (size_t)task * 512;
#pragma unroll
      for (int i = 0; i < 4; ++i) { const int l = lane + 64 * i; kc[l] = f[i] * inv; if (l > 0) kc[512 - l] = b[i] * inv; else kc[256] = 0.f; }
    }
  }
#endif
  grid.sync();
#if (PH_MASK >> 3) & 1
  {
    LAS cf* a = (LAS cf*)lds;
    const float* cw = p.in[I_HCW]; const float* cb = p.in[I_HCB]; const float* skip = p.in[I_HSKIP];
    for (int c = bid; c < 1024; c += G) {
      const h16* uv = (const h16*)(ws + OFF_UT) + (size_t)c * SEQ;
      const h16* u1 = (const h16*)(ws + OFF_UT) + (size_t)(1024 + c) * SEQ;
      const h16* u2 = (const h16*)(ws + OFF_UT) + (size_t)(2048 + c) * SEQ;
#define SCONV(u, cc, n, r0, r1) do { const h16x2 mid = *(const h16x2*)((u) + 2 * (n)); const float um = (n) > 0 ? (float)(u)[2 * (n) - 1] : 0.f; const float up = (n) < 8191 ? (float)(u)[2 * (n) + 2] : 0.f; \
        const float w0 = cw[cc], w1 = cw[3072 + (cc)], w2 = cw[6144 + (cc)], b_ = cb[cc]; \
        r0 = b_ + w0 * um + w1 * (float)mid.x + w2 * (float)mid.y; r1 = b_ + w0 * (float)mid.x + w1 * (float)mid.y + w2 * up; } while (0)
      _Pragma("unroll 2") for (int n = tid; n < 8192; n += NT) { float z0, z1; SCONV(uv, c, n, z0, z1); a[fft_pad(n)] = cmk(z0, z1); a[fft_pad(n + 8192)] = cmk(0.f, 0.f); }
      __syncthreads();
      cf* zkeep = (cf*)(ws + OFF_HX) + (size_t)bid * 8192;
#pragma unroll 1
      for (int o = 0; o < 2; ++o) {
        _Pragma("unroll 1") for (int b = tid; b < 1024; b += NT) fft_bfly16<false, 16384>(a, b);
        __syncthreads();
        _Pragma("unroll 1") for (int b = tid; b < 1024; b += NT) fft_bfly16<false, 1024>(a, b);
        __syncthreads();
        _Pragma("unroll 1") for (int b = tid; b < 1024; b += NT) fft_bfly16<false, 64>(a, b);
        __syncthreads();
        _Pragma("unroll 1") for (int b = tid; b < 4096; b += NT) fft_bfly4<false>(a, b);
        __syncthreads();
        const h16x2* ks = (const h16x2*)(ws + OFF_KSPEC) + (size_t)(o * 1024 + c) * FFT_M;
        _Pragma("unroll 1") for (int g = tid; g < 4096; g += NT) fft_conv_group(a, g, [&](int pos) { const h16x2 hv = ks[pos]; return cmk((float)hv.x * (1.0f / FFT_M), (float)hv.y * (1.0f / FFT_M)); });
        __syncthreads();
        _Pragma("unroll 1") for (int b = tid; b < 4096; b += NT) fft_bfly4<true>(a, b);
        __syncthreads();
        _Pragma("unroll 1") for (int b = tid; b < 1024; b += NT) fft_bfly16<true, 64>(a, b);
        __syncthreads();
        _Pragma("unroll 1") for (int b = tid; b < 1024; b += NT) fft_bfly16<true, 1024>(a, b);
        __syncthreads();
        _Pragma("unroll 1") for (int b = tid; b < 1024; b += NT) fft_bfly16<true, 16384>(a, b);
        __syncthreads();
        if (o == 0) {
          const float sk = skip[c];
          _Pragma("unroll 2") for (int n = tid; n < 8192; n += NT) { float z0, z1, g0, g1; SCONV(uv, c, n, z0, z1); SCONV(u1, 1024 + c, n, g0, g1);
            cf y = a[fft_pad(n)]; DIAG_Y(y); const cf v = cmk(g0 * (y.x + sk * z0), g1 * (y.y + sk * z1)); zkeep[n] = v; a[fft_pad(n)] = v; a[fft_pad(n + 8192)] = cmk(0.f, 0.f); }
        } else {
          const float sk = skip[1024 + c];
          bf16_t* zo = (bf16_t*)(ws + OFF_Z2T) + (size_t)c * SEQ;
          _Pragma("unroll 2") for (int n = tid; n < 8192; n += NT) { float g0, g1; SCONV(u2, 2048 + c, n, g0, g1);
            cf y = a[fft_pad(n)]; DIAG_Y(y); const cf zz = zkeep[n]; ((unsigned*)zo)[n] = pk2(g0 * (y.x + sk * zz.x), g1 * (y.y + sk * zz.y)); }
        }
        __syncthreads();
      }
    }
    LAS float* sf = (LAS float*)lds;
    for (int c = bid; c < 1024; c += G) {
      const h16* ub = (const h16*)(ws + OFF_UCT);
      sf[tid] = ((const float*)(ws + OFF_KCTX))[(size_t)c * 512 + tid]; sf[512 + tid] = ((const float*)(ws + OFF_KCTX))[(size_t)(1024 + c) * 512 + tid];
      if (tid < 256) {
#pragma unroll
        for (int s = 0; s < 3; ++s) { const int cc = s * 1024 + c; const h16* u = ub + (size_t)cc * CTX; const float um = tid > 0 ? (float)u[tid - 1] : 0.f, u0 = (float)u[tid], up = tid < 255 ? (float)u[tid + 1] : 0.f;
          sf[1024 + s * 256 + tid] = cb[cc] + cw[cc] * um + cw[3072 + cc] * u0 + cw[6144 + cc] * up; }
      }
      __syncthreads();
      const int t = tid & 255, part = tid >> 8;
#pragma unroll 1
      for (int o = 0; o < 2; ++o) {
        float s = 0.f;
        for (int q = part * 128; q < part * 128 + 128; ++q) s += sf[o * 512 + ((t - q) & 511)] * sf[1024 + q];
        sf[1792 + tid] = s;
        __syncthreads();
        float znew = 0.f;
        if (tid < 256) { const float y = sf[1792 + tid] + sf[1792 + 256 + tid]; znew = sf[1280 + o * 256 + tid] * (y + skip[o * 1024 + c] * sf[1024 + tid]); }
        __syncthreads();
        if (tid < 256) sf[1024 + tid] = znew;
        __syncthreads();
      }
      if (tid < 256) ((bf16_t*)(ws + OFF_ZC2T))[(size_t)c * CTX + tid] = (bf16_t)f2bf(sf[1024 + tid]);
      __syncthreads();
    }
  }
#endif
  grid.sync();
#if (PH_MASK >> 4) & 1
  {
    LAS bf16_t* tl = (LAS bf16_t*)lds;
    for (int tile = bid; tile < 4096 + 64; tile += G) {
      const bool isx = tile < 4096; const int tt = isx ? tile : tile - 4096;
      const int ld = isx ? SEQ : CTX; const int ntt = ld / 64;
      const int cb_ = tt / ntt, tb = tt % ntt;
      const bf16_t* src = isx ? (const bf16_t*)(ws + OFF_Z2T) : (const bf16_t*)(ws + OFF_ZC2T);
      bf16_t* dst = isx ? (bf16_t*)(ws + OFF_HX) : (bf16_t*)(ws + OFF_ZC2);
      { const int r = tid >> 3, ch = tid & 7; const u32x4 v = *(const u32x4*)(src + (size_t)(cb_ * 64 + r) * ld + tb * 64 + ch * 8); *(LAS u32x4*)(tl + r * 72 + ch * 8) = v; }
      __syncthreads();
      { const int t = tid >> 3, ch = tid & 7; unsigned short e[8];
#pragma unroll
        for (int i = 0; i < 8; ++i) e[i] = tl[(ch * 8 + i) * 72 + t];
        u32x4 o; o.x = e[0] | ((unsigned)e[1] << 16); o.y = e[2] | ((unsigned)e[3] << 16); o.z = e[4] | ((unsigned)e[5] << 16); o.w = e[6] | ((unsigned)e[7] << 16);
        *(u32x4*)(dst + (size_t)(tb * 64 + t) * 1024 + cb_ * 64 + ch * 8) = o; }
      __syncthreads();
    }
    convert_moe(p.in[I_WG], p.in[I_WU], p.in[I_WDN], (bf16_t*)(ws + OFF_WGU), (bf16_t*)(ws + OFF_WD), gw, ngw, lf + wid * (64 * 33), lane);
  }
#endif
  grid.sync();
#if (PH_MASK >> 5) & 1
  {
    for (int tile = bid; tile < 256 + 4; tile += G) {
      const bool isx = tile < 256; const int tt = isx ? tile : tile - 256;
      const int pm = isx ? tt >> 2 : 0, pn = tt & 3;
      const bf16_t* A = isx ? (const bf16_t*)(ws + OFF_HX) + (size_t)pm * 256 * 1024 : (const bf16_t*)(ws + OFF_ZC2);
      const bf16_t* B = (const bf16_t*)(ws + OFF_WHO) + (size_t)pn * 256 * 1024;
      const float* xin = isx ? p.in[I_X] : p.in[I_CTX]; float* xo = isx ? p.out : (float*)(ws + OFF_CTXMID);
      const float* gate = MODP(0, isx ? 0 : 1, 2); const float* bo = p.in[I_HBOUT];
      gemm_tile(lds, A, B, 1024, [](int r) { return r * 1024; }, [](int r) { return r * 1024; },
        [&](f32x4 (&acc)[8][4], int wr, int wc, int fr, int fq) {
          const int col0 = pn * 256 + wc * 64 + fr;
          float gt[4], bb[4];
#pragma unroll
          for (int n = 0; n < 4; ++n) { gt[n] = gate[col0 + n * 16]; bb[n] = bo[col0 + n * 16]; }
#pragma unroll
          for (int m = 0; m < 8; ++m) {
            int r0 = pm * 256 + wr * 128 + m * 16 + fq * 4; EPI_FENCE(r0);
            const size_t base = (size_t)r0 * 1024 + col0;
#pragma unroll
            for (int j = 0; j < 4; ++j)
#pragma unroll
              for (int n = 0; n < 4; ++n) xo[base + j * 1024 + n * 16] = xin[base + j * 1024 + n * 16] + gt[n] * (acc[m][n][j] + bb[n]);
          }
        });
    }
  }
#endif
  grid.sync();

#ifdef DIAG_C
  {
    unsigned* cnt = (unsigned*)(ws + OFF_AFF);
    if (bid == 0 && tid == 0) { cnt[0] = 0u; cnt[1] = 0u; }
    grid.sync();
    const unsigned gid = bid * NT + tid; unsigned hsh = gid * 2654435761u + 12345u; hsh ^= hsh >> 13; hsh *= 0x5bd1e995u; hsh ^= hsh >> 15;
    const int ch = hsh % 1024u, tok = (hsh >> 12) % 16384u, n1 = (hsh >> 5) % 1024u;
    int bad = 0;
    const h16* UTp = (const h16*)(ws + OFF_UT); const float* cw = p.in[I_HCW]; const float* cb = p.in[I_HCB]; const float* skip = p.in[I_HSKIP];
    auto sc = [&](int cc, int t) { const h16* u = UTp + (size_t)cc * SEQ; const float um = t > 0 ? (float)u[t - 1] : 0.f, u0 = (float)u[t], up = t < SEQ - 1 ? (float)u[t + 1] : 0.f; return cb[cc] + cw[cc] * um + cw[3072 + cc] * u0 + cw[6144 + cc] * up; };
    { const float v = sc(ch, tok), g1 = sc(1024 + ch, tok), g2 = sc(2048 + ch, tok); const float r = g2 * (skip[1024 + ch] * (g1 * (skip[ch] * v)));
      const float got = bf2f(((const bf16_t*)(ws + OFF_Z2T))[(size_t)ch * SEQ + tok]); if (!(fabsf(got - r) <= 0.01f + 0.02f * fabsf(r))) bad |= DIAG_C & 1;
      const float got2 = bf2f(((const bf16_t*)(ws + OFF_HX))[(size_t)tok * 1024 + ch]); if (got2 != got) bad |= DIAG_C & 2; }
    { float acc = 0.f; const bf16_t* zr = (const bf16_t*)(ws + OFF_HX) + (size_t)tok * 1024; const bf16_t* wr_ = (const bf16_t*)(ws + OFF_WHO) + (size_t)n1 * 1024;
      for (int q = 0; q < 1024; ++q) acc += bf2f(zr[q]) * bf2f(wr_[q]);
      const float r = p.in[I_X][(size_t)tok * 1024 + n1] + mods[2 * 1024 + n1] * (acc + p.in[I_HBOUT][n1]);
      const float got = p.out[(size_t)tok * 1024 + n1]; if (!(fabsf(got - r) <= 0.005f + 0.005f * fabsf(r))) bad |= DIAG_C & 4; }
    if (bad) atomicAdd(&cnt[0], 1u);
    grid.sync();
    const float f = (float)cnt[0] / (float)(G * NT); const float e = sqrtf(f);
    for (size_t i = (size_t)gid; i < (size_t)SEQ * 1024; i += (size_t)G * NT) p.out[i] = p.in[I_X][i] * (1.f + e);
    return;
  }
#endif
#if STOP_STAGE <= 5
  return;
#endif
  auto phase_router = [&](int layer, int nrows) {
    for (int i = tid; i < 16384; i += NT) lf[i] = p.in[I_ROUTER][(size_t)layer * 16384 + i];
    __syncthreads();
    const float* gn = p.in[I_NFFN] + layer * 1024;
    for (int row = gw; row < nrows; row += ngw) {
      const bool isx = row < SEQ; const int r = isx ? row : row - SEQ; const int set = isx ? 0 : 1;
      const float* xr = isx ? p.out + (size_t)r * 1024 : (const float*)(ws + OFF_CTXMID) + (size_t)r * 1024;
      bf16_t* o = isx ? (bf16_t*)(ws + OFF_HX) + (size_t)r * 1024 : (bf16_t*)(ws + OFF_HC) + (size_t)r * 1024;
      const float* sh = MODP(layer, set, 3); const float* sc = MODP(layer, set, 4);
      const float rstd = norm_mod_row(xr, gn, sh, sc, o, lane);
      float lg[16];
#pragma unroll
      for (int e = 0; e < 16; ++e) lg[e] = 0.f;
#pragma unroll 4
      for (int m = 0; m < 16; ++m) {
        const int k = lane + 64 * m; const float h = xr[k] * rstd * gn[k] * (1.f + sc[k]) + sh[k];
        const LAS f32x4* wp = (const LAS f32x4*)(lf + k * 16);
        const f32x4 w0 = wp[0], w1 = wp[1], w2 = wp[2], w3 = wp[3];
        lg[0] += h * w0.x; lg[1] += h * w0.y; lg[2] += h * w0.z; lg[3] += h * w0.w; lg[4] += h * w1.x; lg[5] += h * w1.y; lg[6] += h * w1.z; lg[7] += h * w1.w;
        lg[8] += h * w2.x; lg[9] += h * w2.y; lg[10] += h * w2.z; lg[11] += h * w2.w; lg[12] += h * w3.x; lg[13] += h * w3.y; lg[14] += h * w3.z; lg[15] += h * w3.w;
      }
      float mxv = -1e30f;
#pragma unroll
      for (int e = 0; e < 16; ++e) { lg[e] = wave_sum(lg[e]); mxv = fmaxf(mxv, lg[e]); }
      float den = 0.f, mine = 0.f;
#pragma unroll
      for (int e = 0; e < 16; ++e) { const float ex = __expf(lg[e] - mxv); den += ex; if (lane == e) mine = ex; }
      if (lane < 16) ((float*)(ws + OFF_AFF))[(size_t)row * 16 + lane] = mine / den;
    }
    __syncthreads();
  };
  auto phase_topk = [&](int ntasks) {
    for (int task = bid; task < ntasks; task += G) {
      const int set = task >> 4, e = task & 15;
      int* si = (int*)(ws + OFF_SELI) + (size_t)task * 2048; float* sg = (float*)(ws + OFF_SELG) + (size_t)task * 2048;
      if (set == 0) topk_block<32>(lds, (const float*)(ws + OFF_AFF), e, SEQ, 2048, si, sg, (int*)(ws + OFF_SLOT));
      else topk_block<1>(lds, (const float*)(ws + OFF_AFF) + (size_t)SEQ * 16, e, CTX, 32, si, sg, (int*)(ws + OFF_SLOT) + (size_t)SEQ * 16);
    }
  };
  auto phase_gateup = [&](int ntiles) {
    for (int tile = bid; tile < ntiles; tile += G) {
      const bool isx = tile < 1024; const int tt = isx ? tile : tile - 1024;
      const int e = isx ? tt >> 6 : tt >> 3, pn = isx ? (tt >> 3) & 7 : tt & 7, pm = isx ? tt & 7 : 0;
      const bf16_t* A = isx ? (const bf16_t*)(ws + OFF_HX) : (const bf16_t*)(ws + OFF_HC);
      const bf16_t* B = (const bf16_t*)(ws + OFF_WGU) + ((size_t)e * 2048 + pn * 256) * 1024;
      const int* si = (const int*)(ws + OFF_SELI) + (size_t)((isx ? 0 : 16) + e) * 2048;
      bf16_t* act = isx ? (bf16_t*)(ws + OFF_ACT) + ((size_t)e * 2048 + pm * 256) * 1024 : (bf16_t*)(ws + OFF_ACTC) + (size_t)e * 256 * 1024;
      const int rmask = isx ? 255 : 31;
      gemm_tile(lds, A, B, 1024, [&](int r) { return si[pm * 256 + (r & rmask)] * 1024; }, [](int r) { return r * 1024; },
        [&](f32x4 (&acc)[8][4], int wr, int wc, int fr, int fq) {
#pragma unroll
          for (int m = 0; m < 8; ++m) {
            int r0 = wr * 128 + m * 16 + fq * 4; EPI_FENCE(r0);
            bf16_t* rp = act + (size_t)r0 * 1024 + pn * 128 + wc * 32 + fr;
#pragma unroll
            for (int j = 0; j < 4; ++j)
#pragma unroll
              for (int n = 0; n < 2; ++n) { const float gv = acc[m][n][j], uv_ = acc[m][n + 2][j]; rp[(size_t)j * 1024 + n * 16] = (bf16_t)f2bf(gv / (1.f + __expf(-gv)) * uv_); }
          }
        });
    }
  };
  auto phase_down = [&](int ntiles) {
    for (int tile = bid; tile < ntiles; tile += G) {
      const bool isx = tile < 512; const int tt = isx ? tile : tile - 512;
      const int e = isx ? tt >> 5 : tt >> 2, pn = isx ? (tt >> 3) & 3 : tt & 3, pm = isx ? tt & 7 : 0;
      const bf16_t* A = isx ? (const bf16_t*)(ws + OFF_ACT) + ((size_t)e * 2048 + pm * 256) * 1024 : (const bf16_t*)(ws + OFF_ACTC) + (size_t)e * 256 * 1024;
      const bf16_t* B = (const bf16_t*)(ws + OFF_WD) + ((size_t)e * 1024 + pn * 256) * 1024;
      const float* sg = (const float*)(ws + OFF_SELG) + (size_t)((isx ? 0 : 16) + e) * 2048 + pm * 256;
      bf16_t* yb = isx ? (bf16_t*)(ws + OFF_YB) + ((size_t)e * 2048 + pm * 256) * 1024 : (bf16_t*)(ws + OFF_YBC) + (size_t)e * 256 * 1024;
      const int rmask = isx ? 255 : 31;
      gemm_tile(lds, A, B, 1024, [](int r) { return r * 1024; }, [](int r) { return r * 1024; },
        [&](f32x4 (&acc)[8][4], int wr, int wc, int fr, int fq) {
#pragma unroll
          for (int m = 0; m < 8; ++m) {
            int r0 = wr * 128 + m * 16 + fq * 4; EPI_FENCE(r0);
            bf16_t* rp = yb + (size_t)r0 * 1024 + pn * 256 + wc * 64 + fr;
#pragma unroll
            for (int j = 0; j < 4; ++j) { const float g = sg[(r0 + j) & rmask];
#pragma unroll
              for (int n = 0; n < 4; ++n) rp[(size_t)j * 1024 + n * 16] = (bf16_t)f2bf(acc[m][n][j] * g); }
          }
        });
    }
  };
  auto phase_combine = [&](int layer, int nrows, float* xdst, bool next_norm) {
    for (int row = gw; row < nrows; row += ngw) {
      const bool isx = row < SEQ; const int r = isx ? row : row - SEQ; const int set = isx ? 0 : 1;
      const float* xr = isx ? p.out + (size_t)r * 1024 : (const float*)(ws + OFF_CTXMID) + (size_t)r * 1024;
      const bf16_t* yb = isx ? (const bf16_t*)(ws + OFF_YB) : (const bf16_t*)(ws + OFF_YBC); const int capp = isx ? 2048 : 256;
      const int* so = (const int*)(ws + OFF_SLOT) + (size_t)row * 16;
      f32x4 a[4];
#pragma unroll
      for (int j = 0; j < 4; ++j) a[j] = (f32x4){0.f, 0.f, 0.f, 0.f};
#pragma unroll 1
      for (int e = 0; e < 16; ++e) {
        const int s = so[e];
        if (s >= 0) { const u32x2* yr = (const u32x2*)(yb + ((size_t)e * capp + s) * 1024);
#pragma unroll
          for (int j = 0; j < 4; ++j) { const u32x2 w = yr[lane + 64 * j]; a[j].x += bf2f(w.x & 0xffffu); a[j].y += bf2f(w.x >> 16); a[j].z += bf2f(w.y & 0xffffu); a[j].w += bf2f(w.y >> 16); } }
      }
      const float* g5 = MODP(layer, set, 5);
      f32x4 v[4];
#pragma unroll
      for (int j = 0; j < 4; ++j) v[j] = ((const f32x4*)xr)[lane + 64 * j] + ((const f32x4*)g5)[lane + 64 * j] * a[j];
      if (isx) {
#pragma unroll
        for (int j = 0; j < 4; ++j) ((f32x4*)(xdst + (size_t)r * 1024))[lane + 64 * j] = v[j];
      }
      if (next_norm) {
        bf16_t* o = isx ? (bf16_t*)(ws + OFF_HX) + (size_t)r * 1024 : (bf16_t*)(ws + OFF_HC) + (size_t)r * 1024;
        norm_mod_regs(v, p.in[I_NMIX] + 1024, MODP(1, set, 0), MODP(1, set, 1), o, lane);
      }
    }
  };

  phase_router(0, NKEY);
  grid.sync();
  phase_topk(32);
  grid.sync();
  phase_gateup(1024 + 128);
  grid.sync();
  phase_down(512 + 64);
  grid.sync();
  phase_combine(0, NKEY, (float*)(ws + OFF_X1), true);
  convert_moe(p.in[I_WG] + (size_t)16 * 1024 * 1024, p.in[I_WU] + (size_t)16 * 1024 * 1024, p.in[I_WDN] + (size_t)16 * 1024 * 1024, (bf16_t*)(ws + OFF_WGU), (bf16_t*)(ws + OFF_WD), gw, ngw, lf + wid * (64 * 33), lane);
  grid.sync();
#if STOP_STAGE <= 10
  { const size_t gid = (size_t)bid * NT + tid; for (size_t i = gid; i < (size_t)SEQ * 256; i += (size_t)G * NT) ((f32x4*)p.out)[i] = ((const f32x4*)(ws + OFF_X1))[i]; }
  return;
#endif
  {
    for (int tile = bid; tile < 768 + 8; tile += G) {
      const bool isx = tile < 768; const int tt = isx ? tile : tile - 768;
      const int pm = isx ? tt / 12 : 0, pn = isx ? tt % 12 : 4 + tt;
      const bf16_t* A = isx ? (const bf16_t*)(ws + OFF_HX) + (size_t)pm * 256 * 1024 : (const bf16_t*)(ws + OFF_HC);
      const bf16_t* B = (const bf16_t*)(ws + OFF_WQKV) + (size_t)pn * 256 * 1024;
      const int trow0 = isx ? 256 + pm * 256 : 0;
      bf16_t* Qb = (bf16_t*)(ws + OFF_Q); bf16_t* Kb = (bf16_t*)(ws + OFF_KALL); bf16_t* Vb = (bf16_t*)(ws + OFF_VT);
      gemm_tile(lds, A, B, 1024, [](int r) { return r * 1024; }, [](int r) { return r * 1024; },
        [&](f32x4 (&acc)[8][4], int wr, int wc, int fr, int fq) {
          if (pn < 8) {
            bf16_t* base = pn < 4 ? Qb + (size_t)(pm * 256) * 1024 + pn * 256 : Kb + (size_t)trow0 * 1024 + (pn - 4) * 256;
#pragma unroll
            for (int m = 0; m < 8; ++m) {
              int r0 = wr * 128 + m * 16 + fq * 4; EPI_FENCE(r0);
              bf16_t* rp = base + (size_t)r0 * 1024 + wc * 64 + fr;
#pragma unroll
              for (int j = 0; j < 4; ++j)
#pragma unroll
                for (int n = 0; n < 4; ++n) rp[(size_t)j * 1024 + n * 16] = (bf16_t)f2bf(acc[m][n][j]);
            }
          } else {
#pragma unroll
            for (int n = 0; n < 4; ++n) {
              int col = (pn - 8) * 256 + wc * 64 + n * 16 + fr; EPI_FENCE(col);
              bf16_t* cp = Vb + (size_t)col * NKEY + trow0 + wr * 128 + fq * 4;
#pragma unroll
              for (int m = 0; m < 8; ++m) { u32x2 w; w.x = pk2(acc[m][n][0], acc[m][n][1]); w.y = pk2(acc[m][n][2], acc[m][n][3]); *(u32x2*)(cp + m * 16) = w; }
            }
          }
        });
    }
  }
  grid.sync();
  {
    const f32x2* rope = (const f32x2*)(ws + OFF_ROPE);
    for (int row = gw; row < SEQ + NKEY; row += ngw) {
      const bool isq = row < SEQ; const int t = isq ? row : row - SEQ;
      bf16_t* ptr = (isq ? (bf16_t*)(ws + OFF_Q) : (bf16_t*)(ws + OFF_KALL)) + (size_t)t * 1024 + lane * 16;
      const int post = isq ? t : t - 256; const bool dorope = isq || t >= 256;
      const float* gn = isq ? p.in[I_DQN] : p.in[I_DKN];
      const int qd = lane & 3;
      const u32x4 w0 = ((const u32x4*)ptr)[0], w1 = ((const u32x4*)ptr)[1];
      float v[16];
      v[0] = bf2f(w0.x & 0xffffu); v[1] = bf2f(w0.x >> 16); v[2] = bf2f(w0.y & 0xffffu); v[3] = bf2f(w0.y >> 16); v[4] = bf2f(w0.z & 0xffffu); v[5] = bf2f(w0.z >> 16); v[6] = bf2f(w0.w & 0xffffu); v[7] = bf2f(w0.w >> 16);
      v[8] = bf2f(w1.x & 0xffffu); v[9] = bf2f(w1.x >> 16); v[10] = bf2f(w1.y & 0xffffu); v[11] = bf2f(w1.y >> 16); v[12] = bf2f(w1.z & 0xffffu); v[13] = bf2f(w1.z >> 16); v[14] = bf2f(w1.w & 0xffffu); v[15] = bf2f(w1.w >> 16);
      float ss = 0.f;
#pragma unroll
      for (int i = 0; i < 16; ++i) ss += v[i] * v[i];
      ss += __shfl_xor(ss, 1); ss += __shfl_xor(ss, 2);
      const float rstd = 1.0f / sqrtf(ss * (1.f / 64.f) + 1e-6f);
#pragma unroll
      for (int i = 0; i < 16; ++i) v[i] = v[i] * rstd * gn[qd * 16 + i];
      if (dorope) {
        const int pos = (qd < 2) ? (post >> 6) : (post & 63);
#pragma unroll
        for (int i = 0; i < 16; ++i) { const f32x2 cs = rope[pos * 16 + i]; const float other = __shfl_xor(v[i], 1); v[i] = (qd & 1) ? v[i] * cs.x + other * cs.y : v[i] * cs.x - other * cs.y; }
      }
      const float qs = isq ? 0.125f * 1.4426950408889634f : 1.f;
      u32x4 o0, o1;
      o0.x = pk2(v[0] * qs, v[1] * qs); o0.y = pk2(v[2] * qs, v[3] * qs); o0.z = pk2(v[4] * qs, v[5] * qs); o0.w = pk2(v[6] * qs, v[7] * qs);
      o1.x = pk2(v[8] * qs, v[9] * qs); o1.y = pk2(v[10] * qs, v[11] * qs); o1.z = pk2(v[12] * qs, v[13] * qs); o1.w = pk2(v[14] * qs, v[15] * qs);
      ((u32x4*)ptr)[0] = o0; ((u32x4*)ptr)[1] = o1;
    }
  }
  grid.sync();
  {
    constexpr int KB_B = 64 * 144, VB_B = 128 * 136, BUF_B = KB_B + VB_B;
    const int r32 = lane & 31, hi = lane >> 5;
    const bf16_t* Qg = (const bf16_t*)(ws + OFF_Q); const bf16_t* Kg = (const bf16_t*)(ws + OFF_KALL); const bf16_t* Vg = (const bf16_t*)(ws + OFF_VT);
    float* Og = (float*)(ws + OFF_O);
    const int krow = tid >> 3, kch = tid & 7;
    constexpr int NKT = NKEY / 64;
    for (int unit = bid; unit < 1024; unit += G) {
      const int c = unit >> 6, qb = unit & 63, vh = c >> 1;
      const bf16_t* Qp = Qg + (size_t)(qb * 256 + wid * 32 + r32) * 1024 + c * 64 + hi * 8;
      bf16x8 qf[4];
#pragma unroll
      for (int s = 0; s < 4; ++s) qf[s] = *(const bf16x8*)(Qp + 16 * s);
      f32x16 o[4];
#pragma unroll
      for (int eb = 0; eb < 4; ++eb)
#pragma unroll
        for (int r = 0; r < 16; ++r) o[eb][r] = 0.f;
      float mrun = -1e30f, lrun = 0.f;
      const bf16_t* kg = Kg + (size_t)krow * 1024 + c * 64 + kch * 8;
      const bf16_t* vg0 = Vg + (size_t)(vh * 128 + krow) * NKEY + kch * 8;
      const bf16_t* vg1 = vg0 + (size_t)64 * NKEY;
      u32x4 kreg = *(const u32x4*)kg, v0reg = *(const u32x4*)vg0, v1reg = *(const u32x4*)vg1;
      { ldsp kb_ = lds, vb_ = lds + KB_B;
        *(LAS u32x4*)(kb_ + krow * 144 + kch * 16) = kreg;
        *(LAS u32x2*)(vb_ + krow * 136 + kch * 16) = (u32x2){v0reg.x, v0reg.y}; *(LAS u32x2*)(vb_ + krow * 136 + kch * 16 + 8) = (u32x2){v0reg.z, v0reg.w};
        *(LAS u32x2*)(vb_ + (krow + 64) * 136 + kch * 16) = (u32x2){v1reg.x, v1reg.y}; *(LAS u32x2*)(vb_ + (krow + 64) * 136 + kch * 16 + 8) = (u32x2){v1reg.z, v1reg.w}; }
      __syncthreads();
#pragma unroll 1
      for (int kt = 0; kt < NKT; ++kt) {
        const bool more = kt + 1 < NKT;
        if (more) { kreg = *(const u32x4*)(kg + (size_t)(kt + 1) * 64 * 1024); v0reg = *(const u32x4*)(vg0 + (kt + 1) * 64); v1reg = *(const u32x4*)(vg1 + (kt + 1) * 64); }
        ldsp kb_ = lds + (kt & 1) * BUF_B, vb_ = kb_ + KB_B;
        f32x16 p0, p1;
#pragma unroll
        for (int r = 0; r < 16; ++r) { p0[r] = 0.f; p1[r] = 0.f; }
#pragma unroll
        for (int s = 0; s < 4; ++s) {
          const bf16x8 k0 = *(const LAS bf16x8*)(kb_ + r32 * 144 + (16 * s + 8 * hi) * 2);
          const bf16x8 k1 = *(const LAS bf16x8*)(kb_ + (32 + r32) * 144 + (16 * s + 8 * hi) * 2);
          p0 = __builtin_amdgcn_mfma_f32_32x32x16_bf16(k0, qf[s], p0, 0, 0, 0);
          p1 = __builtin_amdgcn_mfma_f32_32x32x16_bf16(k1, qf[s], p1, 0, 0, 0);
        }
        float mx = fmaxf(p0[0], p1[0]);
#pragma unroll
        for (int r = 1; r < 16; ++r) mx = fmaxf(mx, fmaxf(p0[r], p1[r]));
        mx = fmaxf(mx, __shfl_xor(mx, 32));
        const float mnew = fmaxf(mrun, mx); const float alpha = exp2f(mrun - mnew); mrun = mnew;
        float ls = 0.f;
#pragma unroll
        for (int r = 0; r < 16; ++r) { p0[r] = exp2f(p0[r] - mnew); p1[r] = exp2f(p1[r] - mnew); ls += p0[r] + p1[r]; }
        lrun = lrun * alpha + ls;
#pragma unroll
        for (int eb = 0; eb < 4; ++eb)
#pragma unroll
          for (int r = 0; r < 16; ++r) o[eb][r] *= alpha;
        bf16x8 pf[2][2];
#pragma unroll
        for (int s2 = 0; s2 < 2; ++s2) {
          u32x4 a0, a1;
          a0.x = pk2(p0[8 * s2 + 0], p0[8 * s2 + 1]); a0.y = pk2(p0[8 * s2 + 2], p0[8 * s2 + 3]); a0.z = pk2(p0[8 * s2 + 4], p0[8 * s2 + 5]); a0.w = pk2(p0[8 * s2 + 6], p0[8 * s2 + 7]);
          a1.x = pk2(p1[8 * s2 + 0], p1[8 * s2 + 1]); a1.y = pk2(p1[8 * s2 + 2], p1[8 * s2 + 3]); a1.z = pk2(p1[8 * s2 + 4], p1[8 * s2 + 5]); a1.w = pk2(p1[8 * s2 + 6], p1[8 * s2 + 7]);
          pf[0][s2] = __builtin_bit_cast(bf16x8, a0); pf[1][s2] = __builtin_bit_cast(bf16x8, a1);
        }
#pragma unroll
        for (int eb = 0; eb < 4; ++eb)
#pragma unroll
          for (int kb2 = 0; kb2 < 2; ++kb2)
#pragma unroll
            for (int s2 = 0; s2 < 2; ++s2) {
              ldsp ap = vb_ + (eb * 32 + r32) * 136 + (kb2 * 32 + 16 * s2 + 4 * hi) * 2;
              const s16x4 lo = *(const LAS s16x4*)ap, hi4 = *(const LAS s16x4*)(ap + 16);
              const bf16x8 vf = (bf16x8){lo[0], lo[1], lo[2], lo[3], hi4[0], hi4[1], hi4[2], hi4[3]};
              o[eb] = __builtin_amdgcn_mfma_f32_32x32x16_bf16(vf, pf[kb2][s2], o[eb], 0, 0, 0);
            }
        if (more) { ldsp kn = lds + ((kt + 1) & 1) * BUF_B, vn = kn + KB_B;
          *(LAS u32x4*)(kn + krow * 144 + kch * 16) = kreg;
          *(LAS u32x2*)(vn + krow * 136 + kch * 16) = (u32x2){v0reg.x, v0reg.y}; *(LAS u32x2*)(vn + krow * 136 + kch * 16 + 8) = (u32x2){v0reg.z, v0reg.w};
          *(LAS u32x2*)(vn + (krow + 64) * 136 + kch * 16) = (u32x2){v1reg.x, v1reg.y}; *(LAS u32x2*)(vn + (krow + 64) * 136 + kch * 16 + 8) = (u32x2){v1reg.z, v1reg.w}; }
        __syncthreads();
      }
      const float inv = 1.f / (lrun + __shfl_xor(lrun, 32));
      float* orow = Og + (size_t)(qb * 256 + wid * 32 + r32) * 2048 + c * 128 + 4 * hi;
#pragma unroll
      for (int eb = 0; eb < 4; ++eb)
#pragma unroll
        for (int g4 = 0; g4 < 4; ++g4) *(f32x4*)(orow + eb * 32 + 8 * g4) = (f32x4){o[eb][4 * g4] * inv, o[eb][4 * g4 + 1] * inv, o[eb][4 * g4 + 2] * inv, o[eb][4 * g4 + 3] * inv};
    }
  }
  grid.sync();
  const float lam_init = 0.35550906759096926f;
  {
    const float s1 = wave_sum(p.in[I_LQ1][lane] * p.in[I_LK1][lane]), s2 = wave_sum(p.in[I_LQ2][lane] * p.in[I_LK2][lane]);
    const float lam = expf(s1) - expf(s2) + lam_init;
    const int h = lane >> 3, part = lane & 7;
    const float* Og = (const float*)(ws + OFF_O); const float* sub = p.in[I_SUBLN] + part * 16;
    for (int row = gw; row < SEQ; row += ngw) {
      const f32x4* o1 = (const f32x4*)(Og + (size_t)row * 2048 + (2 * h) * 128 + part * 16); const f32x4* o2 = o1 + 32;
      f32x4 v[4]; float ss = 0.f;
#pragma unroll
      for (int j = 0; j < 4; ++j) { v[j] = o1[j] - lam * o2[j]; ss += v[j].x * v[j].x + v[j].y * v[j].y + v[j].z * v[j].z + v[j].w * v[j].w; }
      ss += __shfl_xor(ss, 1); ss += __shfl_xor(ss, 2); ss += __shfl_xor(ss, 4);
      const float rs = (1.f - lam_init) / sqrtf(ss * (1.f / 128.f) + 1e-5f);
      u32x4 w0, w1;
      { const f32x4 g0 = ((const f32x4*)sub)[0], g1 = ((const f32x4*)sub)[1], g2 = ((const f32x4*)sub)[2], g3 = ((const f32x4*)sub)[3];
        w0.x = pk2(v[0].x * rs * g0.x, v[0].y * rs * g0.y); w0.y = pk2(v[0].z * rs * g0.z, v[0].w * rs * g0.w); w0.z = pk2(v[1].x * rs * g1.x, v[1].y * rs * g1.y); w0.w = pk2(v[1].z * rs * g1.z, v[1].w * rs * g1.w);
        w1.x = pk2(v[2].x * rs * g2.x, v[2].y * rs * g2.y); w1.y = pk2(v[2].z * rs * g2.z, v[2].w * rs * g2.w); w1.z = pk2(v[3].x * rs * g3.x, v[3].y * rs * g3.y); w1.w = pk2(v[3].z * rs * g3.z, v[3].w * rs * g3.w); }
      u32x4* op = (u32x4*)((bf16_t*)(ws + OFF_HX) + (size_t)row * 1024 + h * 128 + part * 16);
      op[0] = w0; op[1] = w1;
    }
  }
  grid.sync();
  {
    for (int tile = bid; tile < 256; tile += G) {
      const int pm = tile >> 2, pn = tile & 3;
      const bf16_t* A = (const bf16_t*)(ws + OFF_HX) + (size_t)pm * 256 * 1024;
      const bf16_t* B = (const bf16_t*)(ws + OFF_WDO) + (size_t)pn * 256 * 1024;
      const float* xin = (const float*)(ws + OFF_X1); float* xo = p.out; const float* gate = MODP(1, 0, 2);
      gemm_tile(lds, A, B, 1024, [](int r) { return r * 1024; }, [](int r) { return r * 1024; },
        [&](f32x4 (&acc)[8][4], int wr, int wc, int fr, int fq) {
          const int col0 = pn * 256 + wc * 64 + fr;
          float gt[4];
#pragma unroll
          for (int n = 0; n < 4; ++n) gt[n] = gate[col0 + n * 16];
#pragma unroll
          for (int m = 0; m < 8; ++m) {
            int r0 = pm * 256 + wr * 128 + m * 16 + fq * 4; EPI_FENCE(r0);
            const size_t base = (size_t)r0 * 1024 + col0;
#pragma unroll
            for (int j = 0; j < 4; ++j)
#pragma unroll
              for (int n = 0; n < 4; ++n) xo[base + j * 1024 + n * 16] = xin[base + j * 1024 + n * 16] + gt[n] * acc[m][n][j];
          }
        });
    }
  }
  grid.sync();
#if STOP_STAGE <= 15
  return;
#endif
  phase_router(1, SEQ);
  grid.sync();
  phase_topk(16);
  grid.sync();
  phase_gateup(1024);
  grid.sync();
  phase_down(512);
  grid.sync();
  phase_combine(1, SEQ, p.out, false);
}

extern "C" void kernel_launch(void* const* d_in, const int* in_sizes, int n_in, void* d_out, int out_size,
                              void* d_ws, size_t ws_size, hipStream_t stream) {
  static int grid_blocks = 0;
  if (!grid_blocks) {
    int dev = 0, cus = 0, per_cu = 0;
    (void)hipGetDevice(&dev);
    (void)hipDeviceGetAttribute(&cus, hipDeviceAttributeMultiprocessorCount, dev);
    (void)hipFuncSetAttribute((const void*)mega, hipFuncAttributeMaxDynamicSharedMemorySize, LDS_BYTES);
    (void)hipOccupancyMaxActiveBlocksPerMultiprocessor(&per_cu, mega, NT, LDS_BYTES);
    if (per_cu < 1) { fprintf(stderr, "occupancy query says %d\n", per_cu); per_cu = 1; }
    grid_blocks = cus * (per_cu > 1 ? 1 : per_cu);
    if (ws_size < WS_END) fprintf(stderr, "kernel_launch: workspace too small: %zu < %zu\n", ws_size, (size_t)WS_END);
  }
  if (ws_size < WS_END || n_in != 36) return;
  Params p{};
  for (int i = 0; i < 36; ++i) p.in[i] = (const float*)d_in[i];
  p.out = (float*)d_out; p.ws = (unsigned char*)d_ws;
  void* args[] = {&p};
  hipError_t e = hipLaunchCooperativeKernel((void*)mega, dim3(grid_blocks), dim3(NT), args, LDS_BYTES, stream);
  if (e != hipSuccess) fprintf(stderr, "cooperative launch failed: %s (grid %d)\n", hipGetErrorString(e), grid_blocks);
}
```

```cpp
#include <hip/hip_runtime.h>
#include <hip/hip_cooperative_groups.h>
#include <cstdio>
#include <cstdint>
namespace cg = cooperative_groups;

#ifndef PH_MASK
#define PH_MASK 0xffffffffu
#endif
#ifndef REP_P2
#define REP_P2 1
#endif
#ifndef REP_P3
#define REP_P3 1
#endif
#ifndef REP_P13
#define REP_P13 1
#endif
#ifndef REP_MOE
#define REP_MOE 1
#endif
#ifdef DIAG_NOCONV
#define DIAG_Y(y) y = cmk(0.f, 0.f)
#else
#define DIAG_Y(y)
#endif
#ifndef STOP_STAGE
#define STOP_STAGE 99
#endif

#define LAS __attribute__((address_space(3)))
typedef LAS unsigned char* ldsp;
typedef unsigned short bf16_t;
typedef short bf16x8 __attribute__((ext_vector_type(8)));
typedef short s16x4 __attribute__((ext_vector_type(4)));
typedef float f32x4 __attribute__((ext_vector_type(4)));
typedef float f32x2 __attribute__((ext_vector_type(2)));
typedef float f32x16 __attribute__((ext_vector_type(16)));
typedef unsigned u32x4 __attribute__((ext_vector_type(4)));
typedef unsigned u32x2 __attribute__((ext_vector_type(2)));
typedef __bf16 bf16x2_t __attribute__((ext_vector_type(2)));
typedef _Float16 h16;
typedef _Float16 h16x2 __attribute__((ext_vector_type(2)));

constexpr int NT = 512;
constexpr int LDS_BYTES = 147456;
constexpr int SEQ = 16384, CTX = 256, DM = 1024, NKEY = SEQ + CTX;
constexpr size_t MiB = 1u << 20;
constexpr size_t OFF_MODS = 0;
constexpr size_t OFF_ROPE = 160 * 1024;
constexpr size_t OFF_HIDX = 1 * MiB;
constexpr size_t OFF_HIDC = 3 * MiB;
constexpr size_t OFF_W4T = 3 * MiB + 512 * 1024;
constexpr size_t OFF_WIN = 4 * MiB;
constexpr size_t OFF_WHO = 10 * MiB;
constexpr size_t OFF_WQKV = 12 * MiB;
constexpr size_t OFF_WDO = 18 * MiB;
constexpr size_t OFF_KCTX = 20 * MiB;
constexpr size_t OFF_AFF = 24 * MiB;
constexpr size_t OFF_SELI = 26 * MiB;
constexpr size_t OFF_SELG = 26 * MiB + 256 * 1024;
constexpr size_t OFF_SLOT = 26 * MiB + 512 * 1024;
constexpr size_t OFF_CTXMID = 28 * MiB;
constexpr size_t OFF_HC = 30 * MiB;
constexpr size_t OFF_UCT = 31 * MiB;
constexpr size_t OFF_HCT = 33 * MiB;
constexpr size_t OFF_ZC2T = 35 * MiB;
constexpr size_t OFF_ZC2 = 35 * MiB + 512 * 1024;
constexpr size_t OFF_ACTC = 36 * MiB;
constexpr size_t OFF_YBC = 44 * MiB;
constexpr size_t OFF_HX = 56 * MiB;
constexpr size_t OFF_HT = 88 * MiB;
constexpr size_t OFF_WGU = 88 * MiB, OFF_WD = 152 * MiB;
constexpr size_t OFF_KSPEC = 216 * MiB;
constexpr size_t OFF_ACT = 216 * MiB, OFF_YB = 280 * MiB, OFF_O = 216 * MiB;
constexpr size_t OFF_UT = 344 * MiB;
constexpr size_t OFF_X1 = 344 * MiB;
constexpr size_t OFF_Q = 408 * MiB;
constexpr size_t OFF_Z2T = 440 * MiB;
constexpr size_t OFF_KALL = 440 * MiB;
constexpr size_t OFF_VT = 473 * MiB;
constexpr size_t WS_END = 506 * MiB;

struct Params { const float* in[36]; float* out; unsigned char* ws; };
enum { I_X = 0, I_C, I_CTX, I_CCTX, I_ADAW, I_ADAB, I_NMIX, I_NFFN, I_HWIN, I_HBIN, I_HCW, I_HCB, I_FW1, I_FB1, I_FW2, I_FB2, I_FW3, I_FB3, I_FW4, I_FFREQ,
       I_HSKIP, I_HWOUT, I_HBOUT, I_DWQKV, I_DQN, I_DKN, I_LQ1, I_LK1, I_LQ2, I_LK2, I_SUBLN, I_DWOUT, I_ROUTER, I_WG, I_WU, I_WDN };

__device__ __forceinline__ unsigned f2bf(float f) { unsigned u = __builtin_bit_cast(unsigned, f); return (u + 0x7fffu + ((u >> 16) & 1u)) >> 16; }
__device__ __forceinline__ float bf2f(unsigned b) { return __builtin_bit_cast(float, b << 16); }
__device__ __forceinline__ unsigned pk2(float lo, float hi) { f32x2 v = {lo, hi}; bf16x2_t b = __builtin_convertvector(v, bf16x2_t); return __builtin_bit_cast(unsigned, b); }
__device__ __forceinline__ float wave_sum(float v) {
#pragma unroll
  for (int o = 1; o < 64; o <<= 1) v += __shfl_xor(v, o);
  return v;
}
__device__ __forceinline__ float siluf(float x) { return x / (1.f + __expf(-x)); }

#define FFT_HD __device__ __forceinline__
#define FFT_LDS LAS
#define EPI_FENCE(v) asm volatile("" : "+v"(v) :: "memory")
#define FFT_OPAQUE(v) asm volatile("" : "+v"(v))
__device__ __forceinline__ float fft_sin_rev(float x) { return __builtin_amdgcn_sinf(x); }
__device__ __forceinline__ float fft_cos_rev(float x) { return __builtin_amdgcn_cosf(x); }
#ifdef FFT_HOST_TEST
struct cf { float x, y; };
FFT_HD cf cmk(float a, float b) { cf r; r.x = a; r.y = b; return r; }
#else
typedef float cf __attribute__((ext_vector_type(2)));
FFT_HD cf cmk(float a, float b) { cf r; r.x = a; r.y = b; return r; }
#endif
FFT_HD cf cadd(cf a, cf b) { return cmk(a.x + b.x, a.y + b.y); }
FFT_HD cf csub(cf a, cf b) { return cmk(a.x - b.x, a.y - b.y); }
FFT_HD cf cmul(cf a, cf b) { return cmk(a.x * b.x - a.y * b.y, a.x * b.y + a.y * b.x); }
FFT_HD cf cconj(cf a) { return cmk(a.x, -a.y); }
constexpr int FFT_M = 16384;
FFT_HD int fft_pad(int i) { return i + ((i >> 6) << 2); }
constexpr int FFT_LDS_ELEMS = FFT_M + (FFT_M >> 6) * 4;

template <bool INV> FFT_HD void dft4(cf& a, cf& b, cf& c, cf& d) {
  cf s0 = cadd(a, c), s1 = csub(a, c), s2 = cadd(b, d), s3 = csub(b, d);
  cf r = INV ? cmk(-s3.y, s3.x) : cmk(s3.y, -s3.x);
  a = cadd(s0, s2); c = csub(s0, s2); b = cadd(s1, r); d = csub(s1, r);
}
template <bool INV> FFT_HD void dft16(cf (&x)[16]) {
#pragma unroll
  for (int n2 = 0; n2 < 4; ++n2) dft4<INV>(x[n2], x[4 + n2], x[8 + n2], x[12 + n2]);
  const float C1 = 0.92387953251128674f, S1 = 0.38268343236508977f, C2 = 0.70710678118654752f;
#define TW(i, cr, ci) x[i] = cmul(x[i], cmk(cr, INV ? -(ci) : (ci)))
  TW(4 + 1, C1, -S1); TW(4 + 2, C2, -C2); TW(4 + 3, S1, -C1);
  TW(8 + 1, C2, -C2); TW(8 + 2, 0.f, -1.f); TW(8 + 3, -C2, -C2);
  TW(12 + 1, S1, -C1); TW(12 + 2, -C2, -C2); TW(12 + 3, -C1, S1);
#undef TW
#pragma unroll
  for (int k1 = 0; k1 < 4; ++k1) dft4<INV>(x[4 * k1], x[4 * k1 + 1], x[4 * k1 + 2], x[4 * k1 + 3]);
}
template <bool INV, int NP> FFT_HD void fft_bfly16(FFT_LDS cf* a, int b) {
  constexpr int S = NP / 16;
  FFT_OPAQUE(b);
  const int blk = b / S, j = b % S, base = blk * NP + j;
  cf x[16];
  if (!INV) {
#pragma unroll
    for (int q = 0; q < 16; ++q) x[q] = a[fft_pad(base + q * S)];
    dft16<false>(x);
#pragma unroll
    for (int q = 0; q < 16; ++q) {
      cf v = x[4 * (q & 3) + (q >> 2)];
      if (q > 0 && S > 1) { const float fr = (float)((j * q) & (NP - 1)) * (1.0f / NP); v = cmul(v, cmk(fft_cos_rev(fr), -fft_sin_rev(fr))); }
      a[fft_pad(base + q * S)] = v;
    }
  } else {
#pragma unroll
    for (int q = 0; q < 16; ++q) {
      cf v = a[fft_pad(base + q * S)];
      if (q > 0 && S > 1) { const float fr = (float)((j * q) & (NP - 1)) * (1.0f / NP); v = cmul(v, cmk(fft_cos_rev(fr), fft_sin_rev(fr))); }
      x[q] = v;
    }
    dft16<true>(x);
#pragma unroll
    for (int q = 0; q < 16; ++q) a[fft_pad(base + q * S)] = x[4 * (q & 3) + (q >> 2)];
  }
}
template <bool INV> FFT_HD void fft_bfly4(FFT_LDS cf* a, int b) {
  const int p = fft_pad(4 * b);
  cf x0 = a[p], x1 = a[p + 1], x2 = a[p + 2], x3 = a[p + 3];
  dft4<INV>(x0, x1, x2, x3);
  a[p] = x0; a[p + 1] = x1; a[p + 2] = x2; a[p + 3] = x3;
}
FFT_HD int fft_pos_of_k(int k) { return ((k & 15) << 10) | (((k >> 4) & 15) << 6) | (((k >> 8) & 15) << 2) | (k >> 12); }
FFT_HD int fft_kbase_of_group(int g) { return (g >> 8) | (((g >> 4) & 15) << 4) | ((g & 15) << 8); }
FFT_HD void rfft_unpack(cf Ck, cf Cm, float wr, float wi, cf& Ak, cf& Am) {
  cf E = cmk(0.5f * (Ck.x + Cm.x), 0.5f * (Ck.y - Cm.y));
  cf T = cmk(0.5f * (Ck.x - Cm.x), 0.5f * (Ck.y + Cm.y));
  cf O = cmk(T.y, -T.x);
  cf wO = cmul(cmk(wr, wi), O);
  Ak = cadd(E, wO); Am = cconj(csub(E, wO));
}
FFT_HD void rfft_pack(cf Yk, cf Ym, float wr, float wi, cf& Ck, cf& Cm) {
  cf E = cmk(0.5f * (Yk.x + Ym.x), 0.5f * (Yk.y - Ym.y));
  cf D = cmk(0.5f * (Yk.x - Ym.x), 0.5f * (Yk.y + Ym.y));
  cf O = cmul(cmk(wr, -wi), D);
  Ck = cmk(E.x - O.y, E.y + O.x);
  Cm = cmk(E.x + O.y, -E.y + O.x);
}
template <class ST> FFT_HD void fft_filter_group(FFT_LDS cf* a, int g, float scale, ST st) {
  FFT_OPAQUE(g);
  const int ka = fft_kbase_of_group(g), kb = ka + 4096;
  const int pa = 4 * g, pb = 4 * g + 1;
  {
    const int km = FFT_M - kb, pm = fft_pos_of_k(km);
    const float fr = (float)kb * (1.0f / (2 * FFT_M));
    cf Ak, Am; rfft_unpack(a[fft_pad(pb)], a[fft_pad(pm)], fft_cos_rev(fr), -fft_sin_rev(fr), Ak, Am);
    st(pb, cmk(Ak.x * scale, Ak.y * scale)); st(pm, cmk(Am.x * scale, Am.y * scale));
  }
  if (g == 0) {
    cf C0 = a[fft_pad(0)]; st(0, cmk((C0.x + C0.y) * scale, (C0.x - C0.y) * scale));
    cf C2 = a[fft_pad(2)]; st(2, cmk(C2.x * scale, -C2.y * scale));
  } else {
    const int km = FFT_M - ka, pm = fft_pos_of_k(km);
    const float fr = (float)ka * (1.0f / (2 * FFT_M));
    cf Ak, Am; rfft_unpack(a[fft_pad(pa)], a[fft_pad(pm)], fft_cos_rev(fr), -fft_sin_rev(fr), Ak, Am);
    st(pa, cmk(Ak.x * scale, Ak.y * scale)); st(pm, cmk(Am.x * scale, Am.y * scale));
  }
}
template <class LD> FFT_HD void fft_conv_group(FFT_LDS cf* a, int g, LD ld) {
  FFT_OPAQUE(g);
  const int ka = fft_kbase_of_group(g), kb = ka + 4096;
  const int pa = 4 * g, pb = 4 * g + 1;
  {
    const int km = FFT_M - kb, pm = fft_pos_of_k(km);
    const float fr = (float)kb * (1.0f / (2 * FFT_M));
    const float wr = fft_cos_rev(fr), wi = -fft_sin_rev(fr);
    cf Ak, Am; rfft_unpack(a[fft_pad(pb)], a[fft_pad(pm)], wr, wi, Ak, Am);
    cf Yk = cmul(Ak, ld(pb)), Ym = cmul(Am, ld(pm));
    cf Ck, Cm; rfft_pack(Yk, Ym, wr, wi, Ck, Cm);
    a[fft_pad(pb)] = Ck; a[fft_pad(pm)] = Cm;
  }
  if (g == 0) {
    cf C0 = a[fft_pad(0)]; cf K0 = ld(0);
    const float Y0 = (C0.x + C0.y) * K0.x, YM = (C0.x - C0.y) * K0.y;
    a[fft_pad(0)] = cmk(0.5f * (Y0 + YM), 0.5f * (Y0 - YM));
    cf C2 = a[fft_pad(2)]; cf Y = cmul(cconj(C2), ld(2)); a[fft_pad(2)] = cconj(Y);
  } else {
    const int km = FFT_M - ka, pm = fft_pos_of_k(km);
    const float fr = (float)ka * (1.0f / (2 * FFT_M));
    const float wr = fft_cos_rev(fr), wi = -fft_sin_rev(fr);
    cf Ak, Am; rfft_unpack(a[fft_pad(pa)], a[fft_pad(pm)], wr, wi, Ak, Am);
    cf Yk = cmul(Ak, ld(pa)), Ym = cmul(Am, ld(pm));
    cf Ck, Cm; rfft_pack(Yk, Ym, wr, wi, Ck, Cm);
    a[fft_pad(pa)] = Ck; a[fft_pad(pm)] = Cm;
  }
}


__device__ __forceinline__ int lds_byte2(int r, int c) { int st = (r >> 4) * 2 + (c >> 5), ob = (r & 15) * 64 + (c & 31) * 2; return st * 1024 + (ob ^ (((ob >> 9) & 1) << 5)); }
__device__ __forceinline__ void stage_rc2(int b, int& R, int& C) { int st = b >> 10, sb = b & 1023, swz = sb ^ (((sb >> 9) & 1) << 5); R = (st >> 1) * 16 + swz / 64; C = (st & 1) * 32 + (swz % 64) / 2; }

template <class AR, class BR, class EP>
__device__ __forceinline__ void gemm_tile(ldsp shm, const bf16_t* __restrict__ A, const bf16_t* __restrict__ Bt, int K, AR arow, BR brow, EP epi) {
  constexpr int TILE_B = 32768, STAGE_B = 65536, GL = 4;
  const int tid = threadIdx.x, wid = __builtin_amdgcn_readfirstlane(tid >> 6), lane = tid & 63, wr = wid >> 2, wc = wid & 3, fr = lane & 15, fq = lane >> 4;
  unsigned oa[GL], ob[GL];
#pragma unroll
  for (int i = 0; i < GL; ++i) { int R, C; stage_rc2(wid * 1024 + i * 8192 + lane * 16, R, C); oa[i] = (unsigned)(arow(R) + C) * 2u; ob[i] = (unsigned)(brow(R) + C) * 2u; }
  f32x4 acc[8][4];
#pragma unroll
  for (int m = 0; m < 8; ++m)
#pragma unroll
    for (int n = 0; n < 4; ++n) acc[m][n] = (f32x4){0.f, 0.f, 0.f, 0.f};
  const int aoff = lds_byte2(wr * 128 + fr, fq * 8), boff = TILE_B + lds_byte2(wc * 64 + fr, fq * 8);
#define G_STAGE(buf, kt) do { const char* ga = (const char*)(A + (kt) * 64); const char* gb = (const char*)(Bt + (kt) * 64); _Pragma("unroll") for (int i = 0; i < GL; ++i) { \
    __builtin_amdgcn_global_load_lds((const unsigned*)(ga + oa[i]), (LAS unsigned*)(shm + (buf) * STAGE_B + wid * 1024 + i * 8192), 16, 0, 0); \
    __builtin_amdgcn_global_load_lds((const unsigned*)(gb + ob[i]), (LAS unsigned*)(shm + (buf) * STAGE_B + TILE_B + wid * 1024 + i * 8192), 16, 0, 0); } } while (0)
  const int nt = K / 64;
  G_STAGE(0, 0);
  asm volatile("s_waitcnt vmcnt(0)" ::: "memory"); __syncthreads();
  for (int t = 0; t < nt; ++t) {
    const int cur = t & 1;
    if (t + 1 < nt) G_STAGE(cur ^ 1, t + 1);
    ldsp sa = shm + cur * STAGE_B;
#pragma unroll
    for (int ks = 0; ks < 2; ++ks) {
      bf16x8 At[8], Bf[4];
#pragma unroll
      for (int m = 0; m < 8; ++m) At[m] = *(const LAS bf16x8*)(sa + aoff + m * 2048 + ks * 1024);
#pragma unroll
      for (int n = 0; n < 4; ++n) Bf[n] = *(const LAS bf16x8*)(sa + boff + n * 2048 + ks * 1024);
#pragma unroll
      for (int m = 0; m < 8; ++m)
#pragma unroll
        for (int n = 0; n < 4; ++n) acc[m][n] = __builtin_amdgcn_mfma_f32_16x16x32_bf16(At[m], Bf[n], acc[m][n], 0, 0, 0);
      __builtin_amdgcn_sched_barrier(0);
    }
    asm volatile("s_waitcnt vmcnt(0)" ::: "memory"); __syncthreads();
  }
#undef G_STAGE
  epi(acc, wr, wc, fr, fq);
}

__device__ __forceinline__ void transpose_item(const float* __restrict__ W, int ldw, int k0, int n0, bf16_t* __restrict__ dst, int ldd, int drow0, LAS float* scr, int lane) {
#pragma unroll 8
  for (int i = 0; i < 32; ++i) { const int kk = 2 * i + (lane >> 5); scr[kk * 33 + (lane & 31)] = W[(size_t)(k0 + kk) * ldw + n0 + (lane & 31)]; }
  asm volatile("s_waitcnt lgkmcnt(0)" ::: "memory");
  const int c = lane & 7;
#pragma unroll
  for (int j = 0; j < 4; ++j) {
    const int n = (lane >> 3) + 8 * j; const LAS float* s = scr + (8 * c) * 33 + n;
    u32x4 o; o.x = pk2(s[0], s[33]); o.y = pk2(s[2 * 33], s[3 * 33]); o.z = pk2(s[4 * 33], s[5 * 33]); o.w = pk2(s[6 * 33], s[7 * 33]);
    *(u32x4*)(dst + (size_t)(drow0 + n) * ldd + k0 + 8 * c) = o;
  }
  asm volatile("s_waitcnt lgkmcnt(0)" ::: "memory");
}
__device__ __forceinline__ void transpose_weight(const float* W, int K, int N, bf16_t* dst, int gw, int ngw, LAS float* scr, int lane) {
  const int nblk = N / 32, items = (K / 64) * nblk;
  for (int it = gw; it < items; it += ngw) { const int kb = it / nblk, nb = it % nblk; transpose_item(W, N, kb * 64, nb * 32, dst, K, nb * 32, scr, lane); }
}
__device__ __forceinline__ void convert_moe(const float* wg, const float* wu, const float* wd, bf16_t* Wgu, bf16_t* Wd, int gw, int ngw, LAS float* scr, int lane) {
  const int total = 16 * 1536;
  for (int it = gw; it < total; it += ngw) {
    const int e = it / 1536, r = it % 1536;
    if (r < 1024) {
      const int up = r >> 9, q = r & 511, kb = q >> 5, nb = q & 31;
      const float* W = (up ? wu : wg) + (size_t)e * 1024 * 1024;
      const int f0 = nb * 32, pn = f0 >> 7, wcx = (f0 & 127) >> 5;
      transpose_item(W, 1024, kb * 64, f0, Wgu + (size_t)e * 2048 * 1024, 1024, pn * 256 + wcx * 64 + up * 32, scr, lane);
    } else {
      const int q = r - 1024, kb = q >> 5, nb = q & 31;
      transpose_item(wd + (size_t)e * 1024 * 1024, 1024, kb * 64, nb * 32, Wd + (size_t)e * 1024 * 1024, 1024, nb * 32, scr, lane);
    }
  }
}

__device__ __forceinline__ float norm_mod_regs(const f32x4 (&v)[4], const float* g, const float* shift, const float* scale, bf16_t* orow, int lane) {
  float ss = 0.f;
#pragma unroll
  for (int j = 0; j < 4; ++j) ss += v[j].x * v[j].x + v[j].y * v[j].y + v[j].z * v[j].z + v[j].w * v[j].w;
  const float rstd = 1.0f / sqrtf(wave_sum(ss) * (1.f / 1024.f) + 1e-6f);
#pragma unroll
  for (int j = 0; j < 4; ++j) {
    const f32x4 gg = ((const f32x4*)g)[lane + 64 * j], sh = ((const f32x4*)shift)[lane + 64 * j], sc = ((const f32x4*)scale)[lane + 64 * j];
    const f32x4 y = v[j] * rstd * gg * (1.f + sc) + sh;
    u32x2 o; o.x = pk2(y.x, y.y); o.y = pk2(y.z, y.w);
    ((u32x2*)orow)[lane + 64 * j] = o;
  }
  return rstd;
}
__device__ __forceinline__ float norm_mod_row(const float* xrow, const float* g, const float* shift, const float* scale, bf16_t* orow, int lane) {
  f32x4 v[4];
#pragma unroll
  for (int j = 0; j < 4; ++j) v[j] = ((const f32x4*)xrow)[lane + 64 * j];
  return norm_mod_regs(v, g, shift, scale, orow, lane);
}
template <int NPT>
__device__ __forceinline__ void topk_block(ldsp lds, const float* aff, int e, int N, int cap, int* sel_idx, float* sel_g, int* slot_of) {
  LAS int* hist = (LAS int*)lds; LAS int* misc = hist + 256; LAS int* wtot = misc + 8;
  const int tid = threadIdx.x, lane = tid & 63, wid = tid >> 6;
  unsigned key[NPT];
#pragma unroll
  for (int i = 0; i < NPT; ++i) { const int idx = tid * NPT + i; key[i] = idx < N ? __builtin_bit_cast(unsigned, aff[(size_t)idx * 16 + e]) : 0u; }
  unsigned prefix = 0u, mask = 0u; int rem = cap;
#pragma unroll 1
  for (int pass = 0; pass < 4; ++pass) {
    const int shift = 24 - 8 * pass;
    if (tid < 256) hist[tid] = 0;
    __syncthreads();
#pragma unroll
    for (int i = 0; i < NPT; ++i) { const int idx = tid * NPT + i; if (idx < N && (key[i] & mask) == prefix) atomicAdd((int*)&hist[(key[i] >> shift) & 255u], 1); }
    __syncthreads();
    if (wid == 0) {
      const int h0 = hist[4 * lane], h1 = hist[4 * lane + 1], h2 = hist[4 * lane + 2], h3 = hist[4 * lane + 3];
      const int s = h0 + h1 + h2 + h3; int suf = s;
#pragma unroll
      for (int off = 1; off < 64; off <<= 1) { const int t = __shfl_down(suf, off); if (lane + off < 64) suf += t; }
      int c = suf - s;
      if (c < rem && c + h3 >= rem) { misc[0] = 4 * lane + 3; misc[1] = rem - c; } c += h3;
      if (c < rem && c + h2 >= rem) { misc[0] = 4 * lane + 2; misc[1] = rem - c; } c += h2;
      if (c < rem && c + h1 >= rem) { misc[0] = 4 * lane + 1; misc[1] = rem - c; } c += h1;
      if (c < rem && c + h0 >= rem) { misc[0] = 4 * lane + 0; misc[1] = rem - c; }
    }
    __syncthreads();
    const int bin = misc[0]; rem = misc[1];
    prefix |= (unsigned)bin << shift; mask |= 0xFFu << shift;
    __syncthreads();
  }
  const unsigned T = prefix;
  int cgt = 0, ceq = 0;
#pragma unroll
  for (int i = 0; i < NPT; ++i) { const int idx = tid * NPT + i; if (idx < N) { cgt += key[i] > T ? 1 : 0; ceq += key[i] == T ? 1 : 0; } }
  int igt = cgt, ieq = ceq;
#pragma unroll
  for (int off = 1; off < 64; off <<= 1) { const int a = __shfl_up(igt, off), b = __shfl_up(ieq, off); if (lane >= off) { igt += a; ieq += b; } }
  if (lane == 63) { wtot[wid * 2] = igt; wtot[wid * 2 + 1] = ieq; }
  __syncthreads();
  int bgt = 0, beq = 0, tgt = 0;
#pragma unroll
  for (int w = 0; w < 8; ++w) { const int a = wtot[2 * w], b = wtot[2 * w + 1]; if (w < wid) { bgt += a; beq += b; } tgt += a; }
  int pgt = bgt + igt - cgt, peq = beq + ieq - ceq;
#pragma unroll
  for (int i = 0; i < NPT; ++i) {
    const int idx = tid * NPT + i;
    if (idx < N) {
      int slot = -1;
      if (key[i] > T) slot = pgt++;
      else if (key[i] == T) { if (peq < rem) slot = tgt + peq; ++peq; }
      slot_of[(size_t)idx * 16 + e] = slot;
      if (slot >= 0) { sel_idx[slot] = idx; sel_g[slot] = __builtin_bit_cast(float, key[i]); }
    }
  }
  __syncthreads();
}

__global__ void __launch_bounds__(NT) mega(Params p) {
  extern __shared__ __attribute__((aligned(16))) unsigned char lds_raw[];
  cg::grid_group grid = cg::this_grid();
  ldsp lds = (ldsp)lds_raw;
  const int tid = threadIdx.x, lane = tid & 63, wid = tid >> 6;
  const int G = gridDim.x, bid = blockIdx.x;
  const int gw = bid * 8 + wid, ngw = G * 8;
  unsigned char* ws = p.ws;
  float* mods = (float*)(ws + OFF_MODS);
#define MODP(layer, set, m) (mods + (((layer) * 2 + (set)) * 6 + (m)) * 1024)
  LAS float* lf = (LAS float*)lds;

#if (PH_MASK >> 0) & 1
  {
    { for (int i = tid; i < 1024; i += NT) { lf[i] = siluf(p.in[I_C][i]); lf[1024 + i] = siluf(p.in[I_CCTX][i]); }
      __syncthreads();
      for (int task = bid; task < 192; task += G) {
        const int l = task / 96, n0 = (task % 96) * 64, kq = tid >> 6, n = tid & 63;
        const float* W = p.in[I_ADAW] + (size_t)l * 1024 * 6144 + n0 + n;
        float s0 = 0.f, s1 = 0.f;
        for (int k = kq; k < 1024; k += 8) { const float w = W[(size_t)k * 6144]; s0 += lf[k] * w; s1 += lf[1024 + k] * w; }
        lf[2048 + (kq * 64 + n) * 2] = s0; lf[2048 + (kq * 64 + n) * 2 + 1] = s1;
        __syncthreads();
        if (tid < 64) { float a = 0.f, b = 0.f;
#pragma unroll
          for (int q = 0; q < 8; ++q) { a += lf[2048 + (q * 64 + tid) * 2]; b += lf[2048 + (q * 64 + tid) * 2 + 1]; }
          const float bb = p.in[I_ADAB][l * 6144 + n0 + tid];
          mods[(l * 2 + 0) * 6144 + n0 + tid] = a + bb; mods[(l * 2 + 1) * 6144 + n0 + tid] = b + bb; }
        __syncthreads();
      }
    }
    __syncthreads();
    { LAS float* w1 = lf; LAS float* w2 = lf + 33 * 64; LAS float* w3 = w2 + 4096; LAS float* bz = w3 + 4096;   LAS float* scr = bz + 256 + wid * 64;
      for (int i = tid; i < 33 * 64; i += NT) w1[i] = p.in[I_FW1][i];
      for (int i = tid; i < 4096; i += NT) { w2[i] = p.in[I_FW2][i]; w3[i] = p.in[I_FW3][i]; }
      if (tid < 64) { bz[tid] = p.in[I_FB1][tid]; bz[64 + tid] = p.in[I_FB2][tid]; bz[128 + tid] = p.in[I_FB3][tid]; bz[192 + tid] = p.in[I_FFREQ][tid]; }
      __syncthreads();
      const float fq_ = bz[192 + lane];
      for (int rg = bid; rg < NKEY / 8; rg += G) {
        const int row = rg * 8 + wid; const bool isx = row < SEQ; const int l = isx ? row : row - SEQ; const int L = isx ? SEQ : CTX;
        const float t = (float)l / (float)(L - 1); const float w = 6.283185307179586f * (float)l / (float)L;
        float zv;
        if (lane == 0) zv = t;
        else if (lane <= 32) { const int b = (lane - 1) & 15; const float band = 1e-4f + (float)b * ((15.f - 1e-4f) / 15.f); const float a = w * band; zv = (lane <= 16) ? cosf(a) : -sinf(a); }
        else zv = 0.f;
        scr[lane] = zv;
        __syncthreads();
        float a = bz[lane];
        for (int i = 0; i < 33; ++i) a += scr[i] * w1[i * 64 + lane];
        float h = sinf(fq_ * a);
        __syncthreads(); scr[lane] = h; __syncthreads();
        a = bz[64 + lane];
        for (int i = 0; i < 64; ++i) a += scr[i] * w2[i * 64 + lane];
        h = sinf(fq_ * a);
        __syncthreads(); scr[lane] = h; __syncthreads();
        a = bz[128 + lane];
        for (int i = 0; i < 64; ++i) a += scr[i] * w3[i * 64 + lane];
        h = sinf(fq_ * a);
        bf16_t* hid = isx ? (bf16_t*)(ws + OFF_HIDX) + (size_t)l * 64 : (bf16_t*)(ws + OFF_HIDC) + (size_t)l * 64;
        hid[lane] = (bf16_t)f2bf(h);
        __syncthreads();
      }
    }
    __syncthreads();
    { LAS float* scr = lf + wid * (64 * 33);
      transpose_weight(p.in[I_FW4], 64, 4096, (bf16_t*)(ws + OFF_W4T), gw, ngw, scr, lane);
      transpose_weight(p.in[I_HWIN], 1024, 3072, (bf16_t*)(ws + OFF_WIN), gw, ngw, scr, lane);
      transpose_weight(p.in[I_HWOUT], 1024, 1024, (bf16_t*)(ws + OFF_WHO), gw, ngw, scr, lane);
      transpose_weight(p.in[I_DWQKV], 1024, 3072, (bf16_t*)(ws + OFF_WQKV), gw, ngw, scr, lane);
      transpose_weight(p.in[I_DWOUT], 1024, 1024, (bf16_t*)(ws + OFF_WDO), gw, ngw, scr, lane);
    }
    { f32x2* rope = (f32x2*)(ws + OFF_ROPE);
      for (int i = bid * NT + tid; i < 4096; i += G * NT) { const int pos = i >> 4, k = i & 15; const float inv = powf(10000.f, -(float)(2 * k) / 32.f); const float a = (float)pos * inv; rope[i] = (f32x2){cosf(a), sinf(a)}; }
    }
  }
#endif
  grid.sync();
#if (PH_MASK >> 1) & 1
  {
    for (int tile = bid; tile < 1024 + 16; tile += G) {
      const bool isx = tile < 1024; const int tt = isx ? tile : tile - 1024;
      const int pm = isx ? (tt >> 6) : tt, pn = isx ? (tt & 63) : 0;
      const bf16_t* A = (const bf16_t*)(ws + OFF_W4T) + (size_t)pm * 256 * 64;
      const bf16_t* B = isx ? (const bf16_t*)(ws + OFF_HIDX) + (size_t)pn * 256 * 64 : (const bf16_t*)(ws + OFF_HIDC);
      h16* HT = isx ? (h16*)(ws + OFF_HT) : (h16*)(ws + OFF_HCT); const int ld = isx ? SEQ : CTX;
      gemm_tile(lds, A, B, 64, [](int r) { return r * 64; }, [](int r) { return r * 64; },
        [&](f32x4 (&acc)[8][4], int wr, int wc, int fr, int fq) {
#pragma unroll
          for (int m = 0; m < 8; ++m) {
            int r0 = pm * 256 + wr * 128 + m * 16 + fq * 4; EPI_FENCE(r0);
            h16* rp = HT + (size_t)r0 * ld + pn * 256 + wc * 64 + fr;
#pragma unroll
            for (int j = 0; j < 4; ++j)
#pragma unroll
              for (int n = 0; n < 4; ++n) rp[(size_t)j * ld + n * 16] = (h16)acc[m][n][j];
          }
        });
    }
    for (int row = gw; row < NKEY; row += ngw) {
      const bool isx = row < SEQ; const int r = isx ? row : row - SEQ; const int set = isx ? 0 : 1;
      const float* xr = isx ? p.in[I_X] + (size_t)r * 1024 : p.in[I_CTX] + (size_t)r * 1024;
      bf16_t* o = isx ? (bf16_t*)(ws + OFF_HX) + (size_t)r * 1024 : (bf16_t*)(ws + OFF_HC) + (size_t)r * 1024;
      norm_mod_row(xr, p.in[I_NMIX], MODP(0, set, 0), MODP(0, set, 1), o, lane);
    }
  }
#endif
  grid.sync();
#if (PH_MASK >> 2) & 1
  for (int rep_ = 0; rep_ < REP_P2; ++rep_, __syncthreads())
  {
    for (int tile = bid; tile < 768 + 12; tile += G) {
      const bool isx = tile < 768; const int tt = isx ? tile : tile - 768;
      const int pm = isx ? tt / 64 : tt, pn = isx ? tt % 64 : 0;
      const bf16_t* A = (const bf16_t*)(ws + OFF_WIN) + (size_t)pm * 256 * 1024;
      const bf16_t* B = isx ? (const bf16_t*)(ws + OFF_HX) + (size_t)pn * 256 * 1024 : (const bf16_t*)(ws + OFF_HC);
      h16* UT = isx ? (h16*)(ws + OFF_UT) : (h16*)(ws + OFF_UCT); const int ld = isx ? SEQ : CTX;
      const float* bin = p.in[I_HBIN];
      gemm_tile(lds, A, B, 1024, [](int r) { return r * 1024; }, [](int r) { return r * 1024; },
        [&](f32x4 (&acc)[8][4], int wr, int wc, int fr, int fq) {
#pragma unroll
          for (int m = 0; m < 8; ++m) {
            int r0 = pm * 256 + wr * 128 + m * 16 + fq * 4; EPI_FENCE(r0);
            const f32x4 bv = *(const f32x4*)(bin + r0);
            h16* rp = UT + (size_t)r0 * ld + pn * 256 + wc * 64 + fr;
#pragma unroll
            for (int j = 0; j < 4; ++j)
#pragma unroll
              for (int n = 0; n < 4; ++n) rp[(size_t)j * ld + n * 16] = (h16)(acc[m][n][j] + bv[j]);
          }
        });
    }
    LAS cf* a = (LAS cf*)lds; LAS float* red = (LAS float*)(lds + FFT_LDS_ELEMS * 8);
    for (int task = bid; task < 2048; task += G) {
      const int o = task >> 10, c = task & 1023;
      const h16* hf_ = (const h16*)(ws + OFF_HT) + (size_t)((o * 2 + 0) * 1024 + c) * SEQ;
      const h16* hb_ = (const h16*)(ws + OFF_HT) + (size_t)((o * 2 + 1) * 1024 + c) * SEQ;
      const float adl = 3.0701134573253945f + (15.350567286626973f - 3.0701134573253945f) * (float)c * (1.f / 1023.f);
      const float kdec = -adl * (1.f / 16383.f) * 1.4426950408889634f;
      float sabs = 0.f;
      _Pragma("unroll 2") for (int n = tid; n < FFT_M; n += NT) {
        float re, im;
        if (n < 8192) { const h16x2 v = *(const h16x2*)(hf_ + 2 * n); re = (float)v.x * exp2f(kdec * (float)(2 * n)); im = (float)v.y * exp2f(kdec * (float)(2 * n + 1)); }
        else if (n == 8192) { re = 0.f; im = (float)hb_[16383] * exp2f(kdec * 16383.f); }
        else { const int l0 = 32768 - 2 * n; re = (float)hb_[l0] * exp2f(kdec * (float)l0); im = (float)hb_[l0 - 1] * exp2f(kdec * (float)(l0 - 1)); }
        sabs += fabsf(re) + fabsf(im);
        a[fft_pad(n)] = cmk(re, im);
      }
      sabs = wave_sum(sabs); if (lane == 0) red[wid] = sabs;
      __syncthreads();
      float S = 1e-6f;
#pragma unroll
      for (int q = 0; q < 8; ++q) S += red[q];
      const float scale = 1.0f / S;
      _Pragma("unroll 1") for (int b = tid; b < 1024; b += NT) fft_bfly16<false, 16384>(a, b);
      __syncthreads();
      _Pragma("unroll 1") for (int b = tid; b < 1024; b += NT) fft_bfly16<false, 1024>(a, b);
      __syncthreads();
      _Pragma("unroll 1") for (int b = tid; b < 1024; b += NT) fft_bfly16<false, 64>(a, b);
      __syncthreads();
      _Pragma("unroll 1") for (int b = tid; b < 4096; b += NT) fft_bfly4<false>(a, b);
      __syncthreads();
      h16x2* ks = (h16x2*)(ws + OFF_KSPEC) + (size_t)task * FFT_M;
      _Pragma("unroll 1") for (int g = tid; g < 4096; g += NT) fft_filter_group(a, g, scale, [&](int pos, cf v) { h16x2 hv; hv.x = (h16)v.x; hv.y = (h16)v.y; ks[pos] = hv; });
      __syncthreads();
    }
    for (int task = gw; task < 2048; task += ngw) {
      const int o = task >> 10, c = task & 1023;
      const h16* hf_ = (const h16*)(ws + OFF_HCT) + (size_t)((o * 2 + 0) * 1024 + c) * CTX;
      const h16* hb_ = (const h16*)(ws + OFF_HCT) + (size_t)((o * 2 + 1) * 1024 + c) * CTX;
      const float adl = 3.0701134573253945f + (15.350567286626973f - 3.0701134573253945f) * (float)c * (1.f / 1023.f);
      const float kdec = -adl * (1.f / 255.f) * 1.4426950408889634f;
      float f[4], b[4], s = 0.f;
#pragma unroll
      for (int i = 0; i < 4; ++i) { const int l = lane + 64 * i; const float d = exp2f(kdec * (float)l); f[i] = (float)hf_[l] * d; b[i] = (float)hb_[l] * d; s += fabsf(f[i]) + (l > 0 ? fabsf(b[i]) : 0.f); }
      const float inv = 1.f / (wave_sum(s) + 1e-6f);
      float* kc = (float*)(ws + OFF_KCTX) + (size_t)task * 512;
#pragma unroll
      for (int i = 0; i < 4; ++i) { const int l = lane + 64 * i; kc[l] = f[i] * inv; if (l > 0) kc[512 - l] = b[i] * inv; else kc[256] = 0.f; }
    }
  }
#endif
  grid.sync();
#if (PH_MASK >> 3) & 1
  for (int rep_ = 0; rep_ < REP_P3; ++rep_, __syncthreads())
  {
    LAS cf* a = (LAS cf*)lds;
    const float* cw = p.in[I_HCW]; const float* cb = p.in[I_HCB]; const float* skip = p.in[I_HSKIP];
    for (int c = bid; c < 1024; c += G) {
      const h16* uv = (const h16*)(ws + OFF_UT) + (size_t)c * SEQ;
      const h16* u1 = (const h16*)(ws + OFF_UT) + (size_t)(1024 + c) * SEQ;
      const h16* u2 = (const h16*)(ws + OFF_UT) + (size_t)(2048 + c) * SEQ;
#define SCONV(u, cc, n, r0, r1) do { const h16x2 mid = *(const h16x2*)((u) + 2 * (n)); const float um = (n) > 0 ? (float)(u)[2 * (n) - 1] : 0.f; const float up = (n) < 8191 ? (float)(u)[2 * (n) + 2] : 0.f; \
        const float w0 = cw[cc], w1 = cw[3072 + (cc)], w2 = cw[6144 + (cc)], b_ = cb[cc]; \
        r0 = b_ + w0 * um + w1 * (float)mid.x + w2 * (float)mid.y; r1 = b_ + w0 * (float)mid.x + w1 * (float)mid.y + w2 * up; } while (0)
      _Pragma("unroll 2") for (int n = tid; n < 8192; n += NT) { float z0, z1; SCONV(uv, c, n, z0, z1); a[fft_pad(n)] = cmk(z0, z1); a[fft_pad(n + 8192)] = cmk(0.f, 0.f); }
      __syncthreads();
      cf* zkeep = (cf*)(ws + OFF_HX) + (size_t)bid * 8192;
#pragma unroll 1
      for (int o = 0; o < 2; ++o) {
        _Pragma("unroll 1") for (int b = tid; b < 1024; b += NT) fft_bfly16<false, 16384>(a, b);
        __syncthreads();
        _Pragma("unroll 1") for (int b = tid; b < 1024; b += NT) fft_bfly16<false, 1024>(a, b);
        __syncthreads();
        _Pragma("unroll 1") for (int b = tid; b < 1024; b += NT) fft_bfly16<false, 64>(a, b);
        __syncthreads();
        _Pragma("unroll 1") for (int b = tid; b < 4096; b += NT) fft_bfly4<false>(a, b);
        __syncthreads();
        const h16x2* ks = (const h16x2*)(ws + OFF_KSPEC) + (size_t)(o * 1024 + c) * FFT_M;
        _Pragma("unroll 1") for (int g = tid; g < 4096; g += NT) fft_conv_group(a, g, [&](int pos) { const h16x2 hv = ks[pos]; return cmk((float)hv.x * (1.0f / FFT_M), (float)hv.y * (1.0f / FFT_M)); });
        __syncthreads();
        _Pragma("unroll 1") for (int b = tid; b < 4096; b += NT) fft_bfly4<true>(a, b);
        __syncthreads();
        _Pragma("unroll 1") for (int b = tid; b < 1024; b += NT) fft_bfly16<true, 64>(a, b);
        __syncthreads();
        _Pragma("unroll 1") for (int b = tid; b < 1024; b += NT) fft_bfly16<true, 1024>(a, b);
        __syncthreads();
        _Pragma("unroll 1") for (int b = tid; b < 1024; b += NT) fft_bfly16<true, 16384>(a, b);
        __syncthreads();
        if (o == 0) {
          const float sk = skip[c];
          _Pragma("unroll 2") for (int n = tid; n < 8192; n += NT) { float z0, z1, g0, g1; SCONV(uv, c, n, z0, z1); SCONV(u1, 1024 + c, n, g0, g1);
            cf y = a[fft_pad(n)]; DIAG_Y(y); const cf v = cmk(g0 * (y.x + sk * z0), g1 * (y.y + sk * z1)); zkeep[n] = v; a[fft_pad(n)] = v; a[fft_pad(n + 8192)] = cmk(0.f, 0.f); }
        } else {
          const float sk = skip[1024 + c];
          bf16_t* zo = (bf16_t*)(ws + OFF_Z2T) + (size_t)c * SEQ;
          _Pragma("unroll 2") for (int n = tid; n < 8192; n += NT) { float g0, g1; SCONV(u2, 2048 + c, n, g0, g1);
            cf y = a[fft_pad(n)]; DIAG_Y(y); const cf zz = zkeep[n]; ((unsigned*)zo)[n] = pk2(g0 * (y.x + sk * zz.x), g1 * (y.y + sk * zz.y)); }
        }
        __syncthreads();
      }
    }
    LAS float* sf = (LAS float*)lds;
    for (int c = bid; c < 1024; c += G) {
      const h16* ub = (const h16*)(ws + OFF_UCT);
      sf[tid] = ((const float*)(ws + OFF_KCTX))[(size_t)c * 512 + tid]; sf[512 + tid] = ((const float*)(ws + OFF_KCTX))[(size_t)(1024 + c) * 512 + tid];
      if (tid < 256) {
#pragma unroll
        for (int s = 0; s < 3; ++s) { const int cc = s * 1024 + c; const h16* u = ub + (size_t)cc * CTX; const float um = tid > 0 ? (float)u[tid - 1] : 0.f, u0 = (float)u[tid], up = tid < 255 ? (float)u[tid + 1] : 0.f;
          sf[1024 + s * 256 + tid] = cb[cc] + cw[cc] * um + cw[3072 + cc] * u0 + cw[6144 + cc] * up; }
      }
      __syncthreads();
      const int t = tid & 255, part = tid >> 8;
#pragma unroll 1
      for (int o = 0; o < 2; ++o) {
        float s = 0.f;
        for (int q = part * 128; q < part * 128 + 128; ++q) s += sf[o * 512 + ((t - q) & 511)] * sf[1024 + q];
        sf[1792 + tid] = s;
        __syncthreads();
        float znew = 0.f;
        if (tid < 256) { const float y = sf[1792 + tid] + sf[1792 + 256 + tid]; znew = sf[1280 + o * 256 + tid] * (y + skip[o * 1024 + c] * sf[1024 + tid]); }
        __syncthreads();
        if (tid < 256) sf[1024 + tid] = znew;
        __syncthreads();
      }
      if (tid < 256) ((bf16_t*)(ws + OFF_ZC2T))[(size_t)c * CTX + tid] = (bf16_t)f2bf(sf[1024 + tid]);
      __syncthreads();
    }
  }
#endif
  grid.sync();
#if (PH_MASK >> 4) & 1
  {
    LAS bf16_t* tl = (LAS bf16_t*)lds;
    for (int tile = bid; tile < 4096 + 64; tile += G) {
      const bool isx = tile < 4096; const int tt = isx ? tile : tile - 4096;
      const int ld = isx ? SEQ : CTX; const int ntt = ld / 64;
      const int cb_ = tt / ntt, tb = tt % ntt;
      const bf16_t* src = isx ? (const bf16_t*)(ws + OFF_Z2T) : (const bf16_t*)(ws + OFF_ZC2T);
      bf16_t* dst = isx ? (bf16_t*)(ws + OFF_HX) : (bf16_t*)(ws + OFF_ZC2);
      { const int r = tid >> 3, ch = tid & 7; const u32x4 v = *(const u32x4*)(src + (size_t)(cb_ * 64 + r) * ld + tb * 64 + ch * 8); *(LAS u32x4*)(tl + r * 72 + ch * 8) = v; }
      __syncthreads();
      { const int t = tid >> 3, ch = tid & 7; unsigned short e[8];
#pragma unroll
        for (int i = 0; i < 8; ++i) e[i] = tl[(ch * 8 + i) * 72 + t];
        u32x4 o; o.x = e[0] | ((unsigned)e[1] << 16); o.y = e[2] | ((unsigned)e[3] << 16); o.z = e[4] | ((unsigned)e[5] << 16); o.w = e[6] | ((unsigned)e[7] << 16);
        *(u32x4*)(dst + (size_t)(tb * 64 + t) * 1024 + cb_ * 64 + ch * 8) = o; }
      __syncthreads();
    }
    convert_moe(p.in[I_WG], p.in[I_WU], p.in[I_WDN], (bf16_t*)(ws + OFF_WGU), (bf16_t*)(ws + OFF_WD), gw, ngw, lf + wid * (64 * 33), lane);
  }
#endif
  grid.sync();
#if (PH_MASK >> 5) & 1
  {
    for (int tile = bid; tile < 256 + 4; tile += G) {
      const bool isx = tile < 256; const int tt = isx ? tile : tile - 256;
      const int pm = isx ? tt >> 2 : 0, pn = tt & 3;
      const bf16_t* A = isx ? (const bf16_t*)(ws + OFF_HX) + (size_t)pm * 256 * 1024 : (const bf16_t*)(ws + OFF_ZC2);
      const bf16_t* B = (const bf16_t*)(ws + OFF_WHO) + (size_t)pn * 256 * 1024;
      const float* xin = isx ? p.in[I_X] : p.in[I_CTX]; float* xo = isx ? p.out : (float*)(ws + OFF_CTXMID);
      const float* gate = MODP(0, isx ? 0 : 1, 2); const float* bo = p.in[I_HBOUT];
      gemm_tile(lds, A, B, 1024, [](int r) { return r * 1024; }, [](int r) { return r * 1024; },
        [&](f32x4 (&acc)[8][4], int wr, int wc, int fr, int fq) {
          const int col0 = pn * 256 + wc * 64 + fr;
          float gt[4], bb[4];
#pragma unroll
          for (int n = 0; n < 4; ++n) { gt[n] = gate[col0 + n * 16]; bb[n] = bo[col0 + n * 16]; }
#pragma unroll
          for (int m = 0; m < 8; ++m) {
            int r0 = pm * 256 + wr * 128 + m * 16 + fq * 4; EPI_FENCE(r0);
            const size_t base = (size_t)r0 * 1024 + col0;
#pragma unroll
            for (int j = 0; j < 4; ++j)
#pragma unroll
              for (int n = 0; n < 4; ++n) xo[base + j * 1024 + n * 16] = xin[base + j * 1024 + n * 16] + gt[n] * (acc[m][n][j] + bb[n]);
          }
        });
    }
  }
#endif
  grid.sync();

#ifdef DIAG_C
  {
    unsigned* cnt = (unsigned*)(ws + OFF_AFF);
    if (bid == 0 && tid == 0) { cnt[0] = 0u; cnt[1] = 0u; }
    grid.sync();
    const unsigned gid = bid * NT + tid; unsigned hsh = gid * 2654435761u + 12345u; hsh ^= hsh >> 13; hsh *= 0x5bd1e995u; hsh ^= hsh >> 15;
    const int ch = hsh % 1024u, tok = (hsh >> 12) % 16384u, n1 = (hsh >> 5) % 1024u;
    int bad = 0;
    const h16* UTp = (const h16*)(ws + OFF_UT); const float* cw = p.in[I_HCW]; const float* cb = p.in[I_HCB]; const float* skip = p.in[I_HSKIP];
    auto sc = [&](int cc, int t) { const h16* u = UTp + (size_t)cc * SEQ; const float um = t > 0 ? (float)u[t - 1] : 0.f, u0 = (float)u[t], up = t < SEQ - 1 ? (float)u[t + 1] : 0.f; return cb[cc] + cw[cc] * um + cw[3072 + cc] * u0 + cw[6144 + cc] * up; };
    { const float v = sc(ch, tok), g1 = sc(1024 + ch, tok), g2 = sc(2048 + ch, tok); const float r = g2 * (skip[1024 + ch] * (g1 * (skip[ch] * v)));
      const float got = bf2f(((const bf16_t*)(ws + OFF_Z2T))[(size_t)ch * SEQ + tok]); if (!(fabsf(got - r) <= 0.01f + 0.02f * fabsf(r))) bad |= DIAG_C & 1;
      const float got2 = bf2f(((const bf16_t*)(ws + OFF_HX))[(size_t)tok * 1024 + ch]); if (got2 != got) bad |= DIAG_C & 2; }
    { float acc = 0.f; const bf16_t* zr = (const bf16_t*)(ws + OFF_HX) + (size_t)tok * 1024; const bf16_t* wr_ = (const bf16_t*)(ws + OFF_WHO) + (size_t)n1 * 1024;
      for (int q = 0; q < 1024; ++q) acc += bf2f(zr[q]) * bf2f(wr_[q]);
      const float r = p.in[I_X][(size_t)tok * 1024 + n1] + mods[2 * 1024 + n1] * (acc + p.in[I_HBOUT][n1]);
      const float got = p.out[(size_t)tok * 1024 + n1]; if (!(fabsf(got - r) <= 0.005f + 0.005f * fabsf(r))) bad |= DIAG_C & 4; }
    if (bad) atomicAdd(&cnt[0], 1u);
    grid.sync();
    const float f = (float)cnt[0] / (float)(G * NT); const float e = sqrtf(f);
    for (size_t i = (size_t)gid; i < (size_t)SEQ * 1024; i += (size_t)G * NT) p.out[i] = p.in[I_X][i] * (1.f + e);
    return;
  }
#endif
#if STOP_STAGE <= 5
  return;
#endif
  auto phase_router = [&](int layer, int nrows) {
    for (int i = tid; i < 16384; i += NT) lf[i] = p.in[I_ROUTER][(size_t)layer * 16384 + i];
    __syncthreads();
    const float* gn = p.in[I_NFFN] + layer * 1024;
    for (int row = gw; row < nrows; row += ngw) {
      const bool isx = row < SEQ; const int r = isx ? row : row - SEQ; const int set = isx ? 0 : 1;
      const float* xr = isx ? p.out + (size_t)r * 1024 : (const float*)(ws + OFF_CTXMID) + (size_t)r * 1024;
      bf16_t* o = isx ? (bf16_t*)(ws + OFF_HX) + (size_t)r * 1024 : (bf16_t*)(ws + OFF_HC) + (size_t)r * 1024;
      const float* sh = MODP(layer, set, 3); const float* sc = MODP(layer, set, 4);
      const float rstd = norm_mod_row(xr, gn, sh, sc, o, lane);
      float lg[16];
#pragma unroll
      for (int e = 0; e < 16; ++e) lg[e] = 0.f;
#pragma unroll 4
      for (int m = 0; m < 16; ++m) {
        const int k = lane + 64 * m; const float h = xr[k] * rstd * gn[k] * (1.f + sc[k]) + sh[k];
        const LAS f32x4* wp = (const LAS f32x4*)(lf + k * 16);
        const f32x4 w0 = wp[0], w1 = wp[1], w2 = wp[2], w3 = wp[3];
        lg[0] += h * w0.x; lg[1] += h * w0.y; lg[2] += h * w0.z; lg[3] += h * w0.w; lg[4] += h * w1.x; lg[5] += h * w1.y; lg[6] += h * w1.z; lg[7] += h * w1.w;
        lg[8] += h * w2.x; lg[9] += h * w2.y; lg[10] += h * w2.z; lg[11] += h * w2.w; lg[12] += h * w3.x; lg[13] += h * w3.y; lg[14] += h * w3.z; lg[15] += h * w3.w;
      }
      float mxv = -1e30f;
#pragma unroll
      for (int e = 0; e < 16; ++e) { lg[e] = wave_sum(lg[e]); mxv = fmaxf(mxv, lg[e]); }
      float den = 0.f, mine = 0.f;
#pragma unroll
      for (int e = 0; e < 16; ++e) { const float ex = __expf(lg[e] - mxv); den += ex; if (lane == e) mine = ex; }
      if (lane < 16) ((float*)(ws + OFF_AFF))[(size_t)row * 16 + lane] = mine / den;
    }
    __syncthreads();
  };
  auto phase_topk = [&](int ntasks) {
    for (int task = bid; task < ntasks; task += G) {
      const int set = task >> 4, e = task & 15;
      int* si = (int*)(ws + OFF_SELI) + (size_t)task * 2048; float* sg = (float*)(ws + OFF_SELG) + (size_t)task * 2048;
      if (set == 0) topk_block<32>(lds, (const float*)(ws + OFF_AFF), e, SEQ, 2048, si, sg, (int*)(ws + OFF_SLOT));
      else topk_block<1>(lds, (const float*)(ws + OFF_AFF) + (size_t)SEQ * 16, e, CTX, 32, si, sg, (int*)(ws + OFF_SLOT) + (size_t)SEQ * 16);
    }
  };
  auto phase_gateup = [&](int ntiles) {
    for (int tile = bid; tile < ntiles; tile += G) {
      const bool isx = tile < 1024; const int tt = isx ? tile : tile - 1024;
      const int e = isx ? tt >> 6 : tt >> 3, pn = isx ? (tt >> 3) & 7 : tt & 7, pm = isx ? tt & 7 : 0;
      const bf16_t* A = isx ? (const bf16_t*)(ws + OFF_HX) : (const bf16_t*)(ws + OFF_HC);
      const bf16_t* B = (const bf16_t*)(ws + OFF_WGU) + ((size_t)e * 2048 + pn * 256) * 1024;
      const int* si = (const int*)(ws + OFF_SELI) + (size_t)((isx ? 0 : 16) + e) * 2048;
      bf16_t* act = isx ? (bf16_t*)(ws + OFF_ACT) + ((size_t)e * 2048 + pm * 256) * 1024 : (bf16_t*)(ws + OFF_ACTC) + (size_t)e * 256 * 1024;
      const int rmask = isx ? 255 : 31;
      gemm_tile(lds, A, B, 1024, [&](int r) { return si[pm * 256 + (r & rmask)] * 1024; }, [](int r) { return r * 1024; },
        [&](f32x4 (&acc)[8][4], int wr, int wc, int fr, int fq) {
#pragma unroll
          for (int m = 0; m < 8; ++m) {
            int r0 = wr * 128 + m * 16 + fq * 4; EPI_FENCE(r0);
            bf16_t* rp = act + (size_t)r0 * 1024 + pn * 128 + wc * 32 + fr;
#pragma unroll
            for (int j = 0; j < 4; ++j)
#pragma unroll
              for (int n = 0; n < 2; ++n) { const float gv = acc[m][n][j], uv_ = acc[m][n + 2][j]; rp[(size_t)j * 1024 + n * 16] = (bf16_t)f2bf(gv / (1.f + __expf(-gv)) * uv_); }
          }
        });
    }
  };
  auto phase_down = [&](int ntiles) {
    for (int tile = bid; tile < ntiles; tile += G) {
      const bool isx = tile < 512; const int tt = isx ? tile : tile - 512;
      const int e = isx ? tt >> 5 : tt >> 2, pn = isx ? (tt >> 3) & 3 : tt & 3, pm = isx ? tt & 7 : 0;
      const bf16_t* A = isx ? (const bf16_t*)(ws + OFF_ACT) + ((size_t)e * 2048 + pm * 256) * 1024 : (const bf16_t*)(ws + OFF_ACTC) + (size_t)e * 256 * 1024;
      const bf16_t* B = (const bf16_t*)(ws + OFF_WD) + ((size_t)e * 1024 + pn * 256) * 1024;
      const float* sg = (const float*)(ws + OFF_SELG) + (size_t)((isx ? 0 : 16) + e) * 2048 + pm * 256;
      bf16_t* yb = isx ? (bf16_t*)(ws + OFF_YB) + ((size_t)e * 2048 + pm * 256) * 1024 : (bf16_t*)(ws + OFF_YBC) + (size_t)e * 256 * 1024;
      const int rmask = isx ? 255 : 31;
      gemm_tile(lds, A, B, 1024, [](int r) { return r * 1024; }, [](int r) { return r * 1024; },
        [&](f32x4 (&acc)[8][4], int wr, int wc, int fr, int fq) {
#pragma unroll
          for (int m = 0; m < 8; ++m) {
            int r0 = wr * 128 + m * 16 + fq * 4; EPI_FENCE(r0);
            bf16_t* rp = yb + (size_t)r0 * 1024 + pn * 256 + wc * 64 + fr;
#pragma unroll
            for (int j = 0; j < 4; ++j) { const float g = sg[(r0 + j) & rmask];
#pragma unroll
              for (int n = 0; n < 4; ++n) rp[(size_t)j * 1024 + n * 16] = (bf16_t)f2bf(acc[m][n][j] * g); }
          }
        });
    }
  };
  auto phase_combine = [&](int layer, int nrows, float* xdst, bool next_norm) {
    for (int row = gw; row < nrows; row += ngw) {
      const bool isx = row < SEQ; const int r = isx ? row : row - SEQ; const int set = isx ? 0 : 1;
      const float* xr = isx ? p.out + (size_t)r * 1024 : (const float*)(ws + OFF_CTXMID) + (size_t)r * 1024;
      const bf16_t* yb = isx ? (const bf16_t*)(ws + OFF_YB) : (const bf16_t*)(ws + OFF_YBC); const int capp = isx ? 2048 : 256;
      const int* so = (const int*)(ws + OFF_SLOT) + (size_t)row * 16;
      f32x4 a[4];
#pragma unroll
      for (int j = 0; j < 4; ++j) a[j] = (f32x4){0.f, 0.f, 0.f, 0.f};
#pragma unroll 1
      for (int e = 0; e < 16; ++e) {
        const int s = so[e];
        if (s >= 0) { const u32x2* yr = (const u32x2*)(yb + ((size_t)e * capp + s) * 1024);
#pragma unroll
          for (int j = 0; j < 4; ++j) { const u32x2 w = yr[lane + 64 * j]; a[j].x += bf2f(w.x & 0xffffu); a[j].y += bf2f(w.x >> 16); a[j].z += bf2f(w.y & 0xffffu); a[j].w += bf2f(w.y >> 16); } }
      }
      const float* g5 = MODP(layer, set, 5);
      f32x4 v[4];
#pragma unroll
      for (int j = 0; j < 4; ++j) v[j] = ((const f32x4*)xr)[lane + 64 * j] + ((const f32x4*)g5)[lane + 64 * j] * a[j];
      if (isx) {
#pragma unroll
        for (int j = 0; j < 4; ++j) ((f32x4*)(xdst + (size_t)r * 1024))[lane + 64 * j] = v[j];
      }
      if (next_norm) {
        bf16_t* o = isx ? (bf16_t*)(ws + OFF_HX) + (size_t)r * 1024 : (bf16_t*)(ws + OFF_HC) + (size_t)r * 1024;
        norm_mod_regs(v, p.in[I_NMIX] + 1024, MODP(1, set, 0), MODP(1, set, 1), o, lane);
      }
    }
  };

  phase_router(0, NKEY);
  grid.sync();
  phase_topk(32);
  grid.sync();
  for (int rep_ = 0; rep_ < REP_MOE; ++rep_) phase_gateup(1024 + 128);
  grid.sync();
  for (int rep_ = 0; rep_ < REP_MOE; ++rep_) phase_down(512 + 64);
  grid.sync();
  phase_combine(0, NKEY, (float*)(ws + OFF_X1), true);
  convert_moe(p.in[I_WG] + (size_t)16 * 1024 * 1024, p.in[I_WU] + (size_t)16 * 1024 * 1024, p.in[I_WDN] + (size_t)16 * 1024 * 1024, (bf16_t*)(ws + OFF_WGU), (bf16_t*)(ws + OFF_WD), gw, ngw, lf + wid * (64 * 33), lane);
  grid.sync();
#if STOP_STAGE <= 10
  { const size_t gid = (size_t)bid * NT + tid; for (size_t i = gid; i < (size_t)SEQ * 256; i += (size_t)G * NT) ((f32x4*)p.out)[i] = ((const f32x4*)(ws + OFF_X1))[i]; }
  return;
#endif
  {
    for (int tile = bid; tile < 768 + 8; tile += G) {
      const bool isx = tile < 768; const int tt = isx ? tile : tile - 768;
      const int pm = isx ? tt / 12 : 0, pn = isx ? tt % 12 : 4 + tt;
      const bf16_t* A = isx ? (const bf16_t*)(ws + OFF_HX) + (size_t)pm * 256 * 1024 : (const bf16_t*)(ws + OFF_HC);
      const bf16_t* B = (const bf16_t*)(ws + OFF_WQKV) + (size_t)pn * 256 * 1024;
      const int trow0 = isx ? 256 + pm * 256 : 0;
      bf16_t* Qb = (bf16_t*)(ws + OFF_Q); bf16_t* Kb = (bf16_t*)(ws + OFF_KALL); bf16_t* Vb = (bf16_t*)(ws + OFF_VT);
      gemm_tile(lds, A, B, 1024, [](int r) { return r * 1024; }, [](int r) { return r * 1024; },
        [&](f32x4 (&acc)[8][4], int wr, int wc, int fr, int fq) {
          if (pn < 8) {
            bf16_t* base = pn < 4 ? Qb + (size_t)(pm * 256) * 1024 + pn * 256 : Kb + (size_t)trow0 * 1024 + (pn - 4) * 256;
#pragma unroll
            for (int m = 0; m < 8; ++m) {
              int r0 = wr * 128 + m * 16 + fq * 4; EPI_FENCE(r0);
              bf16_t* rp = base + (size_t)r0 * 1024 + wc * 64 + fr;
#pragma unroll
              for (int j = 0; j < 4; ++j)
#pragma unroll
                for (int n = 0; n < 4; ++n) rp[(size_t)j * 1024 + n * 16] = (bf16_t)f2bf(acc[m][n][j]);
            }
          } else {
#pragma unroll
            for (int n = 0; n < 4; ++n) {
              int col = (pn - 8) * 256 + wc * 64 + n * 16 + fr; EPI_FENCE(col);
              bf16_t* cp = Vb + (size_t)col * NKEY + trow0 + wr * 128 + fq * 4;
#pragma unroll
              for (int m = 0; m < 8; ++m) { u32x2 w; w.x = pk2(acc[m][n][0], acc[m][n][1]); w.y = pk2(acc[m][n][2], acc[m][n][3]); *(u32x2*)(cp + m * 16) = w; }
            }
          }
        });
    }
  }
  grid.sync();
  {
    const f32x2* rope = (const f32x2*)(ws + OFF_ROPE);
    for (int row = gw; row < SEQ + NKEY; row += ngw) {
      const bool isq = row < SEQ; const int t = isq ? row : row - SEQ;
      bf16_t* ptr = (isq ? (bf16_t*)(ws + OFF_Q) : (bf16_t*)(ws + OFF_KALL)) + (size_t)t * 1024 + lane * 16;
      const int post = isq ? t : t - 256; const bool dorope = isq || t >= 256;
      const float* gn = isq ? p.in[I_DQN] : p.in[I_DKN];
      const int qd = lane & 3;
      const u32x4 w0 = ((const u32x4*)ptr)[0], w1 = ((const u32x4*)ptr)[1];
      float v[16];
      v[0] = bf2f(w0.x & 0xffffu); v[1] = bf2f(w0.x >> 16); v[2] = bf2f(w0.y & 0xffffu); v[3] = bf2f(w0.y >> 16); v[4] = bf2f(w0.z & 0xffffu); v[5] = bf2f(w0.z >> 16); v[6] = bf2f(w0.w & 0xffffu); v[7] = bf2f(w0.w >> 16);
      v[8] = bf2f(w1.x & 0xffffu); v[9] = bf2f(w1.x >> 16); v[10] = bf2f(w1.y & 0xffffu); v[11] = bf2f(w1.y >> 16); v[12] = bf2f(w1.z & 0xffffu); v[13] = bf2f(w1.z >> 16); v[14] = bf2f(w1.w & 0xffffu); v[15] = bf2f(w1.w >> 16);
      float ss = 0.f;
#pragma unroll
      for (int i = 0; i < 16; ++i) ss += v[i] * v[i];
      ss += __shfl_xor(ss, 1); ss += __shfl_xor(ss, 2);
      const float rstd = 1.0f / sqrtf(ss * (1.f / 64.f) + 1e-6f);
#pragma unroll
      for (int i = 0; i < 16; ++i) v[i] = v[i] * rstd * gn[qd * 16 + i];
      if (dorope) {
        const int pos = (qd < 2) ? (post >> 6) : (post & 63);
#pragma unroll
        for (int i = 0; i < 16; ++i) { const f32x2 cs = rope[pos * 16 + i]; const float other = __shfl_xor(v[i], 1); v[i] = (qd & 1) ? v[i] * cs.x + other * cs.y : v[i] * cs.x - other * cs.y; }
      }
      const float qs = isq ? 0.125f * 1.4426950408889634f : 1.f;
      u32x4 o0, o1;
      o0.x = pk2(v[0] * qs, v[1] * qs); o0.y = pk2(v[2] * qs, v[3] * qs); o0.z = pk2(v[4] * qs, v[5] * qs); o0.w = pk2(v[6] * qs, v[7] * qs);
      o1.x = pk2(v[8] * qs, v[9] * qs); o1.y = pk2(v[10] * qs, v[11] * qs); o1.z = pk2(v[12] * qs, v[13] * qs); o1.w = pk2(v[14] * qs, v[15] * qs);
      ((u32x4*)ptr)[0] = o0; ((u32x4*)ptr)[1] = o1;
    }
  }
  grid.sync();
  for (int rep_ = 0; rep_ < REP_P13; ++rep_, __syncthreads())
  {
    constexpr int KB_B = 64 * 144, VB_B = 128 * 144, BUF_B = KB_B + VB_B;
    const int r32 = lane & 31, hi = lane >> 5;
    const bf16_t* Qg = (const bf16_t*)(ws + OFF_Q); const bf16_t* Kg = (const bf16_t*)(ws + OFF_KALL); const bf16_t* Vg = (const bf16_t*)(ws + OFF_VT);
    float* Og = (float*)(ws + OFF_O);
    const int krow = tid >> 3, kch = tid & 7;
    const int vwoff = krow * 144 + (kch >> 1) * 32 + (kch & 1) * 8;
    constexpr int NKT = NKEY / 64;
    for (int unit = bid; unit < 1024; unit += G) {
      const int c = unit >> 6, qb = unit & 63, vh = c >> 1;
      const bf16_t* Qp = Qg + (size_t)(qb * 256 + wid * 32 + r32) * 1024 + c * 64 + hi * 8;
      bf16x8 qf[4];
#pragma unroll
      for (int s = 0; s < 4; ++s) qf[s] = *(const bf16x8*)(Qp + 16 * s);
      f32x16 o[4];
#pragma unroll
      for (int eb = 0; eb < 4; ++eb)
#pragma unroll
        for (int r = 0; r < 16; ++r) o[eb][r] = 0.f;
      float lrun = 0.f;
      const bf16_t* kg = Kg + (size_t)krow * 1024 + c * 64 + kch * 8;
      const bf16_t* vg0 = Vg + (size_t)(vh * 128 + krow) * NKEY + kch * 8;
      const bf16_t* vg1 = vg0 + (size_t)64 * NKEY;
      u32x4 kreg = *(const u32x4*)kg, v0reg = *(const u32x4*)vg0, v1reg = *(const u32x4*)vg1;
#define ATT_STORE(bufbase) do { ldsp kn_ = (bufbase), vn_ = kn_ + KB_B; \
        *(LAS u32x4*)(kn_ + krow * 144 + kch * 16) = kreg; \
        *(LAS u32x2*)(vn_ + vwoff) = (u32x2){v0reg.x, v0reg.y}; *(LAS u32x2*)(vn_ + vwoff + 16) = (u32x2){v0reg.z, v0reg.w}; \
        *(LAS u32x2*)(vn_ + 64 * 144 + vwoff) = (u32x2){v1reg.x, v1reg.y}; *(LAS u32x2*)(vn_ + 64 * 144 + vwoff + 16) = (u32x2){v1reg.z, v1reg.w}; } while (0)
      ATT_STORE(lds);
      __syncthreads();
#pragma unroll 1
      for (int kt = 0; kt < NKT; ++kt) {
        const bool more = kt + 1 < NKT;
        if (more) { kreg = *(const u32x4*)(kg + (size_t)(kt + 1) * 64 * 1024); v0reg = *(const u32x4*)(vg0 + (kt + 1) * 64); v1reg = *(const u32x4*)(vg1 + (kt + 1) * 64); }
        ldsp kb_ = lds + (kt & 1) * BUF_B, vb_ = kb_ + KB_B;
        f32x16 p0, p1;
#pragma unroll
        for (int r = 0; r < 16; ++r) { p0[r] = 0.f; p1[r] = 0.f; }
#pragma unroll
        for (int s = 0; s < 4; ++s) {
          const bf16x8 k0 = *(const LAS bf16x8*)(kb_ + r32 * 144 + (16 * s + 8 * hi) * 2);
          const bf16x8 k1 = *(const LAS bf16x8*)(kb_ + (32 + r32) * 144 + (16 * s + 8 * hi) * 2);
          p0 = __builtin_amdgcn_mfma_f32_32x32x16_bf16(k0, qf[s], p0, 0, 0, 0);
          p1 = __builtin_amdgcn_mfma_f32_32x32x16_bf16(k1, qf[s], p1, 0, 0, 0);
        }
        float ls0 = 0.f, ls1 = 0.f;
#pragma unroll
        for (int r = 0; r < 16; ++r) { p0[r] = __builtin_amdgcn_exp2f(p0[r]); p1[r] = __builtin_amdgcn_exp2f(p1[r]); ls0 += p0[r]; ls1 += p1[r]; }
        lrun += ls0 + ls1;
        bf16x8 pf[2][2];
#pragma unroll
        for (int s2 = 0; s2 < 2; ++s2) {
          u32x4 a0, a1;
          a0.x = pk2(p0[8 * s2 + 0], p0[8 * s2 + 1]); a0.y = pk2(p0[8 * s2 + 2], p0[8 * s2 + 3]); a0.z = pk2(p0[8 * s2 + 4], p0[8 * s2 + 5]); a0.w = pk2(p0[8 * s2 + 6], p0[8 * s2 + 7]);
          a1.x = pk2(p1[8 * s2 + 0], p1[8 * s2 + 1]); a1.y = pk2(p1[8 * s2 + 2], p1[8 * s2 + 3]); a1.z = pk2(p1[8 * s2 + 4], p1[8 * s2 + 5]); a1.w = pk2(p1[8 * s2 + 6], p1[8 * s2 + 7]);
          pf[0][s2] = __builtin_bit_cast(bf16x8, a0); pf[1][s2] = __builtin_bit_cast(bf16x8, a1);
        }
#pragma unroll
        for (int kb2 = 0; kb2 < 2; ++kb2)
#pragma unroll
          for (int s2 = 0; s2 < 2; ++s2)
#pragma unroll
            for (int eb = 0; eb < 4; ++eb) {
              const bf16x8 vf = *(const LAS bf16x8*)(vb_ + (eb * 32 + r32) * 144 + (kb2 * 32 + 16 * s2 + 8 * hi) * 2);
              o[eb] = __builtin_amdgcn_mfma_f32_32x32x16_bf16(vf, pf[kb2][s2], o[eb], 0, 0, 0);
            }
        if (more) ATT_STORE(lds + ((kt + 1) & 1) * BUF_B);
        __syncthreads();
      }
#undef ATT_STORE
      const float inv = 1.f / (lrun + __shfl_xor(lrun, 32));
      float* orow = Og + (size_t)(qb * 256 + wid * 32 + r32) * 2048 + c * 128 + 4 * hi;
#pragma unroll
      for (int eb = 0; eb < 4; ++eb)
#pragma unroll
        for (int g4 = 0; g4 < 4; ++g4) *(f32x4*)(orow + eb * 32 + 8 * g4) = (f32x4){o[eb][4 * g4] * inv, o[eb][4 * g4 + 1] * inv, o[eb][4 * g4 + 2] * inv, o[eb][4 * g4 + 3] * inv};
    }
  }
  grid.sync();
  const float lam_init = 0.35550906759096926f;
  {
    const float s1 = wave_sum(p.in[I_LQ1][lane] * p.in[I_LK1][lane]), s2 = wave_sum(p.in[I_LQ2][lane] * p.in[I_LK2][lane]);
    const float lam = expf(s1) - expf(s2) + lam_init;
    const int h = lane >> 3, part = lane & 7;
    const float* Og = (const float*)(ws + OFF_O); const float* sub = p.in[I_SUBLN] + part * 16;
    for (int row = gw; row < SEQ; row += ngw) {
      const f32x4* o1 = (const f32x4*)(Og + (size_t)row * 2048 + (2 * h) * 128 + part * 16); const f32x4* o2 = o1 + 32;
      f32x4 v[4]; float ss = 0.f;
#pragma unroll
      for (int j = 0; j < 4; ++j) { v[j] = o1[j] - lam * o2[j]; ss += v[j].x * v[j].x + v[j].y * v[j].y + v[j].z * v[j].z + v[j].w * v[j].w; }
      ss += __shfl_xor(ss, 1); ss += __shfl_xor(ss, 2); ss += __shfl_xor(ss, 4);
      const float rs = (1.f - lam_init) / sqrtf(ss * (1.f / 128.f) + 1e-5f);
      u32x4 w0, w1;
      { const f32x4 g0 = ((const f32x4*)sub)[0], g1 = ((const f32x4*)sub)[1], g2 = ((const f32x4*)sub)[2], g3 = ((const f32x4*)sub)[3];
        w0.x = pk2(v[0].x * rs * g0.x, v[0].y * rs * g0.y); w0.y = pk2(v[0].z * rs * g0.z, v[0].w * rs * g0.w); w0.z = pk2(v[1].x * rs * g1.x, v[1].y * rs * g1.y); w0.w = pk2(v[1].z * rs * g1.z, v[1].w * rs * g1.w);
        w1.x = pk2(v[2].x * rs * g2.x, v[2].y * rs * g2.y); w1.y = pk2(v[2].z * rs * g2.z, v[2].w * rs * g2.w); w1.z = pk2(v[3].x * rs * g3.x, v[3].y * rs * g3.y); w1.w = pk2(v[3].z * rs * g3.z, v[3].w * rs * g3.w); }
      u32x4* op = (u32x4*)((bf16_t*)(ws + OFF_HX) + (size_t)row * 1024 + h * 128 + part * 16);
      op[0] = w0; op[1] = w1;
    }
  }
  grid.sync();
  {
    for (int tile = bid; tile < 256; tile += G) {
      const int pm = tile >> 2, pn = tile & 3;
      const bf16_t* A = (const bf16_t*)(ws + OFF_HX) + (size_t)pm * 256 * 1024;
      const bf16_t* B = (const bf16_t*)(ws + OFF_WDO) + (size_t)pn * 256 * 1024;
      const float* xin = (const float*)(ws + OFF_X1); float* xo = p.out; const float* gate = MODP(1, 0, 2);
      gemm_tile(lds, A, B, 1024, [](int r) { return r * 1024; }, [](int r) { return r * 1024; },
        [&](f32x4 (&acc)[8][4], int wr, int wc, int fr, int fq) {
          const int col0 = pn * 256 + wc * 64 + fr;
          float gt[4];
#pragma unroll
          for (int n = 0; n < 4; ++n) gt[n] = gate[col0 + n * 16];
#pragma unroll
          for (int m = 0; m < 8; ++m) {
            int r0 = pm * 256 + wr * 128 + m * 16 + fq * 4; EPI_FENCE(r0);
            const size_t base = (size_t)r0 * 1024 + col0;
#pragma unroll
            for (int j = 0; j < 4; ++j)
#pragma unroll
              for (int n = 0; n < 4; ++n) xo[base + j * 1024 + n * 16] = xin[base + j * 1024 + n * 16] + gt[n] * acc[m][n][j];
          }
        });
    }
  }
  grid.sync();
#if STOP_STAGE <= 15
  return;
#endif
  phase_router(1, SEQ);
  grid.sync();
  phase_topk(16);
  grid.sync();
  phase_gateup(1024);
  grid.sync();
  phase_down(512);
  grid.sync();
  phase_combine(1, SEQ, p.out, false);
}

extern "C" void kernel_launch(void* const* d_in, const int* in_sizes, int n_in, void* d_out, int out_size,
                              void* d_ws, size_t ws_size, hipStream_t stream) {
  static int grid_blocks = 0;
  if (!grid_blocks) {
    int dev = 0, cus = 0, per_cu = 0;
    (void)hipGetDevice(&dev);
    (void)hipDeviceGetAttribute(&cus, hipDeviceAttributeMultiprocessorCount, dev);
    (void)hipFuncSetAttribute((const void*)mega, hipFuncAttributeMaxDynamicSharedMemorySize, LDS_BYTES);
    (void)hipOccupancyMaxActiveBlocksPerMultiprocessor(&per_cu, mega, NT, LDS_BYTES);
    if (per_cu < 1) { fprintf(stderr, "occupancy query says %d\n", per_cu); per_cu = 1; }
    grid_blocks = cus * (per_cu > 1 ? 1 : per_cu);
    if (ws_size < WS_END) fprintf(stderr, "kernel_launch: workspace too small: %zu < %zu\n", ws_size, (size_t)WS_END);
  }
  if (ws_size < WS_END || n_in != 36) return;
  Params p{};
  for (int i = 0; i < 36; ++i) p.in[i] = (const float*)d_in[i];
  p.out = (float*)d_out; p.ws = (unsigned char*)d_ws;
  void* args[] = {&p};
  hipError_t e = hipLaunchCooperativeKernel((void*)mega, dim3(grid_blocks), dim3(NT), args, LDS_BYTES, stream);
  if (e != hipSuccess) fprintf(stderr, "cooperative launch failed: %s (grid %d)\n", hipGetErrorString(e), grid_blocks);
}
```

```cpp
#include <hip/hip_runtime.h>
#include <hip/hip_cooperative_groups.h>
#include <cstdio>
#include <cstdint>
namespace cg = cooperative_groups;

#ifndef PH_MASK
#define PH_MASK 0xffffffffu
#endif
#ifndef REP_P2
#define REP_P2 1
#endif
#ifndef REP_P3
#define REP_P3 1
#endif
#ifndef REP_P13
#define REP_P13 1
#endif
#ifndef REP_MOE
#define REP_MOE 1
#endif
#ifdef DIAG_NOCONV
#define DIAG_Y(y) y = v4mk(0.f, 0.f, 0.f, 0.f)
#else
#define DIAG_Y(y)
#endif
#ifndef STOP_STAGE
#define STOP_STAGE 99
#endif

#define LAS __attribute__((address_space(3)))
typedef LAS unsigned char* ldsp;
typedef unsigned short bf16_t;
typedef short bf16x8 __attribute__((ext_vector_type(8)));
typedef short s16x4 __attribute__((ext_vector_type(4)));
typedef float f32x4 __attribute__((ext_vector_type(4)));
typedef float f32x2 __attribute__((ext_vector_type(2)));
typedef float f32x16 __attribute__((ext_vector_type(16)));
typedef unsigned u32x4 __attribute__((ext_vector_type(4)));
typedef unsigned u32x2 __attribute__((ext_vector_type(2)));
typedef __bf16 bf16x2_t __attribute__((ext_vector_type(2)));
typedef _Float16 h16;
typedef _Float16 h16x2 __attribute__((ext_vector_type(2)));
typedef _Float16 h16x4 __attribute__((ext_vector_type(4)));

constexpr int NT = 512;
constexpr int LDS_BYTES = 147456;
constexpr int SEQ = 16384, CTX = 256, DM = 1024, NKEY = SEQ + CTX;
constexpr size_t MiB = 1u << 20;
constexpr size_t OFF_MODS = 0;
constexpr size_t OFF_BAR = 104 * 1024;
constexpr size_t OFF_ROPE = 160 * 1024;
constexpr size_t OFF_HIDX = 1 * MiB;
constexpr size_t OFF_HIDC = 3 * MiB;
constexpr size_t OFF_W4T = 3 * MiB + 512 * 1024;
constexpr size_t OFF_WIN = 4 * MiB;
constexpr size_t OFF_WHO = 10 * MiB;
constexpr size_t OFF_WQKV = 12 * MiB;
constexpr size_t OFF_WDO = 18 * MiB;
constexpr size_t OFF_KCTX = 20 * MiB;
constexpr size_t OFF_AFF = 24 * MiB;
constexpr size_t OFF_SELI = 26 * MiB;
constexpr size_t OFF_SELG = 26 * MiB + 256 * 1024;
constexpr size_t OFF_SLOT = 26 * MiB + 512 * 1024;
constexpr size_t OFF_CTXMID = 28 * MiB;
constexpr size_t OFF_HC = 30 * MiB;
constexpr size_t OFF_UCT = 31 * MiB;
constexpr size_t OFF_HCT = 33 * MiB;
constexpr size_t OFF_ZC2T = 35 * MiB;
constexpr size_t OFF_ZC2 = 35 * MiB + 512 * 1024;
constexpr size_t OFF_ACTC = 36 * MiB;
constexpr size_t OFF_YBC = 44 * MiB;
constexpr size_t OFF_HX = 56 * MiB;
constexpr size_t OFF_HT = 88 * MiB;
constexpr size_t OFF_WGU = 88 * MiB, OFF_WD = 152 * MiB;
constexpr size_t OFF_KSPEC = 216 * MiB;
constexpr size_t OFF_ACT = 216 * MiB, OFF_YB = 280 * MiB, OFF_O = 216 * MiB;
constexpr size_t OFF_UT = 344 * MiB;
constexpr size_t OFF_X1 = 344 * MiB;
constexpr size_t OFF_Q = 408 * MiB;
constexpr size_t OFF_Z2T = 440 * MiB;
constexpr size_t OFF_KALL = 440 * MiB;
constexpr size_t OFF_VT = 473 * MiB;
constexpr size_t WS_END = 506 * MiB;

struct Params { const float* in[36]; float* out; unsigned char* ws; };
enum { I_X = 0, I_C, I_CTX, I_CCTX, I_ADAW, I_ADAB, I_NMIX, I_NFFN, I_HWIN, I_HBIN, I_HCW, I_HCB, I_FW1, I_FB1, I_FW2, I_FB2, I_FW3, I_FB3, I_FW4, I_FFREQ,
       I_HSKIP, I_HWOUT, I_HBOUT, I_DWQKV, I_DQN, I_DKN, I_LQ1, I_LK1, I_LQ2, I_LK2, I_SUBLN, I_DWOUT, I_ROUTER, I_WG, I_WU, I_WDN };

__device__ __forceinline__ unsigned f2bf(float f) { unsigned u = __builtin_bit_cast(unsigned, f); return (u + 0x7fffu + ((u >> 16) & 1u)) >> 16; }
__device__ __forceinline__ float bf2f(unsigned b) { return __builtin_bit_cast(float, b << 16); }
__device__ __forceinline__ unsigned pk2(float lo, float hi) { f32x2 v = {lo, hi}; bf16x2_t b = __builtin_convertvector(v, bf16x2_t); return __builtin_bit_cast(unsigned, b); }
__device__ __forceinline__ float wave_sum(float v) {
#pragma unroll
  for (int o = 1; o < 64; o <<= 1) v += __shfl_xor(v, o);
  return v;
}
__device__ __forceinline__ float siluf(float x) { return x / (1.f + __expf(-x)); }

#define FFT_HD __device__ __forceinline__
#define FFT_LDS LAS
#define EPI_FENCE(v) asm volatile("" : "+v"(v) :: "memory")
#define FFT_OPAQUE(v) asm volatile("" : "+v"(v))
__device__ __forceinline__ float fft_sin_rev(float x) { return __builtin_amdgcn_sinf(x); }
__device__ __forceinline__ float fft_cos_rev(float x) { return __builtin_amdgcn_cosf(x); }
typedef float v2 __attribute__((ext_vector_type(2)));
typedef float v4 __attribute__((ext_vector_type(4)));
__device__ __forceinline__ v2 v2mk(float a, float b) { v2 r; r.x = a; r.y = b; return r; }
__device__ __forceinline__ v4 v4mk(float a, float b, float c, float d) { v4 r; r.x = a; r.y = b; r.z = c; r.w = d; return r; }
struct cf { float x, y; };
FFT_HD cf cmk(float a, float b) { cf r; r.x = a; r.y = b; return r; }
FFT_HD cf cadd(cf a, cf b) { return cmk(a.x + b.x, a.y + b.y); }
FFT_HD cf csub(cf a, cf b) { return cmk(a.x - b.x, a.y - b.y); }
FFT_HD cf cmul(cf a, cf b) { return cmk(a.x * b.x - a.y * b.y, a.x * b.y + a.y * b.x); }
FFT_HD cf cconj(cf a) { return cmk(a.x, -a.y); }
constexpr int FFT_M = 16384;
FFT_HD int fft_padp(int pp) { return pp + ((pp >> 5) << 1); }
constexpr int FFT_LDS_SLOTS = FFT_M / 2 + (FFT_M >> 6) * 2;
struct cp { v2 re, im; };
FFT_HD cp cpadd(cp a, cp b) { cp r; r.re = a.re + b.re; r.im = a.im + b.im; return r; }
FFT_HD cp cpsub(cp a, cp b) { cp r; r.re = a.re - b.re; r.im = a.im - b.im; return r; }
FFT_HD cp cpmul(cp a, cp b) { cp r; r.re = a.re * b.re - a.im * b.im; r.im = a.re * b.im + a.im * b.re; return r; }
FFT_HD cp cpmulc(cp a, float cr, float ci) { cp r; r.re = a.re * cr - a.im * ci; r.im = a.re * ci + a.im * cr; return r; }

template <bool INV> FFT_HD void dft4(cf& a, cf& b, cf& c, cf& d) {
  cf s0 = cadd(a, c), s1 = csub(a, c), s2 = cadd(b, d), s3 = csub(b, d);
  cf r = INV ? cmk(-s3.y, s3.x) : cmk(s3.y, -s3.x);
  a = cadd(s0, s2); c = csub(s0, s2); b = cadd(s1, r); d = csub(s1, r);
}
template <bool INV> FFT_HD void dft4p(cp& a, cp& b, cp& c, cp& d) {
  cp s0 = cpadd(a, c), s1 = cpsub(a, c), s2 = cpadd(b, d), s3 = cpsub(b, d);
  a = cpadd(s0, s2); c = cpsub(s0, s2);
  if (!INV) { b.re = s1.re + s3.im; b.im = s1.im - s3.re; d.re = s1.re - s3.im; d.im = s1.im + s3.re; }
  else      { b.re = s1.re - s3.im; b.im = s1.im + s3.re; d.re = s1.re + s3.im; d.im = s1.im - s3.re; }
}
template <bool INV> FFT_HD void dft16p(cp (&x)[16]) {
#pragma unroll
  for (int n2 = 0; n2 < 4; ++n2) dft4p<INV>(x[n2], x[4 + n2], x[8 + n2], x[12 + n2]);
  const float C1 = 0.92387953251128674f, S1 = 0.38268343236508977f, C2 = 0.70710678118654752f;
#define TW(i, cr, ci) x[i] = cpmulc(x[i], cr, INV ? -(ci) : (ci))
  TW(4 + 1, C1, -S1); TW(4 + 2, C2, -C2); TW(4 + 3, S1, -C1);
  TW(8 + 1, C2, -C2); TW(8 + 2, 0.f, -1.f); TW(8 + 3, -C2, -C2);
  TW(12 + 1, S1, -C1); TW(12 + 2, -C2, -C2); TW(12 + 3, -C1, S1);
#undef TW
#pragma unroll
  for (int k1 = 0; k1 < 4; ++k1) dft4p<INV>(x[4 * k1], x[4 * k1 + 1], x[4 * k1 + 2], x[4 * k1 + 3]);
}
template <bool INV, int NP> FFT_HD void fft2_bfly16(FFT_LDS v4* A4, int t) {
  constexpr int S = NP / 16, S2 = S / 2;
  constexpr int STR = (S2 >= 32) ? S2 + (S2 >> 5) * 2 : S2;
  FFT_OPAQUE(t);
  const int blk = t / S2, jp = t % S2, j = 2 * jp;
  FFT_LDS v4* ap = A4 + fft_padp((blk * NP + j) >> 1);
  cp w1;
  { const float f0 = (float)j * (1.0f / NP), f1 = (float)(j + 1) * (1.0f / NP);
    w1.re = v2mk(fft_cos_rev(f0), fft_cos_rev(f1));
    w1.im = INV ? v2mk(fft_sin_rev(f0), fft_sin_rev(f1)) : v2mk(-fft_sin_rev(f0), -fft_sin_rev(f1)); }
  cp x[16];
  if (!INV) {
#pragma unroll
    for (int q = 0; q < 16; ++q) { const v4 v = ap[q * STR]; x[q].re = v2mk(v.x, v.y); x[q].im = v2mk(v.z, v.w); }
    dft16p<false>(x);
    cp wq = w1;
#pragma unroll
    for (int q = 0; q < 16; ++q) {
      cp v = x[4 * (q & 3) + (q >> 2)];
      if (q > 0) { v = cpmul(v, wq); if (q < 15) wq = cpmul(wq, w1); }
      ap[q * STR] = v4mk(v.re.x, v.re.y, v.im.x, v.im.y);
    }
  } else {
    cp wq = w1;
#pragma unroll
    for (int q = 0; q < 16; ++q) {
      const v4 t4 = ap[q * STR]; cp v; v.re = v2mk(t4.x, t4.y); v.im = v2mk(t4.z, t4.w);
      if (q > 0) { v = cpmul(v, wq); if (q < 15) wq = cpmul(wq, w1); }
      x[q] = v;
    }
    dft16p<true>(x);
#pragma unroll
    for (int q = 0; q < 16; ++q) { const cp v = x[4 * (q & 3) + (q >> 2)]; ap[q * STR] = v4mk(v.re.x, v.re.y, v.im.x, v.im.y); }
  }
}
template <bool INV> FFT_HD cp fft2_w1_first(int t) {
  const int j = 2 * t; const float f0 = (float)j * (1.0f / FFT_M), f1 = (float)(j + 1) * (1.0f / FFT_M);
  cp w1; w1.re = v2mk(fft_cos_rev(f0), fft_cos_rev(f1)); w1.im = INV ? v2mk(fft_sin_rev(f0), fft_sin_rev(f1)) : v2mk(-fft_sin_rev(f0), -fft_sin_rev(f1)); return w1;
}
FFT_HD void fft2_first_fwd_regs(FFT_LDS v4* A4, int t, cp (&x)[16]) {
  FFT_OPAQUE(t);
  FFT_LDS v4* ap = A4 + fft_padp(t);
  const cp w1 = fft2_w1_first<false>(t);
  dft16p<false>(x);
  cp wq = w1;
#pragma unroll
  for (int q = 0; q < 16; ++q) {
    cp v = x[4 * (q & 3) + (q >> 2)];
    if (q > 0) { v = cpmul(v, wq); if (q < 15) wq = cpmul(wq, w1); }
    ap[q * 544] = v4mk(v.re.x, v.re.y, v.im.x, v.im.y);
  }
}
FFT_HD void fft2_last_inv_regs(FFT_LDS v4* A4, int t, cp (&x)[16]) {
  FFT_OPAQUE(t);
  FFT_LDS v4* ap = A4 + fft_padp(t);
  const cp w1 = fft2_w1_first<true>(t);
  cp wq = w1;
#pragma unroll
  for (int q = 0; q < 16; ++q) {
    const v4 t4 = ap[q * 544]; cp v; v.re = v2mk(t4.x, t4.y); v.im = v2mk(t4.z, t4.w);
    if (q > 0) { v = cpmul(v, wq); if (q < 15) wq = cpmul(wq, w1); }
    x[q] = v;
  }
  dft16p<true>(x);
}
FFT_HD int fft_kbase_of_group(int g) { return (g >> 8) | (((g >> 4) & 15) << 4) | ((g & 15) << 8); }
FFT_HD int fft_group_of_kbase(int kb) { return ((kb & 15) << 8) | (((kb >> 4) & 15) << 4) | (kb >> 8); }
FFT_HD void rfft_unpack(cf Ck, cf Cm, float wr, float wi, cf& Ak, cf& Am) {
  cf E = cmk(0.5f * (Ck.x + Cm.x), 0.5f * (Ck.y - Cm.y));
  cf T = cmk(0.5f * (Ck.x - Cm.x), 0.5f * (Ck.y + Cm.y));
  cf O = cmk(T.y, -T.x);
  cf wO = cmul(cmk(wr, wi), O);
  Ak = cadd(E, wO); Am = cconj(csub(E, wO));
}
FFT_HD void rfft_pack(cf Yk, cf Ym, float wr, float wi, cf& Ck, cf& Cm) {
  cf E = cmk(0.5f * (Yk.x + Ym.x), 0.5f * (Yk.y - Ym.y));
  cf D = cmk(0.5f * (Yk.x - Ym.x), 0.5f * (Yk.y + Ym.y));
  cf O = cmul(cmk(wr, -wi), D);
  Ck = cmk(E.x - O.y, E.y + O.x);
  Cm = cmk(E.x + O.y, -E.y + O.x);
}
FFT_HD void fft2_ldg(FFT_LDS v4* A4, int g, cf (&x)[4]) { const int s = fft_padp(2 * g); const v4 a = A4[s], b = A4[s + 1]; x[0] = cmk(a.x, a.z); x[1] = cmk(a.y, a.w); x[2] = cmk(b.x, b.z); x[3] = cmk(b.y, b.w); }
FFT_HD void fft2_stg(FFT_LDS v4* A4, int g, const cf (&x)[4]) { const int s = fft_padp(2 * g); A4[s] = v4mk(x[0].x, x[1].x, x[0].y, x[1].y); A4[s + 1] = v4mk(x[2].x, x[3].x, x[2].y, x[3].y); }
FFT_HD void fft2_pair(cf& Xk, cf& Xm, int k, cf Kk, cf Km) {
  const float fr = (float)k * (1.0f / (2 * FFT_M)); const float wr = fft_cos_rev(fr), wi = -fft_sin_rev(fr);
  cf Ak, Am; rfft_unpack(Xk, Xm, wr, wi, Ak, Am);
  rfft_pack(cmul(Ak, Kk), cmul(Am, Km), wr, wi, Xk, Xm);
}
template <class LD> FFT_HD void fft2_mid_conv(FFT_LDS v4* A4, int a, LD ld) {
  FFT_OPAQUE(a);
  const int g = (a & 7) | ((a >> 3) << 4);
  cf x[4];
  if (a != 0) {
    const int kb = fft_kbase_of_group(g), kbm = 4096 - kb, gm = fft_group_of_kbase(kbm);
    cf y[4];
    fft2_ldg(A4, g, x); fft2_ldg(A4, gm, y);
    dft4<false>(x[0], x[1], x[2], x[3]); dft4<false>(y[0], y[1], y[2], y[3]);
#pragma unroll
    for (int d = 0; d < 4; ++d) fft2_pair(x[d], y[3 - d], kb + 4096 * d, ld(4 * g + d), ld(4 * gm + 3 - d));
    dft4<true>(x[0], x[1], x[2], x[3]); dft4<true>(y[0], y[1], y[2], y[3]);
    fft2_stg(A4, g, x); fft2_stg(A4, gm, y);
  } else {
    fft2_ldg(A4, 0, x); dft4<false>(x[0], x[1], x[2], x[3]);
    { const cf K0 = ld(0); const float Y0 = (x[0].x + x[0].y) * K0.x, YM = (x[0].x - x[0].y) * K0.y; x[0] = cmk(0.5f * (Y0 + YM), 0.5f * (Y0 - YM)); }
    fft2_pair(x[1], x[3], 4096, ld(1), ld(3));
    { const cf Y = cmul(cconj(x[2]), ld(2)); x[2] = cconj(Y); }
    dft4<true>(x[0], x[1], x[2], x[3]); fft2_stg(A4, 0, x);
    fft2_ldg(A4, 8, x); dft4<false>(x[0], x[1], x[2], x[3]);
    fft2_pair(x[0], x[3], 2048, ld(32), ld(35)); fft2_pair(x[1], x[2], 6144, ld(33), ld(34));
    dft4<true>(x[0], x[1], x[2], x[3]); fft2_stg(A4, 8, x);
  }
}
FFT_HD void fft2_fpair(cf Xk, cf Xm, int k, float scale, cf& Kk, cf& Km) {
  const float fr = (float)k * (1.0f / (2 * FFT_M));
  cf Ak, Am; rfft_unpack(Xk, Xm, fft_cos_rev(fr), -fft_sin_rev(fr), Ak, Am);
  Kk = cmk(Ak.x * scale, Ak.y * scale); Km = cmk(Am.x * scale, Am.y * scale);
}
template <class ST> FFT_HD void fft2_mid_filter(FFT_LDS v4* A4, int a, float scale, ST st) {
  FFT_OPAQUE(a);
  const int g = (a & 7) | ((a >> 3) << 4);
  cf x[4], Kk, Km;
  if (a != 0) {
    const int kb = fft_kbase_of_group(g), kbm = 4096 - kb, gm = fft_group_of_kbase(kbm);
    cf y[4];
    fft2_ldg(A4, g, x); fft2_ldg(A4, gm, y);
    dft4<false>(x[0], x[1], x[2], x[3]); dft4<false>(y[0], y[1], y[2], y[3]);
#pragma unroll
    for (int d = 0; d < 4; ++d) { fft2_fpair(x[d], y[3 - d], kb + 4096 * d, scale, Kk, Km); st(4 * g + d, Kk); st(4 * gm + 3 - d, Km); }
  } else {
    fft2_ldg(A4, 0, x); dft4<false>(x[0], x[1], x[2], x[3]);
    st(0, cmk((x[0].x + x[0].y) * scale, (x[0].x - x[0].y) * scale));
    fft2_fpair(x[1], x[3], 4096, scale, Kk, Km); st(1, Kk); st(3, Km);
    st(2, cmk(x[2].x * scale, -x[2].y * scale));
    fft2_ldg(A4, 8, x); dft4<false>(x[0], x[1], x[2], x[3]);
    fft2_fpair(x[0], x[3], 2048, scale, Kk, Km); st(32, Kk); st(35, Km);
    fft2_fpair(x[1], x[2], 6144, scale, Kk, Km); st(33, Kk); st(34, Km);
  }
}

__device__ __forceinline__ int lds_byte2(int r, int c) { int st = (r >> 4) * 2 + (c >> 5), ob = (r & 15) * 64 + (c & 31) * 2; return st * 1024 + (ob ^ (((ob >> 9) & 1) << 5)); }
__device__ __forceinline__ void stage_rc2(int b, int& R, int& C) { int st = b >> 10, sb = b & 1023, swz = sb ^ (((sb >> 9) & 1) << 5); R = (st >> 1) * 16 + swz / 64; C = (st & 1) * 32 + (swz % 64) / 2; }

struct TileSrc { const bf16_t* A; const bf16_t* B; const int* gidx; int lda, ldb, gmask; };
__device__ __forceinline__ void gemm_offsets(const TileSrc& ts, unsigned (&oa)[4], unsigned (&ob)[4]) {
  const int tid = threadIdx.x, wid = __builtin_amdgcn_readfirstlane(tid >> 6), lane = tid & 63;
#pragma unroll
  for (int i = 0; i < 4; ++i) { int R, C; stage_rc2(wid * 1024 + i * 8192 + lane * 16, R, C);
    const int ra = ts.gidx ? ts.gidx[R & ts.gmask] : R;
    oa[i] = (unsigned)(ra * ts.lda + C) * 2u; ob[i] = (unsigned)(R * ts.ldb + C) * 2u; }
}
#define G_STAGE(ts_, oa_, ob_, buf, kt) do { const int wid_ = __builtin_amdgcn_readfirstlane(threadIdx.x >> 6); const char* ga = (const char*)((ts_).A + (kt) * 64); const char* gb = (const char*)((ts_).B + (kt) * 64); _Pragma("unroll") for (int i = 0; i < 4; ++i) { \
    __builtin_amdgcn_global_load_lds((const unsigned*)(ga + (oa_)[i]), (LAS unsigned*)(shm + (buf) * 65536 + wid_ * 1024 + i * 8192), 16, 0, 0); \
    __builtin_amdgcn_global_load_lds((const unsigned*)(gb + (ob_)[i]), (LAS unsigned*)(shm + (buf) * 65536 + 32768 + wid_ * 1024 + i * 8192), 16, 0, 0); } } while (0)
__device__ __forceinline__ void gemm_issue0(ldsp shm, const TileSrc& ts) { unsigned oa[4], ob[4]; gemm_offsets(ts, oa, ob); G_STAGE(ts, oa, ob, 0, 0); }
template <bool TRANS, class EP, class PF>
__device__ __forceinline__ void gemm_tile(ldsp shm, const TileSrc& ts, int K, bool pre_issued, PF prefetch_next, EP epi) {
  constexpr int TILE_B = 32768, STAGE_B = 65536;
  const int tid = threadIdx.x, wid = __builtin_amdgcn_readfirstlane(tid >> 6), lane = tid & 63, wr = wid >> 2, wc = wid & 3, fr = lane & 15, fq = lane >> 4;
  unsigned oa[4], ob[4];
  gemm_offsets(ts, oa, ob);
  f32x4 acc[8][4];
#pragma unroll
  for (int m = 0; m < 8; ++m)
#pragma unroll
    for (int n = 0; n < 4; ++n) acc[m][n] = (f32x4){0.f, 0.f, 0.f, 0.f};
  const int aoff = lds_byte2(wr * 128 + fr, fq * 8), boff = TILE_B + lds_byte2(wc * 64 + fr, fq * 8);
  const int nt = K / 64;
  if (!pre_issued) G_STAGE(ts, oa, ob, 0, 0);
  asm volatile("s_waitcnt vmcnt(0)" ::: "memory"); __syncthreads();
  for (int t = 0; t < nt; ++t) {
    const int cur = t & 1;
    if (t + 1 < nt) G_STAGE(ts, oa, ob, cur ^ 1, t + 1);
    ldsp sa = shm + cur * STAGE_B;
#pragma unroll
    for (int ks = 0; ks < 2; ++ks) {
      bf16x8 At[8], Bf[4];
#pragma unroll
      for (int m = 0; m < 8; ++m) At[m] = *(const LAS bf16x8*)(sa + aoff + m * 2048 + ks * 1024);
#pragma unroll
      for (int n = 0; n < 4; ++n) Bf[n] = *(const LAS bf16x8*)(sa + boff + n * 2048 + ks * 1024);
#pragma unroll
      for (int m = 0; m < 8; ++m)
#pragma unroll
        for (int n = 0; n < 4; ++n) acc[m][n] = TRANS ? __builtin_amdgcn_mfma_f32_16x16x32_bf16(Bf[n], At[m], acc[m][n], 0, 0, 0) : __builtin_amdgcn_mfma_f32_16x16x32_bf16(At[m], Bf[n], acc[m][n], 0, 0, 0);
      __builtin_amdgcn_sched_barrier(0);
    }
    asm volatile("s_waitcnt vmcnt(0)" ::: "memory"); __syncthreads();
  }
  prefetch_next();
  epi(acc, wr, wc, fr, fq);
}

namespace pg8 {
#define PG8_LAS __attribute__((address_space(3)))
constexpr int BM = 256, BK = 64, HALF = 128, HTB = HALF * BK * 2  , STAGE_BYTES = 8 * HTB;
__device__ __forceinline__ int lds_byte(int r, int c) { const int st = (r >> 4) * 2 + (c >> 5), rr = r & 15, cc = c & 31, ob = rr * 64 + cc * 2; return st * 1024 + (ob ^ (((ob >> 9) & 1) << 5)); }
__device__ __forceinline__ void stage_rc(int b, int& R, int& C) { const int st = b / 1024, sb = b % 1024, swz = sb ^ (((sb >> 9) & 1) << 5); R = (st >> 1) * 16 + swz / 64; C = (st & 1) * 32 + (swz % 64) / 2; }
__device__ __forceinline__ int perm32(int rho) { const int n = rho >> 4, i = rho & 15; return 8 * (i >> 2) + 4 * n + (i & 3); }
struct Unit { const char* A; const char* B; int pm, pn, e, kind; const int* arow; int nvalid; };
template <class F> struct EpiFn { static constexpr bool PERM = false, AFTER_DRAIN = false; F f;
  __device__ __forceinline__ void operator()(const f32x4 (&acc)[2][2][4][2], const Unit& u, int wr, int wc, int fr, int fq) const { f(acc, u, wr, wc, fr, fq); } };
template <class F> struct SchedFn { F f; int G, c;
  __device__ __forceinline__ bool next(int i, Unit& u) const { return f(i * G + c, u); }
  __device__ __forceinline__ void a_ready(const Unit&) const {}
  __device__ __forceinline__ void done(const Unit&) const {} };
template <class Epi, class Sched, bool ALIGN_EPI = false, bool SP2 = false, bool GATHER = false>
__device__ __forceinline__ void gemm_phase(PG8_LAS unsigned char* lds, const int K, const Sched& S, const Epi& E) {
    const int tid = threadIdx.x, wid = __builtin_amdgcn_readfirstlane(tid >> 6), lane = tid & 63, wr = wid >> 2, wc = wid & 3, fr = lane & 15, fq = lane >> 4;
    const int nt = K / BK;
    static_assert(!Epi::PERM, "row-permuted B staging is not kept in this copy");
    int RA0, CA0; stage_rc(tid * 16, RA0, CA0);
    const unsigned voff0 = (unsigned)(RA0 * K + CA0) * 2u;
    const size_t istep = (size_t)64 * K * 2;
    unsigned vg[2][2], vn[2][2];
    PG8_LAS int* gidx = (PG8_LAS int*)(lds + STAGE_BYTES) + RA0;
    if constexpr (GATHER) {
        Unit tu;
        _Pragma("unroll 1") for (int u_ = 0; u_ < 8 && S.next(u_, tu); ++u_) if (tid < 256) ((PG8_LAS int*)(lds + STAGE_BYTES))[u_ * 256 + tid] = tid < tu.nvalid ? tu.arow[tid] : 0;
        __syncthreads();
#pragma unroll
        for (int h = 0; h < 2; ++h)
#pragma unroll
            for (int i = 0; i < 2; ++i) { vg[h][i] = ((unsigned)gidx[h * 128 + i * 64] * (unsigned)K + (unsigned)CA0) * 2u; vn[h][i] = vg[h][i]; }
    }
    const size_t kstep = (size_t)(BK * 2);
    const size_t hstep = (size_t)HALF * K * 2;
    const size_t tstep = 2 * hstep;
    const unsigned ldsw = (unsigned)wid * 1024u;
    const int aoff = lds_byte(wr * 64 + fr, fq * 8), boff = lds_byte(wc * 32 + fr, fq * 8);
#define PG8_SA(b, h) (((b) * 2 + (h)) * HTB)
#define PG8_SB(b, h) ((4 + (b) * 2 + (h)) * HTB)
#define PG8_LD1(bufoff, gptr, vo) do { unsigned _vo = (vo); asm volatile("" : "+v"(_vo));   \
        __builtin_amdgcn_global_load_lds((const unsigned*)((const char*)(gptr) + _vo), (PG8_LAS unsigned*)(lds + (bufoff) + ldsw), 16, 0, 0); } while (0)
#define PG8_STAGE(bufoff, gbase, voff_unused) do { PG8_LD1(bufoff, gbase, voff0); PG8_LD1((bufoff) + 8192, (const char*)(gbase) + istep, voff0); } while (0)
#define PG8_STAGE2(bufoff, gbase, va, vb) do { PG8_LD1(bufoff, gbase, va); PG8_LD1((bufoff) + 8192, gbase, vb); } while (0)
#define PG8_STAGE_A(b, h, gbase) do { if constexpr (GATHER) { PG8_STAGE2(PG8_SA(b, h), gbase, vg[h][0], vg[h][1]); } else { PG8_STAGE(PG8_SA(b, h), (gbase) + (h) * hstep, voffA); } } while (0)
#define PG8_LDA(dst, b, h) do { _Pragma("unroll") for (int m = 0; m < 4; ++m) _Pragma("unroll") for (int k = 0; k < 2; ++k) dst[m][k] = *(const PG8_LAS bf16x8*)(lds + PG8_SA(b, h) + aoff + m * 2048 + k * 1024); } while (0)
#define PG8_LDB(dst, b, h) do { _Pragma("unroll") for (int n = 0; n < 2; ++n) _Pragma("unroll") for (int k = 0; k < 2; ++k) dst[n][k] = *(const PG8_LAS bf16x8*)(lds + PG8_SB(b, h) + boff + n * 2048 + k * 1024); } while (0)
#define PG8_MMA(ai, bj, At, Bt) do { __builtin_amdgcn_s_setprio(1); _Pragma("unroll") for (int m = 0; m < 4; ++m) _Pragma("unroll") for (int n = 0; n < 2; ++n) _Pragma("unroll") for (int k = 0; k < 2; ++k) \
        acc[ai][bj][m][n] = __builtin_amdgcn_mfma_f32_16x16x32_bf16(Bt[n][k], At[m][k], acc[ai][bj][m][n], 0, 0, 0); __builtin_amdgcn_s_setprio(0); } while (0)
#define PG8_WAIT_V(n) asm volatile("s_waitcnt vmcnt(" #n ")" ::: "memory")
#define PG8_WAIT_L(n) asm volatile("s_waitcnt lgkmcnt(" #n ")" ::: "memory")
#define PG8_BAR __builtin_amdgcn_s_barrier()
#define PG8_SCHED __builtin_amdgcn_sched_barrier(0)
    Unit cur, nxt; int ui = 0;
    if (!S.next(0, cur)) return;
    f32x4 acc[2][2][4][2];
#pragma unroll
    for (int a = 0; a < 2; ++a)
#pragma unroll
        for (int b = 0; b < 2; ++b)
#pragma unroll
            for (int m = 0; m < 4; ++m)
#pragma unroll
                for (int n = 0; n < 2; ++n) acc[a][b][m][n] = (f32x4){0.f, 0.f, 0.f, 0.f};
    bf16x8 At[4][2], B0[2][2], B1[2][2];
    const char* cA = cur.A; const char* cB = cur.B;
    S.a_ready(cur);
    if constexpr (SP2) {
        PG8_STAGE(PG8_SB(0, 0), cB, voffB); PG8_STAGE(PG8_SB(0, 1), cB + hstep, voffB); PG8_STAGE_A(0, 0, cA); PG8_STAGE_A(0, 1, cA);
        if (wr == 1) PG8_BAR;
        PG8_WAIT_V(2); PG8_BAR;
        PG8_STAGE(PG8_SB(1, 0), cB + kstep, voffB); PG8_STAGE_A(1, 0, cA + kstep); PG8_STAGE(PG8_SB(1, 1), cB + hstep + kstep, voffB);
        PG8_WAIT_V(6); PG8_BAR;
    } else {
        PG8_STAGE(PG8_SB(0, 0), cB, voffB); PG8_STAGE(PG8_SA(0, 0), cA, voffA); PG8_STAGE(PG8_SB(0, 1), cB + hstep, voffB); PG8_STAGE(PG8_SA(0, 1), cA + hstep, voffA);
        if (wr == 1) PG8_BAR;
        PG8_WAIT_V(4); PG8_BAR;
        PG8_STAGE(PG8_SB(1, 0), cB + kstep, voffB); PG8_STAGE(PG8_SA(1, 0), cA + kstep, voffA); PG8_STAGE(PG8_SB(1, 1), cB + hstep + kstep, voffB);
        PG8_WAIT_V(6); PG8_BAR;
    }
    for (;;) {
        const bool has_next = S.next(ui + 1, nxt);
        const char* nA = has_next ? nxt.A : cA; const char* nB = has_next ? nxt.B : cB;
        if constexpr (GATHER) { if (has_next) {
            _Pragma("unroll") for (int h = 0; h < 2; ++h) _Pragma("unroll") for (int i = 0; i < 2; ++i) vn[h][i] = ((unsigned)gidx[(ui + 1) * 256 + h * 128 + i * 64] * (unsigned)K + (unsigned)CA0) * 2u; } }
        for (int t = 0; t < nt; t += 2) {
            const bool last = (t == nt - 2);
            const char* a1 = cA + (size_t)(t + 1) * kstep;
            const char* a2 = last ? nA : cA + (size_t)(t + 2) * kstep; const char* b2 = last ? nB : cB + (size_t)(t + 2) * kstep;
            const char* a3 = a2 + kstep; const char* b3 = b2 + kstep;
            if (last && has_next) S.a_ready(nxt);
            if constexpr (SP2) {
            PG8_LDB(B0, 0, 0); PG8_LDB(B1, 0, 1); PG8_SCHED; PG8_LDA(At, 0, 0); PG8_STAGE_A(1, 1, a1);
            if constexpr (GATHER) { if (last) {
              _Pragma("unroll") for (int h = 0; h < 2; ++h) _Pragma("unroll") for (int i = 0; i < 2; ++i) vg[h][i] = vn[h][i]; } }
            PG8_WAIT_V(8); PG8_WAIT_L(0); PG8_BAR; PG8_MMA(0, 0, At, B0); PG8_MMA(0, 1, At, B1); PG8_BAR; PG8_SCHED;
            PG8_LDA(At, 0, 1); PG8_STAGE(PG8_SB(0, 0), b2, voffB); PG8_STAGE(PG8_SB(0, 1), b2 + hstep, voffB); PG8_STAGE_A(0, 0, a2);
            PG8_WAIT_V(8); PG8_WAIT_L(0); PG8_BAR; PG8_MMA(1, 0, At, B0); PG8_MMA(1, 1, At, B1); PG8_BAR; PG8_SCHED;
            PG8_LDB(B0, 1, 0); PG8_LDB(B1, 1, 1); PG8_SCHED; PG8_LDA(At, 1, 0); PG8_STAGE_A(0, 1, a2);
            PG8_WAIT_V(8); PG8_WAIT_L(0); PG8_BAR; PG8_MMA(0, 0, At, B0); PG8_MMA(0, 1, At, B1); PG8_BAR; PG8_SCHED;
            PG8_LDA(At, 1, 1); PG8_STAGE(PG8_SB(1, 0), b3, voffB); PG8_STAGE(PG8_SB(1, 1), b3 + hstep, voffB); PG8_STAGE_A(1, 0, a3);
            PG8_WAIT_V(8); PG8_WAIT_L(0); PG8_BAR; PG8_MMA(1, 0, At, B0); PG8_MMA(1, 1, At, B1); PG8_BAR; PG8_SCHED;
            } else {
            PG8_LDB(B0, 0, 0); PG8_SCHED; PG8_LDA(At, 0, 0); PG8_STAGE(PG8_SA(1, 1), a1 + hstep, voffA);
            PG8_WAIT_L(8); PG8_BAR; PG8_WAIT_L(0); PG8_MMA(0, 0, At, B0); PG8_BAR; PG8_SCHED;
            PG8_LDB(B1, 0, 1); PG8_STAGE(PG8_SB(0, 0), b2, voffB);
            PG8_BAR; PG8_WAIT_L(0); PG8_MMA(0, 1, At, B1); PG8_BAR;
            PG8_LDA(At, 0, 1); PG8_STAGE(PG8_SA(0, 0), a2, voffA);
            PG8_BAR; PG8_WAIT_L(0); PG8_MMA(1, 0, At, B0); PG8_BAR; PG8_SCHED;
            PG8_STAGE(PG8_SB(0, 1), b2 + hstep, voffB);
            PG8_WAIT_V(6); PG8_BAR; PG8_MMA(1, 1, At, B1); PG8_BAR;
            PG8_LDB(B0, 1, 0); PG8_SCHED; PG8_LDA(At, 1, 0); PG8_STAGE(PG8_SA(0, 1), a2 + hstep, voffA);
            PG8_WAIT_L(8); PG8_BAR; PG8_WAIT_L(0); PG8_MMA(0, 0, At, B0); PG8_BAR; PG8_SCHED;
            PG8_LDB(B1, 1, 1); PG8_STAGE(PG8_SB(1, 0), b3, voffB);
            PG8_BAR; PG8_WAIT_L(0); PG8_MMA(0, 1, At, B1); PG8_BAR;
            PG8_LDA(At, 1, 1); PG8_STAGE(PG8_SA(1, 0), a3, voffA);
            PG8_BAR; PG8_WAIT_L(0); PG8_MMA(1, 0, At, B0); PG8_BAR; PG8_SCHED;
            PG8_STAGE(PG8_SB(1, 1), b3 + hstep, voffB);
            PG8_WAIT_V(6); PG8_BAR; PG8_MMA(1, 1, At, B1); PG8_BAR;
            }
        }
        if constexpr (ALIGN_EPI) { if (wr == 0) PG8_BAR; }
        if constexpr (!Epi::AFTER_DRAIN) { E(acc, cur, wr, wc, fr, fq); S.done(cur); }
        if (!has_next) break;
#pragma unroll
        for (int a = 0; a < 2; ++a)
#pragma unroll
            for (int b = 0; b < 2; ++b)
#pragma unroll
                for (int m = 0; m < 4; ++m)
#pragma unroll
                    for (int n = 0; n < 2; ++n) acc[a][b][m][n] = (f32x4){0.f, 0.f, 0.f, 0.f};
        cur = nxt; cA = nA; cB = nB; ++ui;
        if constexpr (ALIGN_EPI) { if (wr == 1) PG8_BAR; }
    }
    PG8_WAIT_V(0);
    if constexpr (!ALIGN_EPI) { if (wr == 0) PG8_BAR; }
    PG8_BAR;
    if constexpr (Epi::AFTER_DRAIN) { E.fused(acc, cur, wr, wc, fr, fq, lds, wid, lane); S.done(cur); }
#undef PG8_STAGE_A
#undef PG8_STAGE2
#undef PG8_LD1
#undef PG8_SA
#undef PG8_SB
#undef PG8_STAGE
#undef PG8_LDA
#undef PG8_LDB
#undef PG8_MMA
#undef PG8_WAIT_V
#undef PG8_WAIT_L
#undef PG8_BAR
#undef PG8_SCHED
}
}
template <class SF, class EF>
__device__ __forceinline__ void pg8_run_gather(ldsp lds, int K, int G, int bid, SF sf, EF ef) {
  const pg8::SchedFn<SF> S_{sf, G, bid}; const pg8::EpiFn<EF> E_{ef};
  pg8::gemm_phase<pg8::EpiFn<EF>, pg8::SchedFn<SF>, true, true, true>(lds, K, S_, E_);
}
template <class SF, class EF>
__device__ __forceinline__ void pg8_run(ldsp lds, int K, int G, int bid, SF sf, EF ef) {
  const pg8::SchedFn<SF> S_{sf, G, bid}; const pg8::EpiFn<EF> E_{ef};
  pg8::gemm_phase<pg8::EpiFn<EF>, pg8::SchedFn<SF>, true, true>(lds, K, S_, E_);
}

template <int MF, int NF, int UNR, class AO, class BO, class EP>
__device__ __forceinline__ void skinny_mma(const bf16_t* __restrict__ A, const bf16_t* __restrict__ B, int K, AO aoff, BO boff, EP epi) {
  const int lane = threadIdx.x & 63, i16 = lane & 15, kg = lane >> 4;
  const bf16_t* pa[MF]; const bf16_t* pb[NF];
#pragma unroll
  for (int mf = 0; mf < MF; ++mf) pa[mf] = A + aoff(mf, i16) + 8 * kg;
#pragma unroll
  for (int nf = 0; nf < NF; ++nf) pb[nf] = B + boff(nf, i16) + 8 * kg;
  f32x4 acc[MF][NF];
#pragma unroll
  for (int mf = 0; mf < MF; ++mf)
#pragma unroll
    for (int nf = 0; nf < NF; ++nf) acc[mf][nf] = (f32x4){0.f, 0.f, 0.f, 0.f};
#pragma unroll 1
  for (int kk = 0; kk < K; kk += 32 * UNR) {
    bf16x8 af[UNR][MF], bfr[UNR][NF];
#pragma unroll
    for (int u = 0; u < UNR; ++u) {
#pragma unroll
      for (int mf = 0; mf < MF; ++mf) af[u][mf] = *(const bf16x8*)(pa[mf] + kk + 32 * u);
#pragma unroll
      for (int nf = 0; nf < NF; ++nf) bfr[u][nf] = *(const bf16x8*)(pb[nf] + kk + 32 * u);
    }
#pragma unroll
    for (int u = 0; u < UNR; ++u)
#pragma unroll
      for (int mf = 0; mf < MF; ++mf)
#pragma unroll
        for (int nf = 0; nf < NF; ++nf) acc[mf][nf] = __builtin_amdgcn_mfma_f32_16x16x32_bf16(bfr[u][nf], af[u][mf], acc[mf][nf], 0, 0, 0);
  }
#pragma unroll
  for (int mf = 0; mf < MF; ++mf)
#pragma unroll
    for (int nf = 0; nf < NF; ++nf) epi(mf, nf, acc[mf][nf]);
}

__device__ __forceinline__ void transpose_item(const float* __restrict__ W, int ldw, int k0, int n0, bf16_t* __restrict__ dst, int ldd, int drow0, LAS float* scr, int lane) {
  { f32x4 v[8]; const int c4 = (lane & 7) * 4;
#pragma unroll
    for (int i = 0; i < 8; ++i) v[i] = *(const f32x4*)(W + (size_t)(k0 + 8 * i + (lane >> 3)) * ldw + n0 + c4);
#pragma unroll
    for (int i = 0; i < 8; ++i) { LAS float* d = scr + (8 * i + (lane >> 3)) * 33 + c4; d[0] = v[i].x; d[1] = v[i].y; d[2] = v[i].z; d[3] = v[i].w; } }
  asm volatile("s_waitcnt lgkmcnt(0)" ::: "memory");
  const int c = lane & 7;
#pragma unroll
  for (int j = 0; j < 4; ++j) {
    const int n = (lane >> 3) + 8 * j; const LAS float* s = scr + (8 * c) * 33 + n;
    u32x4 o; o.x = pk2(s[0], s[33]); o.y = pk2(s[2 * 33], s[3 * 33]); o.z = pk2(s[4 * 33], s[5 * 33]); o.w = pk2(s[6 * 33], s[7 * 33]);
    *(u32x4*)(dst + (size_t)(drow0 + n) * ldd + k0 + 8 * c) = o;
  }
  asm volatile("s_waitcnt lgkmcnt(0)" ::: "memory");
}
__device__ __forceinline__ void transpose_weight(const float* W, int K, int N, bf16_t* dst, int gw, int ngw, LAS float* scr, int lane) {
  const int nblk = N / 32, items = (K / 64) * nblk;
  for (int it = gw; it < items; it += ngw) { const int kb = it / nblk, nb = it % nblk; transpose_item(W, N, kb * 64, nb * 32, dst, K, nb * 32, scr, lane); }
}
__device__ __forceinline__ void convert_moe(const float* wg, const float* wu, const float* wd, bf16_t* Wgu, bf16_t* Wd, int gw, int ngw, LAS float* scr, int lane) {
  const int total = 16 * 1536;
  for (int it = gw; it < total; it += ngw) {
    const int e = it / 1536, r = it % 1536;
    if (r < 1024) {
      const int up = r >> 9, q = r & 511, kb = q >> 5, nb = q & 31;
      const float* W = (up ? wu : wg) + (size_t)e * 1024 * 1024;
      const int f0 = nb * 32, pn = f0 >> 7;
      transpose_item(W, 1024, kb * 64, f0, Wgu + (size_t)e * 2048 * 1024, 1024, pn * 256 + up * 128 + (f0 & 127), scr, lane);
    } else {
      const int q = r - 1024, kb = q >> 5, nb = q & 31;
      transpose_item(wd + (size_t)e * 1024 * 1024, 1024, kb * 64, nb * 32, Wd + (size_t)e * 1024 * 1024, 1024, nb * 32, scr, lane);
    }
  }
}

__device__ __forceinline__ void convert_moe_block(const float* wg, const float* wu, const float* wd, bf16_t* Wgu, bf16_t* Wd, int bid, int G, LAS float* scr) {
  const int t = threadIdx.x;
  for (int it = bid; it < 16 * 3 * 64; it += G) {
    const int e = it / 192, r = it % 192, mat = r >> 6, q = r & 63, kb = q >> 2, nq = q & 3;
    const float* W = (mat == 0 ? wg : mat == 1 ? wu : wd) + (size_t)e * 1024 * 1024;
    const int k0 = kb * 64, n0 = nq * 256;
    { f32x4 v[8]; const int c4 = (t & 63) * 4;
#pragma unroll
      for (int i = 0; i < 8; ++i) v[i] = *(const f32x4*)(W + (size_t)(k0 + i * 8 + (t >> 6)) * 1024 + n0 + c4);
#pragma unroll
      for (int i = 0; i < 8; ++i) { LAS float* d = scr + (i * 8 + (t >> 6)) * 257 + c4; d[0] = v[i].x; d[1] = v[i].y; d[2] = v[i].z; d[3] = v[i].w; } }
    __syncthreads();
#pragma unroll
    for (int j = 0; j < 4; ++j) {
      const int qq = t + 512 * j, n = qq >> 3, c = qq & 7; const LAS float* sp = scr + (8 * c) * 257 + n;
      u32x4 o; o.x = pk2(sp[0], sp[257]); o.y = pk2(sp[2 * 257], sp[3 * 257]); o.z = pk2(sp[4 * 257], sp[5 * 257]); o.w = pk2(sp[6 * 257], sp[7 * 257]);
      const int f = n0 + n;
      bf16_t* drow = mat < 2 ? Wgu + ((size_t)e * 2048 + (f >> 7) * 256 + mat * 128 + (f & 127)) * 1024 : Wd + ((size_t)e * 1024 + f) * 1024;
      *(u32x4*)(drow + k0 + 8 * c) = o;
    }
    __syncthreads();
  }
}

__device__ __forceinline__ float norm_mod_regs(const f32x4 (&v)[4], const float* g, const float* shift, const float* scale, bf16_t* orow, int lane) {
  float ss = 0.f;
#pragma unroll
  for (int j = 0; j < 4; ++j) ss += v[j].x * v[j].x + v[j].y * v[j].y + v[j].z * v[j].z + v[j].w * v[j].w;
  const float rstd = 1.0f / sqrtf(wave_sum(ss) * (1.f / 1024.f) + 1e-6f);
#pragma unroll
  for (int j = 0; j < 4; ++j) {
    const f32x4 gg = ((const f32x4*)g)[lane + 64 * j], sh = ((const f32x4*)shift)[lane + 64 * j], sc = ((const f32x4*)scale)[lane + 64 * j];
    const f32x4 y = v[j] * rstd * gg * (1.f + sc) + sh;
    u32x2 o; o.x = pk2(y.x, y.y); o.y = pk2(y.z, y.w);
    ((u32x2*)orow)[lane + 64 * j] = o;
  }
  return rstd;
}
__device__ __forceinline__ float norm_mod_row(const float* xrow, const float* g, const float* shift, const float* scale, bf16_t* orow, int lane) {
  f32x4 v[4];
#pragma unroll
  for (int j = 0; j < 4; ++j) v[j] = ((const f32x4*)xrow)[lane + 64 * j];
  return norm_mod_regs(v, g, shift, scale, orow, lane);
}
template <int NPT>
__device__ __forceinline__ void topk_block(ldsp lds, const float* aff, int e, int N, int cap, int* sel_idx, float* sel_g, int* slot_of) {
  LAS int* hist = (LAS int*)lds; LAS int* misc = hist + 256; LAS int* wtot = misc + 8;
  const int tid = threadIdx.x, lane = tid & 63, wid = tid >> 6;
  unsigned key[NPT];
#pragma unroll
  for (int i = 0; i < NPT; ++i) { const int idx = tid * NPT + i; key[i] = idx < N ? __builtin_bit_cast(unsigned, aff[(size_t)idx * 16 + e]) : 0u; }
  unsigned prefix = 0u, mask = 0u; int rem = cap;
#pragma unroll 1
  for (int pass = 0; pass < 4; ++pass) {
    const int shift = 24 - 8 * pass;
    if (tid < 256) hist[tid] = 0;
    __syncthreads();
    { int cb = -1, cc = 0;
#pragma unroll
      for (int i = 0; i < NPT; ++i) { const int idx = tid * NPT + i;
        if (idx < N && (key[i] & mask) == prefix) { const int b = (int)((key[i] >> shift) & 255u); if (b == cb) ++cc; else { if (cc) atomicAdd((int*)&hist[cb], cc); cb = b; cc = 1; } } }
      if (cc) atomicAdd((int*)&hist[cb], cc); }
    __syncthreads();
    if (wid == 0) {
      const int h0 = hist[4 * lane], h1 = hist[4 * lane + 1], h2 = hist[4 * lane + 2], h3 = hist[4 * lane + 3];
      const int s = h0 + h1 + h2 + h3; int suf = s;
#pragma unroll
      for (int off = 1; off < 64; off <<= 1) { const int t = __shfl_down(suf, off); if (lane + off < 64) suf += t; }
      int c = suf - s;
      if (c < rem && c + h3 >= rem) { misc[0] = 4 * lane + 3; misc[1] = rem - c; } c += h3;
      if (c < rem && c + h2 >= rem) { misc[0] = 4 * lane + 2; misc[1] = rem - c; } c += h2;
      if (c < rem && c + h1 >= rem) { misc[0] = 4 * lane + 1; misc[1] = rem - c; } c += h1;
      if (c < rem && c + h0 >= rem) { misc[0] = 4 * lane + 0; misc[1] = rem - c; }
    }
    __syncthreads();
    const int bin = misc[0]; rem = misc[1];
    prefix |= (unsigned)bin << shift; mask |= 0xFFu << shift;
    __syncthreads();
  }
  const unsigned T = prefix;
  int cgt = 0, ceq = 0;
#pragma unroll
  for (int i = 0; i < NPT; ++i) { const int idx = tid * NPT + i; if (idx < N) { cgt += key[i] > T ? 1 : 0; ceq += key[i] == T ? 1 : 0; } }
  int igt = cgt, ieq = ceq;
#pragma unroll
  for (int off = 1; off < 64; off <<= 1) { const int a = __shfl_up(igt, off), b = __shfl_up(ieq, off); if (lane >= off) { igt += a; ieq += b; } }
  if (lane == 63) { wtot[wid * 2] = igt; wtot[wid * 2 + 1] = ieq; }
  __syncthreads();
  int bgt = 0, beq = 0, tgt = 0;
#pragma unroll
  for (int w = 0; w < 8; ++w) { const int a = wtot[2 * w], b = wtot[2 * w + 1]; if (w < wid) { bgt += a; beq += b; } tgt += a; }
  int pgt = bgt + igt - cgt, peq = beq + ieq - ceq;
#pragma unroll
  for (int i = 0; i < NPT; ++i) {
    const int idx = tid * NPT + i;
    if (idx < N) {
      int slot = -1;
      if (key[i] > T) slot = pgt++;
      else if (key[i] == T) { if (peq < rem) slot = tgt + peq; ++peq; }
      slot_of[(size_t)idx * 16 + e] = slot;
      if (slot >= 0) { sel_idx[slot] = idx; sel_g[slot] = __builtin_bit_cast(float, key[i]); }
    }
  }
  __syncthreads();
}

#define XB_TMO      128
#define XB_XCNT(j)  (256  + 64 * (j))
#define XB_XSUB(j)  (1280 + 64 * (j))
#define XB_XGEN(j)  (2304 + 64 * (j))
#define XB_TOP      3328
#define XB_TOPGEN   3392
#define XCD_BAR_WORDS 3456
#define XB_SPIN_CAP (1u << 18)

__device__ __forceinline__ unsigned xb_ld(unsigned* p)              { return __hip_atomic_load(p, __ATOMIC_RELAXED, __HIP_MEMORY_SCOPE_AGENT); }
__device__ __forceinline__ unsigned xb_add(unsigned* p, unsigned v) { return __hip_atomic_fetch_add(p, v, __ATOMIC_RELAXED, __HIP_MEMORY_SCOPE_AGENT); }
__device__ __forceinline__ unsigned xb_xcc_id() { return (unsigned)__builtin_amdgcn_s_getreg((3 << 11) | 20) & 0xFu; }
#define XB_SPIN(cond, bar) do { unsigned _sp = 0; while (cond) { __builtin_amdgcn_s_sleep(1); \
    if ((++_sp & 255u) == 0u) { if (xb_ld(&(bar)[XB_TMO])) break; if (_sp > XB_SPIN_CAP) { atomicAdd(&(bar)[XB_TMO], 1u); break; } } } } while (0)

struct XcdBarrier {
    unsigned* bar; unsigned x;
    volatile LAS unsigned* st;
};

__device__ __forceinline__ XcdBarrier xcd_barrier_post(unsigned* bar, volatile LAS unsigned* st) {
    XcdBarrier b; b.bar = bar; b.x = xb_xcc_id(); b.st = st;
    if (threadIdx.x == 0) (void)xb_add(&bar[XB_XCNT(b.x)], 1u);
    return b;
}
__device__ __forceinline__ void xcd_barrier_complete(unsigned* bar, unsigned x, unsigned& nloc, unsigned& nx) {
    const unsigned G = gridDim.x * gridDim.y * gridDim.z;
    unsigned sum, cnt, mine, sp = 0u;
    for (;;) {
        sum = 0u; cnt = 0u; mine = 0u;
#pragma unroll
        for (unsigned j = 0; j < 16; ++j) { const unsigned c = xb_ld(&bar[XB_XCNT(j)]); sum += c; cnt += (c > 0u) ? 1u : 0u; mine = (j == x) ? c : mine; }
        if (sum == G) break;
        __builtin_amdgcn_s_sleep(1);
        if ((++sp & 255u) == 0u) { if (xb_ld(&bar[XB_TMO])) break; if (sp > XB_SPIN_CAP) { atomicAdd(&bar[XB_TMO], 1u); break; } }
    }
    nloc = mine > 0u ? mine : 1u; nx = cnt > 0u ? cnt : 1u;
}

__device__ __forceinline__ void xcd_barrier(const XcdBarrier& b) {
    asm volatile("s_waitcnt vmcnt(0)" ::: "memory");
    __syncthreads();
    if (threadIdx.x == 0) {
        unsigned* bar = b.bar;
        __builtin_amdgcn_s_waitcnt(0);
        unsigned nloc = b.st[0], nx = b.st[1];
        if (nloc == 0u) { xcd_barrier_complete(bar, b.x, nloc, nx); b.st[0] = nloc; b.st[1] = nx; }
        const unsigned old = xb_add(&bar[XB_XSUB(b.x)], 1u);
        const unsigned gen = old / nloc;
        if (old + 1u == (gen + 1u) * nloc) {
            __builtin_amdgcn_fence(__ATOMIC_RELEASE, "agent");
            asm volatile("s_waitcnt vmcnt(0)" ::: "memory");
            const unsigned og = xb_add(&bar[XB_TOP], 1u);
            const unsigned tg = og / nx;
            if (og + 1u == (tg + 1u) * nx) xb_add(&bar[XB_TOPGEN], 1u);
            else XB_SPIN(xb_ld(&bar[XB_TOPGEN]) == tg, bar);
            __builtin_amdgcn_fence(__ATOMIC_ACQUIRE, "agent");
            xb_add(&bar[XB_XGEN(b.x)], 1u);
            asm volatile("s_waitcnt vmcnt(0)" ::: "memory");
        } else {
            XB_SPIN(xb_ld(&bar[XB_XGEN(b.x)]) == gen, bar);
            __builtin_amdgcn_fence(__ATOMIC_ACQUIRE, "agent");
            asm volatile("s_waitcnt vmcnt(0)" ::: "memory");
        }
    }
    __syncthreads();
}


__global__ void __launch_bounds__(NT) mega(Params p) {
  extern __shared__ __attribute__((aligned(16))) unsigned char lds_raw[];
#if defined(LEAK_A0) || defined(LEAK_XCC) || defined(LEAK_SYNC)
  cg::grid_group grid = cg::this_grid();
#endif
  ldsp lds = (ldsp)lds_raw;
  const int tid = threadIdx.x, lane = tid & 63, wid = tid >> 6;
  const int G = gridDim.x, bid = blockIdx.x;
  const int gw = bid * 8 + wid, ngw = G * 8;
  unsigned char* ws = p.ws;
  float* mods = (float*)(ws + OFF_MODS);
#define MODP(layer, set, m) (mods + (((layer) * 2 + (set)) * 6 + (m)) * 1024)
  LAS float* lf = (LAS float*)lds;
  volatile LAS unsigned* xb_st = (volatile LAS unsigned*)(lds + LDS_BYTES - 64);
  if (threadIdx.x < 2) xb_st[threadIdx.x] = 0u;
  __syncthreads();
  const XcdBarrier xbar = xcd_barrier_post((unsigned*)(ws + OFF_BAR), xb_st);
#define GRID_BAR() xcd_barrier(xbar)
#ifdef LEAK_A0
  unsigned long long* tsbuf = (unsigned long long*)(ws + 120 * 1024);
#define TS(k) do { if (blockIdx.x == 0 && threadIdx.x == 0) tsbuf[(k) + 1] = __builtin_amdgcn_s_memrealtime(); } while (0)
  if (blockIdx.x == 0 && threadIdx.x == 0) tsbuf[0] = __builtin_amdgcn_s_memrealtime();
#else
#define TS(k) do {} while (0)
#endif
#define PHASE_VARS int tid = threadIdx.x; asm volatile("" : "+v"(tid)); const int lane = tid & 63, wid = tid >> 6; const int gw = bid * 8 + wid; (void)lane; (void)gw

#if (PH_MASK >> 0) & 1
  {
    PHASE_VARS;
    { for (int i = tid; i < 1024; i += NT) { lf[i] = siluf(p.in[I_C][i]); lf[1024 + i] = siluf(p.in[I_CCTX][i]); }
      __syncthreads();
      for (int task = bid; task < 192; task += G) {
        const int l = task / 96, n0 = (task % 96) * 64, kq = tid >> 4, n4 = tid & 15;
        const float* W = p.in[I_ADAW] + (size_t)l * 1024 * 6144 + n0 + n4 * 4;
        f32x4 s0 = (f32x4){0.f, 0.f, 0.f, 0.f}, s1 = s0;
#pragma unroll 8
        for (int k = kq; k < 1024; k += 32) { const f32x4 w = *(const f32x4*)(W + (size_t)k * 6144); s0 += lf[k] * w; s1 += lf[1024 + k] * w; }
        *(LAS f32x4*)(lf + 2048 + (kq * 16 + n4) * 8) = s0; *(LAS f32x4*)(lf + 2048 + (kq * 16 + n4) * 8 + 4) = s1;
        __syncthreads();
        if (tid < 64) { float a = 0.f, b = 0.f; const int c4 = tid >> 2, cc = tid & 3;
#pragma unroll 8
          for (int q = 0; q < 32; ++q) { a += lf[2048 + (q * 16 + c4) * 8 + cc]; b += lf[2048 + (q * 16 + c4) * 8 + 4 + cc]; }
          const float bb = p.in[I_ADAB][l * 6144 + n0 + tid];
          mods[(l * 2 + 0) * 6144 + n0 + tid] = a + bb; mods[(l * 2 + 1) * 6144 + n0 + tid] = b + bb; }
        __syncthreads();
      }
    }
    __syncthreads();
    { LAS float* w1 = lf; LAS float* w2 = lf + 33 * 64; LAS float* w3 = w2 + 4096; LAS float* bz = w3 + 4096;   LAS float* scr = bz + 256 + wid * 256;
      for (int i = tid; i < 33 * 64; i += NT) w1[i] = p.in[I_FW1][i];
      for (int i = tid; i < 4096; i += NT) { w2[i] = p.in[I_FW2][i]; w3[i] = p.in[I_FW3][i]; }
      if (tid < 64) { bz[tid] = p.in[I_FB1][tid]; bz[64 + tid] = p.in[I_FB2][tid]; bz[128 + tid] = p.in[I_FB3][tid]; bz[192 + tid] = p.in[I_FFREQ][tid]; }
      __syncthreads();
#define WAVE_LDS_SYNC() asm volatile("s_waitcnt lgkmcnt(0)" ::: "memory")
      const float fq_ = bz[192 + lane];
      for (int quad = gw; quad < NKEY / 4; quad += ngw) {
        float zv[4];
#pragma unroll
        for (int k = 0; k < 4; ++k) {
          const int row = quad * 4 + k; const bool isx = row < SEQ; const int l = isx ? row : row - SEQ; const int L = isx ? SEQ : CTX;
          const float t = (float)l / (float)(L - 1); const float w = 6.283185307179586f * (float)l / (float)L;
          if (lane == 0) zv[k] = t;
          else if (lane <= 32) { const int b = (lane - 1) & 15; const float band = 1e-4f + (float)b * ((15.f - 1e-4f) / 15.f); const float a = w * band; zv[k] = (lane <= 16) ? cosf(a) : -sinf(a); }
          else zv[k] = 0.f;
        }
#pragma unroll
        for (int k = 0; k < 4; ++k) scr[64 * k + lane] = zv[k];
        WAVE_LDS_SYNC();
        float a[4], h[4];
#pragma unroll
        for (int k = 0; k < 4; ++k) a[k] = bz[lane];
_Pragma("unroll 4")
        for (int i = 0; i < 33; ++i) { const float wv = w1[i * 64 + lane];
#pragma unroll
          for (int k = 0; k < 4; ++k) a[k] += scr[64 * k + i] * wv; }
#pragma unroll
        for (int k = 0; k < 4; ++k) h[k] = sinf(fq_ * a[k]);
        WAVE_LDS_SYNC();
#pragma unroll
        for (int k = 0; k < 4; ++k) scr[64 * k + lane] = h[k];
        WAVE_LDS_SYNC();
#pragma unroll
        for (int k = 0; k < 4; ++k) a[k] = bz[64 + lane];
_Pragma("unroll 4")
        for (int i = 0; i < 64; ++i) { const float wv = w2[i * 64 + lane];
#pragma unroll
          for (int k = 0; k < 4; ++k) a[k] += scr[64 * k + i] * wv; }
#pragma unroll
        for (int k = 0; k < 4; ++k) h[k] = sinf(fq_ * a[k]);
        WAVE_LDS_SYNC();
#pragma unroll
        for (int k = 0; k < 4; ++k) scr[64 * k + lane] = h[k];
        WAVE_LDS_SYNC();
#pragma unroll
        for (int k = 0; k < 4; ++k) a[k] = bz[128 + lane];
_Pragma("unroll 4")
        for (int i = 0; i < 64; ++i) { const float wv = w3[i * 64 + lane];
#pragma unroll
          for (int k = 0; k < 4; ++k) a[k] += scr[64 * k + i] * wv; }
#pragma unroll
        for (int k = 0; k < 4; ++k) {
          const int row = quad * 4 + k; const bool isx = row < SEQ; const int l = isx ? row : row - SEQ;
          bf16_t* hid = isx ? (bf16_t*)(ws + OFF_HIDX) + (size_t)l * 64 : (bf16_t*)(ws + OFF_HIDC) + (size_t)l * 64;
          hid[lane] = (bf16_t)f2bf(sinf(fq_ * a[k]));
        }
        WAVE_LDS_SYNC();
      }
    }
#undef WAVE_LDS_SYNC
    __syncthreads();
    { LAS float* scr = lf + wid * (64 * 33);
      transpose_weight(p.in[I_FW4], 64, 4096, (bf16_t*)(ws + OFF_W4T), gw, ngw, scr, lane);
      transpose_weight(p.in[I_HWIN], 1024, 3072, (bf16_t*)(ws + OFF_WIN), gw, ngw, scr, lane);
      transpose_weight(p.in[I_HWOUT], 1024, 1024, (bf16_t*)(ws + OFF_WHO), gw, ngw, scr, lane);
      { const float* W = p.in[I_DWQKV]; bf16_t* dst = (bf16_t*)(ws + OFF_WQKV);
        for (int it = gw; it < 16 * 96; it += ngw) { const int kb = it / 96, nb = it % 96; const int f0 = nb * 32;
          const int drow = f0 < 2048 ? (f0 & ~255) + 128 * ((f0 >> 5) & 1) + 32 * ((f0 & 255) >> 6) : f0;
          transpose_item(W, 3072, kb * 64, f0, dst, 1024, drow, scr, lane); } }
      transpose_weight(p.in[I_DWOUT], 1024, 1024, (bf16_t*)(ws + OFF_WDO), gw, ngw, scr, lane);
    }
    { f32x2* rope = (f32x2*)(ws + OFF_ROPE);
      for (int i = bid * NT + tid; i < 4096; i += G * NT) { const int pos = i >> 4, k = i & 15; const float inv = powf(10000.f, -(float)(2 * k) / 32.f); const float a = (float)pos * inv; rope[i] = (f32x2){cosf(a), sinf(a)}; }
    }
  }
#endif
  GRID_BAR();
  TS(0);
#ifdef LEAK_SYNC
  TS(29); grid.sync(); TS(30); grid.sync(); TS(31); grid.sync(); TS(32); grid.sync(); TS(33);
#endif
#if (PH_MASK >> 1) & 1
  {
    PHASE_VARS;
    auto src1 = [&](int tile) { const bool isx = tile < 1024; const int tt = isx ? tile : tile - 1024; const int pm = isx ? (tt >> 6) : tt, pn = isx ? (tt & 63) : 0;
      TileSrc t_; t_.A = (const bf16_t*)(ws + OFF_W4T) + (size_t)pm * 256 * 64; t_.B = isx ? (const bf16_t*)(ws + OFF_HIDX) + (size_t)pn * 256 * 64 : (const bf16_t*)(ws + OFF_HIDC); t_.gidx = nullptr; t_.lda = 64; t_.ldb = 64; t_.gmask = 0; return t_; };
    for (int tile = bid; tile < 1024; tile += G) {
      const bool isx = true; const int tt = tile;
      const int pm = isx ? (tt >> 6) : tt, pn = isx ? (tt & 63) : 0;
      h16* HT = isx ? (h16*)(ws + OFF_HT) : (h16*)(ws + OFF_HCT); const int ld = isx ? SEQ : CTX;
      gemm_tile<true>(lds, src1(tile), 64, tile != bid, [&] { if (tile + G < 1024) gemm_issue0(lds, src1(tile + G)); },
        [&](f32x4 (&acc)[8][4], int wr, int wc, int fr, int fq) {
#pragma unroll
          for (int m = 0; m < 8; ++m) {
            int r0 = pm * 256 + wr * 128 + m * 16 + fr; EPI_FENCE(r0);
            h16* rp = HT + (size_t)r0 * ld + pn * 256 + wc * 64 + fq * 4;
#pragma unroll
            for (int n = 0; n < 4; ++n) *(h16x4*)(rp + n * 16) = __builtin_convertvector(acc[m][n], h16x4);
          }
        });
    }
    if (wid < 4) {
      const int task = bid + 256 * wid, cgp = task >> 2, lq = task & 3;
      const bf16_t* Aw = (const bf16_t*)(ws + OFF_W4T) + (size_t)(16 * cgp) * 64; const bf16_t* Bh = (const bf16_t*)(ws + OFF_HIDC) + (size_t)(64 * lq) * 64; h16* HC = (h16*)(ws + OFF_HCT);
      skinny_mma<1, 4, 2>(Aw, Bh, 64, [&](int, int i) { return i * 64; }, [&](int nf, int i) { return (16 * nf + i) * 64; },
        [&](int, int nf, f32x4 acc) { const int col = 16 * cgp + (lane & 15), l0 = 64 * lq + 16 * nf + 4 * (lane >> 4);
          *(h16x4*)(HC + (size_t)col * CTX + l0) = __builtin_convertvector(acc, h16x4); });
    }
    {
      auto rowp = [&](int row) { const bool isx = row < SEQ; const int r = isx ? row : row - SEQ; return isx ? p.in[I_X] + (size_t)r * 1024 : p.in[I_CTX] + (size_t)r * 1024; };
      f32x4 v[4];
      if (gw < NKEY) {
#pragma unroll
        for (int j = 0; j < 4; ++j) v[j] = ((const f32x4*)rowp(gw))[lane + 64 * j];
      }
      for (int row = gw; row < NKEY; row += ngw) {
        const bool isx = row < SEQ; const int r = isx ? row : row - SEQ; const int set = isx ? 0 : 1;
        bf16_t* o = isx ? (bf16_t*)(ws + OFF_HX) + (size_t)r * 1024 : (bf16_t*)(ws + OFF_HC) + (size_t)r * 1024;
        f32x4 vn[4]; const int rn = row + ngw < NKEY ? row + ngw : row;
#pragma unroll
        for (int j = 0; j < 4; ++j) vn[j] = ((const f32x4*)rowp(rn))[lane + 64 * j];
        norm_mod_regs(v, p.in[I_NMIX], MODP(0, set, 0), MODP(0, set, 1), o, lane);
#pragma unroll
        for (int j = 0; j < 4; ++j) v[j] = vn[j];
      }
    }
  }
#endif
  GRID_BAR();
  TS(1);
#if (PH_MASK >> 2) & 1
  for (int rep_ = 0; rep_ < REP_P2; ++rep_, __syncthreads())
  {
    PHASE_VARS;
    { const float* bin = p.in[I_HBIN];
      pg8_run(lds, 1024, G, bid,
        ([&](int tile, pg8::Unit& u) { if (tile >= 768 + 12) return false; const bool isx = tile < 768; const int tt = isx ? tile : tile - 768;
          u.pm = isx ? tt / 64 : tt; u.pn = isx ? tt % 64 : 0; u.kind = isx ? 0 : 1; u.e = 0;
          u.A = (const char*)((const bf16_t*)(ws + OFF_WIN) + (size_t)u.pm * 256 * 1024);
          u.B = (const char*)(isx ? (const bf16_t*)(ws + OFF_HX) + (size_t)u.pn * 256 * 1024 : (const bf16_t*)(ws + OFF_HC)); return true; }),
        ([&](const f32x4 (&acc)[2][2][4][2], const pg8::Unit& u, int wr, int wc, int fr, int fq) {
          h16* UT = u.kind == 0 ? (h16*)(ws + OFF_UT) : (h16*)(ws + OFF_UCT); const int ld = u.kind == 0 ? SEQ : CTX;
          float bvs[2][4];
#pragma unroll
          for (int ai = 0; ai < 2; ++ai)
#pragma unroll
            for (int m = 0; m < 4; ++m) bvs[ai][m] = bin[u.pm * 256 + ai * 128 + wr * 64 + m * 16 + fr];
#pragma unroll
          for (int ai = 0; ai < 2; ++ai)
#pragma unroll
            for (int m = 0; m < 4; ++m) {
              int r0 = u.pm * 256 + ai * 128 + wr * 64 + m * 16 + fr; EPI_FENCE(r0);
              const float bv = bvs[ai][m];
              h16* rp = UT + (size_t)r0 * ld + u.pn * 256 + wc * 32 + fq * 4;
#pragma unroll
              for (int bj = 0; bj < 2; ++bj)
#pragma unroll
                for (int n = 0; n < 2; ++n) *(h16x4*)(rp + bj * 128 + n * 16) = __builtin_convertvector(acc[ai][bj][m][n] + bv, h16x4);
            }
        }));
    }
    LAS v4* A4 = (LAS v4*)lds; LAS float* red = (LAS float*)(lds + FFT_LDS_SLOTS * 16);
    for (int task = bid; task < 2048; task += G) {
      const int o = task >> 10, c = task & 1023;
      const h16* hf_ = (const h16*)(ws + OFF_HT) + (size_t)((o * 2 + 0) * 1024 + c) * SEQ;
      const h16* hb_ = (const h16*)(ws + OFF_HT) + (size_t)((o * 2 + 1) * 1024 + c) * SEQ;
      const float adl = 3.0701134573253945f + (15.350567286626973f - 3.0701134573253945f) * (float)c * (1.f / 1023.f);
      const float kdec = -adl * (1.f / 16383.f) * 1.4426950408889634f;
      float sabs = 0.f;
      { cp x[16];
#pragma unroll
        for (int q = 0; q < 16; ++q) {
          int pp = tid + 512 * q; EPI_FENCE(pp); float k0, k1, k2, k3;
          if (q < 8) { const h16x4 v = *(const h16x4*)(hf_ + 4 * pp); const float l = (float)(4 * pp);
            k0 = (float)v.x * exp2f(kdec * l); k1 = (float)v.y * exp2f(kdec * (l + 1.f)); k2 = (float)v.z * exp2f(kdec * (l + 2.f)); k3 = (float)v.w * exp2f(kdec * (l + 3.f)); }
          else { const int l0 = 32768 - 4 * pp;
            k0 = pp == 4096 ? 0.f : (float)hb_[l0] * exp2f(kdec * (float)l0);
            k1 = (float)hb_[l0 - 1] * exp2f(kdec * (float)(l0 - 1)); k2 = (float)hb_[l0 - 2] * exp2f(kdec * (float)(l0 - 2)); k3 = (float)hb_[l0 - 3] * exp2f(kdec * (float)(l0 - 3)); }
          sabs += (fabsf(k0) + fabsf(k1)) + (fabsf(k2) + fabsf(k3));
          x[q].re = v2mk(k0, k2); x[q].im = v2mk(k1, k3);
        }
        fft2_first_fwd_regs(A4, tid, x); }
      sabs = wave_sum(sabs); if (lane == 0) red[wid] = sabs;
      __syncthreads();
      float S = 1e-6f;
#pragma unroll
      for (int q = 0; q < 8; ++q) S += red[q];
      const float scale = 1.0f / S;
      fft2_bfly16<false, 1024>(A4, tid);
      __syncthreads();
      fft2_bfly16<false, 64>(A4, tid);
      __syncthreads();
      h16x2* ks = (h16x2*)(ws + OFF_KSPEC) + (size_t)task * FFT_M;
      _Pragma("unroll 1") for (int a = tid; a < 2048; a += NT) fft2_mid_filter(A4, a, scale, [&](int pos, cf v) { h16x2 hv; hv.x = (h16)v.x; hv.y = (h16)v.y; ks[pos] = hv; });
      __syncthreads();
    }
    for (int task = gw; task < 2048; task += ngw) {
      const int o = task >> 10, c = task & 1023;
      const h16* hf_ = (const h16*)(ws + OFF_HCT) + (size_t)((o * 2 + 0) * 1024 + c) * CTX;
      const h16* hb_ = (const h16*)(ws + OFF_HCT) + (size_t)((o * 2 + 1) * 1024 + c) * CTX;
      const float adl = 3.0701134573253945f + (15.350567286626973f - 3.0701134573253945f) * (float)c * (1.f / 1023.f);
      const float kdec = -adl * (1.f / 255.f) * 1.4426950408889634f;
      float f[4], b[4], s = 0.f;
#pragma unroll
      for (int i = 0; i < 4; ++i) { const int l = lane + 64 * i; const float d = exp2f(kdec * (float)l); f[i] = (float)hf_[l] * d; b[i] = (float)hb_[l] * d; s += fabsf(f[i]) + (l > 0 ? fabsf(b[i]) : 0.f); }
      const float inv = 1.f / (wave_sum(s) + 1e-6f);
      float* kc = (float*)(ws + OFF_KCTX) + (size_t)task * 512;
#pragma unroll
      for (int i = 0; i < 4; ++i) { const int l = lane + 64 * i; kc[l] = f[i] * inv; if (l > 0) kc[512 - l] = b[i] * inv; else kc[256] = 0.f; }
    }
  }
#endif
  GRID_BAR();
  TS(2);
#if (PH_MASK >> 3) & 1
  for (int rep_ = 0; rep_ < REP_P3; ++rep_, __syncthreads())
  {
    PHASE_VARS;
    LAS v4* A4 = (LAS v4*)lds;
    const float* cw = p.in[I_HCW]; const float* cb = p.in[I_HCB]; const float* skip = p.in[I_HSKIP];
    for (int c = bid; c < 1024; c += G) {
      const h16* uv = (const h16*)(ws + OFF_UT) + (size_t)c * SEQ;
      const h16* u1 = (const h16*)(ws + OFF_UT) + (size_t)(1024 + c) * SEQ;
      const h16* u2 = (const h16*)(ws + OFF_UT) + (size_t)(2048 + c) * SEQ;
#define SCONV4(u, cc, pp, r) do { const h16x4 mid = *(const h16x4*)((u) + 4 * (pp)); const float um = (pp) > 0 ? (float)(u)[4 * (pp) - 1] : 0.f; const float up = (pp) < 4095 ? (float)(u)[4 * (pp) + 4] : 0.f; \
        const float w0 = cw[cc], w1 = cw[3072 + (cc)], w2 = cw[6144 + (cc)], b_ = cb[cc]; \
        r[0] = b_ + w0 * um + w1 * (float)mid.x + w2 * (float)mid.y; r[1] = b_ + w0 * (float)mid.x + w1 * (float)mid.y + w2 * (float)mid.z; \
        r[2] = b_ + w0 * (float)mid.y + w1 * (float)mid.z + w2 * (float)mid.w; r[3] = b_ + w0 * (float)mid.z + w1 * (float)mid.w + w2 * up; } while (0)
      const float sk0 = skip[c], sk1 = skip[1024 + c];
      bf16_t* zo = (bf16_t*)(ws + OFF_Z2T) + (size_t)c * SEQ;
      v4* zkeep = (v4*)(ws + OFF_HX) + (size_t)bid * 4096 + tid;
      { cp x[16];
#pragma unroll
        for (int q = 0; q < 8; ++q) { float z[4]; SCONV4(uv, c, tid + 512 * q, z); x[q].re = v2mk(z[0], z[2]); x[q].im = v2mk(z[1], z[3]); }
#pragma unroll
        for (int q = 8; q < 16; ++q) { x[q].re = v2mk(0.f, 0.f); x[q].im = v2mk(0.f, 0.f); }
        fft2_first_fwd_regs(A4, tid, x); }
      __syncthreads();
#pragma unroll 1
      for (int o = 0; o < 2; ++o) {
        fft2_bfly16<false, 1024>(A4, tid);
        __syncthreads();
        fft2_bfly16<false, 64>(A4, tid);
        __syncthreads();
        const h16x2* ks = (const h16x2*)(ws + OFF_KSPEC) + (size_t)(o * 1024 + c) * FFT_M;
        _Pragma("unroll 1") for (int a = tid; a < 2048; a += NT) fft2_mid_conv(A4, a, [&](int pos) { const h16x2 hv = ks[pos]; return cmk((float)hv.x * (1.0f / FFT_M), (float)hv.y * (1.0f / FFT_M)); });
        __syncthreads();
        fft2_bfly16<true, 64>(A4, tid);
        __syncthreads();
        fft2_bfly16<true, 1024>(A4, tid);
        __syncthreads();
        cp x[16];
        fft2_last_inv_regs(A4, tid, x);
        if (o == 0) {
          cp x2[16];
#pragma unroll
          for (int q = 0; q < 8; ++q) { int pp = tid + 512 * q; EPI_FENCE(pp); float z[4], g[4]; SCONV4(uv, c, pp, z); SCONV4(u1, 1024 + c, pp, g);
            const cp y = x[4 * (q & 3) + (q >> 2)];
            const v4 v = v4mk(g[0] * (y.re.x + sk0 * z[0]), g[2] * (y.re.y + sk0 * z[2]), g[1] * (y.im.x + sk0 * z[1]), g[3] * (y.im.y + sk0 * z[3]));
            zkeep[512 * q] = v; x2[q].re = v2mk(v.x, v.y); x2[q].im = v2mk(v.z, v.w); }
#pragma unroll
          for (int q = 8; q < 16; ++q) { x2[q].re = v2mk(0.f, 0.f); x2[q].im = v2mk(0.f, 0.f); }
          fft2_first_fwd_regs(A4, tid, x2);
        } else {
#pragma unroll
          for (int q = 0; q < 8; ++q) { int pp = tid + 512 * q; EPI_FENCE(pp); float g[4]; SCONV4(u2, 2048 + c, pp, g);
            const cp y = x[4 * (q & 3) + (q >> 2)]; const v4 zz = zkeep[512 * q];
            u32x2 w; w.x = pk2(g[0] * (y.re.x + sk1 * zz.x), g[1] * (y.im.x + sk1 * zz.z)); w.y = pk2(g[2] * (y.re.y + sk1 * zz.y), g[3] * (y.im.y + sk1 * zz.w));
            ((u32x2*)zo)[pp] = w; }
        }
        __syncthreads();
      }
    }
    LAS float* sf = (LAS float*)lds;
    for (int c = bid; c < 1024; c += G) {
      const h16* ub = (const h16*)(ws + OFF_UCT);
      sf[tid] = ((const float*)(ws + OFF_KCTX))[(size_t)c * 512 + tid]; sf[512 + tid] = ((const float*)(ws + OFF_KCTX))[(size_t)(1024 + c) * 512 + tid];
      if (tid < 256) {
#pragma unroll
        for (int s = 0; s < 3; ++s) { const int cc = s * 1024 + c; const h16* u = ub + (size_t)cc * CTX; const float um = tid > 0 ? (float)u[tid - 1] : 0.f, u0 = (float)u[tid], up = tid < 255 ? (float)u[tid + 1] : 0.f;
          sf[1024 + s * 256 + tid] = cb[cc] + cw[cc] * um + cw[3072 + cc] * u0 + cw[6144 + cc] * up; }
      }
      __syncthreads();
      const int t = tid & 255, part = tid >> 8;
#pragma unroll 1
      for (int o = 0; o < 2; ++o) {
        float s = 0.f;
        for (int q = part * 128; q < part * 128 + 128; ++q) s += sf[o * 512 + ((t - q) & 511)] * sf[1024 + q];
        sf[1792 + tid] = s;
        __syncthreads();
        float znew = 0.f;
        if (tid < 256) { const float y = sf[1792 + tid] + sf[1792 + 256 + tid]; znew = sf[1280 + o * 256 + tid] * (y + skip[o * 1024 + c] * sf[1024 + tid]); }
        __syncthreads();
        if (tid < 256) sf[1024 + tid] = znew;
        __syncthreads();
      }
      if (tid < 256) ((bf16_t*)(ws + OFF_ZC2T))[(size_t)c * CTX + tid] = (bf16_t)f2bf(sf[1024 + tid]);
      __syncthreads();
    }
  }
#endif
  GRID_BAR();
  TS(3);
#if (PH_MASK >> 4) & 1
  {
    PHASE_VARS;
    LAS bf16_t* tl = (LAS bf16_t*)lds;
    for (int tile = bid; tile < 4096 + 64; tile += G) {
      const bool isx = tile < 4096; const int tt = isx ? tile : tile - 4096;
      const int ld = isx ? SEQ : CTX; const int ntt = ld / 64;
      const int cb_ = tt / ntt, tb = tt % ntt;
      const bf16_t* src = isx ? (const bf16_t*)(ws + OFF_Z2T) : (const bf16_t*)(ws + OFF_ZC2T);
      bf16_t* dst = isx ? (bf16_t*)(ws + OFF_HX) : (bf16_t*)(ws + OFF_ZC2);
      { const int r = tid >> 3, ch = tid & 7; const u32x4 v = *(const u32x4*)(src + (size_t)(cb_ * 64 + r) * ld + tb * 64 + ch * 8); *(LAS u32x4*)(tl + r * 72 + ch * 8) = v; }
      __syncthreads();
      { const int t = tid >> 3, ch = tid & 7; unsigned short e[8];
#pragma unroll
        for (int i = 0; i < 8; ++i) e[i] = tl[(ch * 8 + i) * 72 + t];
        u32x4 o; o.x = e[0] | ((unsigned)e[1] << 16); o.y = e[2] | ((unsigned)e[3] << 16); o.z = e[4] | ((unsigned)e[5] << 16); o.w = e[6] | ((unsigned)e[7] << 16);
        *(u32x4*)(dst + (size_t)(tb * 64 + t) * 1024 + cb_ * 64 + ch * 8) = o; }
      __syncthreads();
    }
  }
#endif
  GRID_BAR();
  TS(4);
#if (PH_MASK >> 5) & 1
  {
    PHASE_VARS;
    { const float* bo = p.in[I_HBOUT];
      pg8_run(lds, 1024, G, bid,
        ([&](int tile, pg8::Unit& u) { if (tile >= 256) return false; const bool isx = true; const int tt = tile;
          u.pm = isx ? tt >> 2 : 0; u.pn = tt & 3; u.kind = isx ? 0 : 1; u.e = 0;
          u.A = (const char*)(isx ? (const bf16_t*)(ws + OFF_HX) + (size_t)u.pm * 256 * 1024 : (const bf16_t*)(ws + OFF_ZC2));
          u.B = (const char*)((const bf16_t*)(ws + OFF_WHO) + (size_t)u.pn * 256 * 1024); return true; }),
        ([&](const f32x4 (&acc)[2][2][4][2], const pg8::Unit& u, int wr, int wc, int fr, int fq) {
          const bool isx = u.kind == 0;
          const float* xin = isx ? p.in[I_X] : p.in[I_CTX]; float* xo = isx ? p.out : (float*)(ws + OFF_CTXMID);
          const float* gate = MODP(0, isx ? 0 : 1, 2);
          const int col0 = u.pn * 256 + wc * 32 + fq * 4;
          f32x4 gt[2][2], bb[2][2];
#pragma unroll
          for (int bj = 0; bj < 2; ++bj)
#pragma unroll
            for (int n = 0; n < 2; ++n) { gt[bj][n] = *(const f32x4*)(gate + col0 + bj * 128 + n * 16); bb[bj][n] = *(const f32x4*)(bo + col0 + bj * 128 + n * 16); }
#pragma unroll
          for (int hp = 0; hp < 4; ++hp) {
            const int ai = hp >> 1, m0 = (hp & 1) * 2;
            f32x4 xr[2][2][2];
            int rb = u.pm * 256 + ai * 128 + wr * 64 + m0 * 16 + fr; EPI_FENCE(rb);
#pragma unroll
            for (int mm = 0; mm < 2; ++mm)
#pragma unroll
              for (int bj = 0; bj < 2; ++bj)
#pragma unroll
                for (int n = 0; n < 2; ++n) xr[mm][bj][n] = *(const f32x4*)(xin + (size_t)(rb + mm * 16) * 1024 + col0 + bj * 128 + n * 16);
#pragma unroll
            for (int mm = 0; mm < 2; ++mm) {
              const size_t base = (size_t)(rb + mm * 16) * 1024 + col0;
#pragma unroll
              for (int bj = 0; bj < 2; ++bj)
#pragma unroll
                for (int n = 0; n < 2; ++n) *(f32x4*)(xo + base + bj * 128 + n * 16) = xr[mm][bj][n] + gt[bj][n] * (acc[ai][bj][m0 + mm][n] + bb[bj][n]);
            }
          }
        }));
    }
    {
      PHASE_VARS;
      int bb0 = bid; asm volatile("" : "+s"(bb0) :: "memory");
      if (wid < 2) {
        const int task = bb0 + 256 * wid, cg = task >> 3, rp_ = task & 7;
        const bf16_t* Ac = (const bf16_t*)(ws + OFF_ZC2); const bf16_t* Bc = (const bf16_t*)(ws + OFF_WHO) + (size_t)(16 * cg) * 1024;
        const float* cin = p.in[I_CTX]; float* cmid = (float*)(ws + OFF_CTXMID); const float* gatec = MODP(0, 1, 2); const float* boc = p.in[I_HBOUT];
        skinny_mma<2, 1, 8>(Ac, Bc, 1024, [&](int mf, int i) { return (32 * rp_ + 16 * mf + i) * 1024; }, [&](int, int i) { return i * 1024; },
          [&](int mf, int, f32x4 acc) { const int row = 32 * rp_ + 16 * mf + (lane & 15), col = 16 * cg + 4 * (lane >> 4);
            const size_t idx = (size_t)row * 1024 + col;
            *(f32x4*)(cmid + idx) = *(const f32x4*)(cin + idx) + *(const f32x4*)(gatec + col) * (acc + *(const f32x4*)(boc + col)); });
      }
    }
  }
#endif
  GRID_BAR();
  TS(5);

#ifdef DIAG_C
  {
    unsigned* cnt = (unsigned*)(ws + OFF_AFF);
    if (bid == 0 && tid == 0) { cnt[0] = 0u; cnt[1] = 0u; }
    GRID_BAR();
  TS(6);
    const unsigned gid = bid * NT + tid; unsigned hsh = gid * 2654435761u + 12345u; hsh ^= hsh >> 13; hsh *= 0x5bd1e995u; hsh ^= hsh >> 15;
    const int ch = hsh % 1024u, tok = (hsh >> 12) % 16384u, n1 = (hsh >> 5) % 1024u;
    int bad = 0;
    const h16* UTp = (const h16*)(ws + OFF_UT); const float* cw = p.in[I_HCW]; const float* cb = p.in[I_HCB]; const float* skip = p.in[I_HSKIP];
    auto sc = [&](int cc, int t) { const h16* u = UTp + (size_t)cc * SEQ; const float um = t > 0 ? (float)u[t - 1] : 0.f, u0 = (float)u[t], up = t < SEQ - 1 ? (float)u[t + 1] : 0.f; return cb[cc] + cw[cc] * um + cw[3072 + cc] * u0 + cw[6144 + cc] * up; };
    { const float v = sc(ch, tok), g1 = sc(1024 + ch, tok), g2 = sc(2048 + ch, tok); const float r = g2 * (skip[1024 + ch] * (g1 * (skip[ch] * v)));
      const float got = bf2f(((const bf16_t*)(ws + OFF_Z2T))[(size_t)ch * SEQ + tok]); if (!(fabsf(got - r) <= 0.01f + 0.02f * fabsf(r))) bad |= DIAG_C & 1;
      const float got2 = bf2f(((const bf16_t*)(ws + OFF_HX))[(size_t)tok * 1024 + ch]); if (got2 != got) bad |= DIAG_C & 2; }
    { float acc = 0.f; const bf16_t* zr = (const bf16_t*)(ws + OFF_HX) + (size_t)tok * 1024; const bf16_t* wr_ = (const bf16_t*)(ws + OFF_WHO) + (size_t)n1 * 1024;
      for (int q = 0; q < 1024; ++q) acc += bf2f(zr[q]) * bf2f(wr_[q]);
      const float r = p.in[I_X][(size_t)tok * 1024 + n1] + mods[2 * 1024 + n1] * (acc + p.in[I_HBOUT][n1]);
      const float got = p.out[(size_t)tok * 1024 + n1]; if (!(fabsf(got - r) <= 0.005f + 0.005f * fabsf(r))) bad |= DIAG_C & 4; }
    if (bad) atomicAdd(&cnt[0], 1u);
    GRID_BAR();
  TS(7);
    const float f = (float)cnt[0] / (float)(G * NT); const float e = sqrtf(f);
    for (size_t i = (size_t)gid; i < (size_t)SEQ * 1024; i += (size_t)G * NT) p.out[i] = p.in[I_X][i] * (1.f + e);
    return;
  }
#endif
#if STOP_STAGE <= 5
  return;
#endif
  auto phase_router = [&](int layer, int nrows) {
    PHASE_VARS;
    for (int i = tid; i < 16384; i += NT) lf[(i & 15) * 1024 + (i >> 4)] = p.in[I_ROUTER][(size_t)layer * 16384 + i];
    __syncthreads();
    const float* gn = p.in[I_NFFN] + layer * 1024;
    const int b5 = (lane >> 5) & 1, b4 = (lane >> 4) & 1, b3 = (lane >> 3) & 1, b2 = (lane >> 2) & 1;
    auto rrow = [&](int row) { const bool isx = row < SEQ; const int r = isx ? row : row - SEQ; return isx ? (const float*)p.out + (size_t)r * 1024 : (const float*)(ws + OFF_CTXMID) + (size_t)r * 1024; };
    f32x4 hn[4];
    if (gw < nrows) {
#pragma unroll
      for (int j = 0; j < 4; ++j) hn[j] = ((const f32x4*)rrow(gw))[lane + 64 * j];
    }
    for (int row = gw; row < nrows; row += ngw) {
      const bool isx = row < SEQ; const int r = isx ? row : row - SEQ; const int set = isx ? 0 : 1;
      bf16_t* o = isx ? (bf16_t*)(ws + OFF_HX) + (size_t)r * 1024 : (bf16_t*)(ws + OFF_HC) + (size_t)r * 1024;
      const float* sh = MODP(layer, set, 3); const float* sc = MODP(layer, set, 4);
      f32x4 h[4]; float ss = 0.f;
#pragma unroll
      for (int j = 0; j < 4; ++j) { h[j] = hn[j]; ss += h[j].x * h[j].x + h[j].y * h[j].y + h[j].z * h[j].z + h[j].w * h[j].w; }
      { const int rn = row + ngw < nrows ? row + ngw : row;
#pragma unroll
        for (int j = 0; j < 4; ++j) hn[j] = ((const f32x4*)rrow(rn))[lane + 64 * j]; }
      const float rstd = 1.0f / sqrtf(wave_sum(ss) * (1.f / 1024.f) + 1e-6f);
#pragma unroll
      for (int j = 0; j < 4; ++j) {
        const f32x4 gg = ((const f32x4*)gn)[lane + 64 * j], shv = ((const f32x4*)sh)[lane + 64 * j], scv = ((const f32x4*)sc)[lane + 64 * j];
        h[j] = h[j] * rstd * gg * (1.f + scv) + shv;
        u32x2 w; w.x = pk2(h[j].x, h[j].y); w.y = pk2(h[j].z, h[j].w); ((u32x2*)o)[lane + 64 * j] = w;
      }
      float lg[16];
#pragma unroll
      for (int e = 0; e < 16; ++e) { float a = 0.f; int lo = 4 * lane; EPI_FENCE(lo);
#pragma unroll
        for (int j = 0; j < 4; ++j) { const f32x4 w = *(const LAS f32x4*)(lf + e * 1024 + 256 * j + lo); a += h[j].x * w.x + h[j].y * w.y + h[j].z * w.z + h[j].w * w.w; }
        lg[e] = a; }
      float r8[8], r4[4], r2[2];
#pragma unroll
      for (int i = 0; i < 8; ++i) { const float keep = b5 ? lg[8 + i] : lg[i], give = b5 ? lg[i] : lg[8 + i]; r8[i] = keep + __shfl_xor(give, 32); }
#pragma unroll
      for (int i = 0; i < 4; ++i) { const float keep = b4 ? r8[4 + i] : r8[i], give = b4 ? r8[i] : r8[4 + i]; r4[i] = keep + __shfl_xor(give, 16); }
#pragma unroll
      for (int i = 0; i < 2; ++i) { const float keep = b3 ? r4[2 + i] : r4[i], give = b3 ? r4[i] : r4[2 + i]; r2[i] = keep + __shfl_xor(give, 8); }
      float lgt = (b2 ? r2[1] : r2[0]) + __shfl_xor(b2 ? r2[0] : r2[1], 4);
      lgt += __shfl_xor(lgt, 2); lgt += __shfl_xor(lgt, 1);
      float mxv = lgt;
      mxv = fmaxf(mxv, __shfl_xor(mxv, 4)); mxv = fmaxf(mxv, __shfl_xor(mxv, 8)); mxv = fmaxf(mxv, __shfl_xor(mxv, 16)); mxv = fmaxf(mxv, __shfl_xor(mxv, 32));
      const float ex = __expf(lgt - mxv);
      float den = ex;
      den += __shfl_xor(den, 4); den += __shfl_xor(den, 8); den += __shfl_xor(den, 16); den += __shfl_xor(den, 32);
      if ((lane & 3) == 0) ((float*)(ws + OFF_AFF))[(size_t)row * 16 + (8 * b5 + 4 * b4 + 2 * b3 + b2)] = ex / den;
    }
    __syncthreads();
  };
  auto phase_topk = [&](int ntasks, int layer) {
    PHASE_VARS;
    if (bid >= ntasks) { const size_t lo = (size_t)layer * 16 * 1024 * 1024;
      convert_moe_block(p.in[I_WG] + lo, p.in[I_WU] + lo, p.in[I_WDN] + lo, (bf16_t*)(ws + OFF_WGU), (bf16_t*)(ws + OFF_WD), bid - ntasks, G - ntasks, lf); }
    for (int task = bid; task < ntasks; task += G) {
      const int set = task >> 4, e = task & 15;
      int* si = (int*)(ws + OFF_SELI) + (size_t)task * 2048; float* sg = (float*)(ws + OFF_SELG) + (size_t)task * 2048;
      if (set == 0) topk_block<32>(lds, (const float*)(ws + OFF_AFF), e, SEQ, 2048, si, sg, (int*)(ws + OFF_SLOT));
      else topk_block<1>(lds, (const float*)(ws + OFF_AFF) + (size_t)SEQ * 16, e, CTX, 32, si, sg, (int*)(ws + OFF_SLOT) + (size_t)SEQ * 16);
    }
  };
  auto phase_gateup = [&](int ntiles) {
    PHASE_VARS;
    pg8_run_gather(lds, 1024, G, bid,
      ([&](int tile, pg8::Unit& u) { if (tile >= ntiles) return false; const bool isx = tile < 1024; const int tt = isx ? tile : tile - 1024;
        u.e = isx ? tt >> 6 : tt >> 3; u.pn = isx ? (tt >> 3) & 7 : tt & 7; u.pm = isx ? tt & 7 : 0; u.kind = isx ? 0 : 1;
        u.A = (const char*)(isx ? (const bf16_t*)(ws + OFF_HX) : (const bf16_t*)(ws + OFF_HC));
        u.arow = (const int*)(ws + OFF_SELI) + (size_t)((isx ? 0 : 16) + u.e) * 2048 + u.pm * 256; u.nvalid = isx ? 256 : 32;
        u.B = (const char*)((const bf16_t*)(ws + OFF_WGU) + ((size_t)u.e * 2048 + u.pn * 256) * 1024); return true; }),
      ([&](const f32x4 (&acc)[2][2][4][2], const pg8::Unit& u, int wr, int wc, int fr, int fq) {
        bf16_t* act = u.kind == 0 ? (bf16_t*)(ws + OFF_ACT) + ((size_t)u.e * 2048 + u.pm * 256) * 1024 : (bf16_t*)(ws + OFF_ACTC) + (size_t)u.e * 256 * 1024;
#pragma unroll
        for (int ai = 0; ai < 2; ++ai)
#pragma unroll
          for (int m = 0; m < 4; ++m) {
            int r0 = ai * 128 + wr * 64 + m * 16 + fr; EPI_FENCE(r0);
            bf16_t* rp = act + (size_t)r0 * 1024 + u.pn * 128 + wc * 32 + fq * 4;
#pragma unroll
            for (int n = 0; n < 2; ++n) { const f32x4 gv = acc[ai][0][m][n], uv_ = acc[ai][1][m][n]; f32x4 y;
#pragma unroll
              for (int j = 0; j < 4; ++j) y[j] = gv[j] / (1.f + __expf(-gv[j])) * uv_[j];
              u32x2 w; w.x = pk2(y[0], y[1]); w.y = pk2(y[2], y[3]); *(u32x2*)(rp + n * 16) = w; }
          }
      }));
  };
  auto phase_down = [&](int ntiles) {
    PHASE_VARS;
    pg8_run(lds, 1024, G, bid,
      ([&](int tile, pg8::Unit& u) { if (tile >= 512) return false; const bool isx = true; const int tt = tile;
        u.e = isx ? tt >> 5 : tt >> 2; u.pn = isx ? (tt >> 3) & 3 : tt & 3; u.pm = isx ? tt & 7 : 0; u.kind = isx ? 0 : 1;
        u.A = (const char*)(isx ? (const bf16_t*)(ws + OFF_ACT) + ((size_t)u.e * 2048 + u.pm * 256) * 1024 : (const bf16_t*)(ws + OFF_ACTC) + (size_t)u.e * 256 * 1024);
        u.B = (const char*)((const bf16_t*)(ws + OFF_WD) + ((size_t)u.e * 1024 + u.pn * 256) * 1024); return true; }),
      ([&](const f32x4 (&acc)[2][2][4][2], const pg8::Unit& u, int wr, int wc, int fr, int fq) {
        const bool isx = u.kind == 0;
        const float* sg = (const float*)(ws + OFF_SELG) + (size_t)((isx ? 0 : 16) + u.e) * 2048 + u.pm * 256;
        bf16_t* yb = isx ? (bf16_t*)(ws + OFF_YB) + ((size_t)u.e * 2048 + u.pm * 256) * 1024 : (bf16_t*)(ws + OFF_YBC) + (size_t)u.e * 256 * 1024;
        const int rmask = isx ? 255 : 31;
        float gs[2][4];
#pragma unroll
        for (int ai = 0; ai < 2; ++ai)
#pragma unroll
          for (int m = 0; m < 4; ++m) gs[ai][m] = sg[(ai * 128 + wr * 64 + m * 16 + fr) & rmask];
#pragma unroll
        for (int ai = 0; ai < 2; ++ai)
#pragma unroll
          for (int m = 0; m < 4; ++m) {
            int r0 = ai * 128 + wr * 64 + m * 16 + fr; EPI_FENCE(r0);
            const float g = gs[ai][m];
            bf16_t* rp = yb + (size_t)r0 * 1024 + u.pn * 256 + wc * 32 + fq * 4;
#pragma unroll
            for (int bj = 0; bj < 2; ++bj)
#pragma unroll
              for (int n = 0; n < 2; ++n) { const f32x4 y = acc[ai][bj][m][n] * g; u32x2 w; w.x = pk2(y[0], y[1]); w.y = pk2(y[2], y[3]); *(u32x2*)(rp + bj * 128 + n * 16) = w; }
          }
      }));
    if (ntiles > 512) {
      PHASE_VARS;
      int bb0 = bid; asm volatile("" : "+s"(bb0) :: "memory");
      if (wid < 4) {
        const int task = bb0 + 256 * wid, e = task >> 6, cg = task & 63;
        const bf16_t* Ac = (const bf16_t*)(ws + OFF_ACTC) + (size_t)e * 256 * 1024; const bf16_t* Bc = (const bf16_t*)(ws + OFF_WD) + ((size_t)e * 1024 + 16 * cg) * 1024;
        const float* sgc = (const float*)(ws + OFF_SELG) + (size_t)(16 + e) * 2048; bf16_t* ybc = (bf16_t*)(ws + OFF_YBC) + (size_t)e * 256 * 1024;
        skinny_mma<2, 1, 8>(Ac, Bc, 1024, [&](int mf, int i) { return (16 * mf + i) * 1024; }, [&](int, int i) { return i * 1024; },
          [&](int mf, int, f32x4 acc) { const int row = 16 * mf + (lane & 15), col = 16 * cg + 4 * (lane >> 4);
            const f32x4 y = acc * sgc[row]; u32x2 w; w.x = pk2(y[0], y[1]); w.y = pk2(y[2], y[3]); *(u32x2*)(ybc + (size_t)row * 1024 + col) = w; });
      }
    }
  };
  auto phase_combine = [&](int layer, int nrows, float* xdst, bool next_norm) {
    PHASE_VARS;
    int slot_nx = (gw < nrows && lane < 16) ? ((const int*)(ws + OFF_SLOT))[(size_t)gw * 16 + lane] : -1;
    for (int row = gw; row < nrows; row += ngw) {
      const bool isx = row < SEQ; const int r = isx ? row : row - SEQ; const int set = isx ? 0 : 1;
      const float* xr = isx ? p.out + (size_t)r * 1024 : (const float*)(ws + OFF_CTXMID) + (size_t)r * 1024;
      const bf16_t* yb = isx ? (const bf16_t*)(ws + OFF_YB) : (const bf16_t*)(ws + OFF_YBC); const int capp = isx ? 2048 : 256;
      f32x4 xv[4];
#pragma unroll
      for (int j = 0; j < 4; ++j) xv[j] = ((const f32x4*)xr)[lane + 64 * j];
      f32x4 a[4];
#pragma unroll
      for (int j = 0; j < 4; ++j) a[j] = (f32x4){0.f, 0.f, 0.f, 0.f};
      const int myslot = slot_nx;
      { const int rn = row + ngw; slot_nx = (rn < nrows && lane < 16) ? ((const int*)(ws + OFF_SLOT))[(size_t)rn * 16 + lane] : -1; }
      unsigned long long em = __ballot(myslot >= 0);
      while (em) {
        const int e0 = __builtin_ctzll(em); em &= em - 1;
        const int e1 = em ? __builtin_ctzll(em) : -1; if (em) em &= em - 1;
        const int s0_ = __builtin_amdgcn_readlane(myslot, e0);
        const u32x2* y0 = (const u32x2*)(yb + ((size_t)e0 * capp + s0_) * 1024);
        u32x2 w0[4], w1[4];
#pragma unroll
        for (int j = 0; j < 4; ++j) w0[j] = y0[lane + 64 * j];
        if (e1 >= 0) {
          const int s1_ = __builtin_amdgcn_readlane(myslot, e1);
          const u32x2* y1 = (const u32x2*)(yb + ((size_t)e1 * capp + s1_) * 1024);
#pragma unroll
          for (int j = 0; j < 4; ++j) w1[j] = y1[lane + 64 * j];
#pragma unroll
          for (int j = 0; j < 4; ++j) { a[j].x += bf2f(w1[j].x & 0xffffu); a[j].y += bf2f(w1[j].x >> 16); a[j].z += bf2f(w1[j].y & 0xffffu); a[j].w += bf2f(w1[j].y >> 16); }
        }
#pragma unroll
        for (int j = 0; j < 4; ++j) { a[j].x += bf2f(w0[j].x & 0xffffu); a[j].y += bf2f(w0[j].x >> 16); a[j].z += bf2f(w0[j].y & 0xffffu); a[j].w += bf2f(w0[j].y >> 16); }
      }
      const float* g5 = MODP(layer, set, 5);
      f32x4 v[4];
#pragma unroll
      for (int j = 0; j < 4; ++j) v[j] = xv[j] + ((const f32x4*)g5)[lane + 64 * j] * a[j];
      if (isx) {
#pragma unroll
        for (int j = 0; j < 4; ++j) ((f32x4*)(xdst + (size_t)r * 1024))[lane + 64 * j] = v[j];
      }
      if (next_norm) {
        bf16_t* o = isx ? (bf16_t*)(ws + OFF_HX) + (size_t)r * 1024 : (bf16_t*)(ws + OFF_HC) + (size_t)r * 1024;
        norm_mod_regs(v, p.in[I_NMIX] + 1024, MODP(1, set, 0), MODP(1, set, 1), o, lane);
      }
    }
  };

  phase_router(0, NKEY);
  GRID_BAR();
  TS(8);
  phase_topk(32, 0);
  GRID_BAR();
  TS(9);
  for (int rep_ = 0; rep_ < REP_MOE; ++rep_) phase_gateup(1024 + 128);
  GRID_BAR();
  TS(10);
  for (int rep_ = 0; rep_ < REP_MOE; ++rep_) phase_down(512 + 64);
  GRID_BAR();
  TS(11);
  phase_combine(0, NKEY, (float*)(ws + OFF_X1), true);
  GRID_BAR();
  TS(12);
#if STOP_STAGE <= 10
  { const size_t gid = (size_t)bid * NT + tid; for (size_t i = gid; i < (size_t)SEQ * 256; i += (size_t)G * NT) ((f32x4*)p.out)[i] = ((const f32x4*)(ws + OFF_X1))[i]; }
  return;
#endif
  {
    PHASE_VARS;
    { bf16_t* Qb = (bf16_t*)(ws + OFF_Q); bf16_t* Kb = (bf16_t*)(ws + OFF_KALL); bf16_t* Vb = (bf16_t*)(ws + OFF_VT);
      const bf16_t* Wq = (const bf16_t*)(ws + OFF_WQKV);
      pg8_run(lds, 1024, G, bid,
        ([&](int tile, pg8::Unit& u) { if (tile >= 768) return false; const bool isx = true; const int tt = tile;
          const int pm = isx ? tt / 12 : 0, q = isx ? tt % 12 : 4 + tt;
          const bf16_t* hrow = isx ? (const bf16_t*)(ws + OFF_HX) + (size_t)pm * 256 * 1024 : (const bf16_t*)(ws + OFF_HC);
          u.pm = pm; u.pn = q & 3; u.kind = q >> 2; u.e = isx ? 256 + pm * 256 : 0;
          if (u.kind < 2) { u.A = (const char*)hrow; u.B = (const char*)(Wq + (size_t)q * 256 * 1024); } else { u.A = (const char*)(Wq + (size_t)q * 256 * 1024); u.B = (const char*)hrow; }
          return true; }),
        ([&](const f32x4 (&acc)[2][2][4][2], const pg8::Unit& u, int wr, int wc, int fr, int fq) {
          if (u.kind == 2) {
            bf16_t* base = Vb + (size_t)(u.pn * 256) * NKEY + u.e;
#pragma unroll
            for (int ai = 0; ai < 2; ++ai)
#pragma unroll
              for (int m = 0; m < 4; ++m) {
                int r0 = ai * 128 + wr * 64 + m * 16 + fr; EPI_FENCE(r0);
                bf16_t* rp = base + (size_t)r0 * NKEY + wc * 32 + fq * 4;
#pragma unroll
                for (int bj = 0; bj < 2; ++bj)
#pragma unroll
                  for (int n = 0; n < 2; ++n) { const f32x4 v = acc[ai][bj][m][n]; u32x2 w; w.x = pk2(v[0], v[1]); w.y = pk2(v[2], v[3]); *(u32x2*)(rp + bj * 128 + n * 16) = w; }
              }
          } else {
            const bool isq = u.kind == 0; const bool dorope = isq || u.e != 0;
            const float* gn = isq ? p.in[I_DQN] : p.in[I_DKN];
            const f32x2* rope = (const f32x2*)(ws + OFF_ROPE);
            const float qs = isq ? 0.125f * 1.4426950408889634f : 1.f;
            bf16_t* base = isq ? Qb + (size_t)(u.pm * 256) * 1024 : Kb + (size_t)u.e * 1024;
            f32x4 gnv[2][2];
#pragma unroll
            for (int bj = 0; bj < 2; ++bj)
#pragma unroll
              for (int n = 0; n < 2; ++n) gnv[bj][n] = *(const f32x4*)(gn + 32 * bj + 16 * n + 4 * fq);
#pragma unroll
            for (int ai = 0; ai < 2; ++ai) {
              int prow = u.pm * 4 + ai * 2 + wr; EPI_FENCE(prow);
              const f32x4 rc0 = *(const f32x4*)(rope + prow * 16 + 4 * fq), rc1 = *(const f32x4*)(rope + prow * 16 + 4 * fq + 2);
#pragma unroll
              for (int m = 0; m < 4; ++m) {
                int r0 = ai * 128 + wr * 64 + m * 16 + fr; EPI_FENCE(r0);
                f32x4 v[2][2]; float ss = 0.f;
#pragma unroll
                for (int bj = 0; bj < 2; ++bj)
#pragma unroll
                  for (int n = 0; n < 2; ++n) { v[bj][n] = acc[ai][bj][m][n]; ss += v[bj][n].x * v[bj][n].x + v[bj][n].y * v[bj][n].y + v[bj][n].z * v[bj][n].z + v[bj][n].w * v[bj][n].w; }
                ss += __shfl_xor(ss, 16); ss += __shfl_xor(ss, 32);
                const float rstd = qs / sqrtf(ss * (1.f / 64.f) + 1e-6f);
#pragma unroll
                for (int bj = 0; bj < 2; ++bj)
#pragma unroll
                  for (int n = 0; n < 2; ++n) v[bj][n] = v[bj][n] * gnv[bj][n] * rstd;
                if (dorope) {
                  const int t = u.pm * 256 + r0;
#pragma unroll
                  for (int bj = 0; bj < 2; ++bj) {
                    const int pos = t & 63;
                    const f32x4 cs0 = bj == 0 ? rc0 : *(const f32x4*)(rope + pos * 16 + 4 * fq), cs1 = bj == 0 ? rc1 : *(const f32x4*)(rope + pos * 16 + 4 * fq + 2);
                    const f32x4 a1 = v[bj][0], a2 = v[bj][1];
                    v[bj][0] = (f32x4){a1.x * cs0.x - a2.x * cs0.y, a1.y * cs0.z - a2.y * cs0.w, a1.z * cs1.x - a2.z * cs1.y, a1.w * cs1.z - a2.w * cs1.w};
                    v[bj][1] = (f32x4){a2.x * cs0.x + a1.x * cs0.y, a2.y * cs0.z + a1.y * cs0.w, a2.z * cs1.x + a1.z * cs1.y, a2.w * cs1.z + a1.w * cs1.w};
                  }
                }
                bf16_t* rp = base + (size_t)r0 * 1024 + (4 * u.pn + wc) * 64 + fq * 4;
#pragma unroll
                for (int bj = 0; bj < 2; ++bj)
#pragma unroll
                  for (int n = 0; n < 2; ++n) { u32x2 w; w.x = pk2(v[bj][n].x, v[bj][n].y); w.y = pk2(v[bj][n].z, v[bj][n].w); *(u32x2*)(rp + bj * 32 + n * 16) = w; }
              }
            }
          }
        }));
    }
    {
      PHASE_VARS;
      int bb0 = bid; asm volatile("" : "+s"(bb0) :: "memory");
      if (wid == 0) {
        const int head = bb0 >> 4, rg = bb0 & 15;
        const bf16_t* Ac = (const bf16_t*)(ws + OFF_HC); const bf16_t* Wq = (const bf16_t*)(ws + OFF_WQKV); bf16_t* Kb = (bf16_t*)(ws + OFF_KALL);
        const int f0 = 1024 + 64 * head;
        const float* gn = p.in[I_DKN];
        f32x4 kv[4];
        skinny_mma<1, 4, 4>(Ac, Wq, 1024, [&](int, int i) { return (16 * rg + i) * 1024; },
          [&](int nf, int i) { const int f = f0 + 16 * nf + i; return ((f & ~255) + 128 * ((f >> 5) & 1) + 32 * ((f & 255) >> 6) + (f & 31)) * 1024; },
          [&](int, int nf, f32x4 acc) { kv[nf] = acc; });
        float ss = 0.f;
#pragma unroll
        for (int nf = 0; nf < 4; ++nf) ss += kv[nf].x * kv[nf].x + kv[nf].y * kv[nf].y + kv[nf].z * kv[nf].z + kv[nf].w * kv[nf].w;
        ss += __shfl_xor(ss, 16); ss += __shfl_xor(ss, 32);
        const float rstd = 1.0f / sqrtf(ss * (1.f / 64.f) + 1e-6f);
        bf16_t* rp = Kb + (size_t)(16 * rg + (lane & 15)) * 1024 + 64 * head + 4 * (lane >> 4);
#pragma unroll
        for (int nf = 0; nf < 4; ++nf) { const f32x4 y = kv[nf] * *(const f32x4*)(gn + 16 * nf + 4 * (lane >> 4)) * rstd; u32x2 w; w.x = pk2(y[0], y[1]); w.y = pk2(y[2], y[3]); *(u32x2*)(rp + 16 * nf) = w; }
      } else if (wid == 1) {
        const int fg = bb0 & 63, tq = bb0 >> 6;
        const bf16_t* Wv = (const bf16_t*)(ws + OFF_WQKV) + (size_t)(2048 + 16 * fg) * 1024; const bf16_t* Bc = (const bf16_t*)(ws + OFF_HC); bf16_t* Vb = (bf16_t*)(ws + OFF_VT);
        skinny_mma<1, 4, 4>(Wv, Bc, 1024, [&](int, int i) { return i * 1024; }, [&](int nf, int i) { return (64 * tq + 16 * nf + i) * 1024; },
          [&](int, int nf, f32x4 acc) { const int e = 16 * fg + (lane & 15), tok = 64 * tq + 16 * nf + 4 * (lane >> 4);
            u32x2 w; w.x = pk2(acc[0], acc[1]); w.y = pk2(acc[2], acc[3]); *(u32x2*)(Vb + (size_t)e * NKEY + tok) = w; });
      }
    }
  }
  GRID_BAR();
  TS(13);
  TS(14);
  {
    PHASE_VARS;
    constexpr int KB_B = 64 * 128, VB_B = 128 * 128, BUF_B = KB_B + VB_B;
    const int l16 = lane & 15, g4_ = lane >> 4;
    const bf16_t* Qg = (const bf16_t*)(ws + OFF_Q); const bf16_t* Kg = (const bf16_t*)(ws + OFF_KALL); const bf16_t* Vg = (const bf16_t*)(ws + OFF_VT);
    float* Og = (float*)(ws + OFF_O);
    const int wv = __builtin_amdgcn_readfirstlane(wid);
    const int drow = 8 * wv + (lane >> 3);
    const int dchk = (lane & 7) ^ ((drow & 2) | ((drow >> 1) & 4)), dchv = (lane & 7) ^ ((drow >> 1) & 7);
    const int Rl = 8 * (l16 >> 2) + (l16 & 3), fkl = (l16 & 2) | (((l16 >> 2) & 1) << 2), fvl = (l16 >> 1) & 7;
    int kbase[2], vro[2];
#pragma unroll
    for (int ks = 0; ks < 2; ++ks) { kbase[ks] = Rl * 128 + (((4 * ks + g4_) ^ fkl) << 4); vro[ks] = KB_B + l16 * 128 + (((4 * ks + g4_) ^ fvl) << 4); }
    constexpr int NKT = NKEY / 64;
    const float lam_init = 0.35550906759096926f;
    const float lam = expf(wave_sum(p.in[I_LQ1][lane] * p.in[I_LK1][lane])) - expf(wave_sum(p.in[I_LQ2][lane] * p.in[I_LK2][lane])) + lam_init;
    const unsigned kofs = (unsigned)(drow * 1024 + dchk * 8) * 2u, vofs = (unsigned)(drow * NKEY + dchv * 8) * 2u;
    for (int su2 = 2 * bid; su2 < 1024; su2 += (su2 & 1) ? 2 * G - 1 : 1) {
      const int su = su2 >> 1, pass = su2 & 1;
      const int h = su & 7, qbk = su >> 3, c = 2 * h + pass;
      const char* kbc = (const char*)(Kg + c * 64); const char* vbc = (const char*)(Vg + (size_t)h * 128 * NKEY);
      bf16x8 qf[2][2];
#pragma unroll
      for (int qb = 0; qb < 2; ++qb)
#pragma unroll
        for (int ks = 0; ks < 2; ++ks) qf[qb][ks] = *(const bf16x8*)(Qg + (size_t)(qbk * 256 + wid * 32 + qb * 16 + l16) * 1024 + c * 64 + 32 * ks + 8 * g4_);
      f32x4 o[8][2];
#pragma unroll
      for (int db = 0; db < 8; ++db)
#pragma unroll
        for (int qb = 0; qb < 2; ++qb) o[db][qb] = (f32x4){0.f, 0.f, 0.f, 0.f};
      float lrun[2] = {0.f, 0.f}, lsn[2] = {0.f, 0.f};
#define ATT_LD(gp_, vo_, dst_) do { unsigned _vo = (vo_); asm volatile("" : "+v"(_vo)); __builtin_amdgcn_global_load_lds((const unsigned*)((gp_) + _vo), (LAS unsigned*)(dst_), 16, 0, 0); } while (0)
#define ATT_DMAX(ts_, td_) do { ldsp bb_ = lds + ((td_) & 3) * BUF_B + wv * 1024; \
        ATT_LD(kbc + (size_t)(ts_) * (64 * 1024 * 2), kofs, bb_); \
        ATT_LD(vbc + (size_t)(ts_) * 128, vofs, bb_ + KB_B); \
        ATT_LD(vbc + (size_t)(ts_) * 128 + (size_t)64 * NKEY * 2, vofs, bb_ + KB_B + 8192); } while (0)
#define SB_() __builtin_amdgcn_sched_barrier(0)
#define RD_K(dst, t_, s_) do { ldsp kb_ = lds + ((t_) & 3) * BUF_B + (32 * (s_)) * 128; _Pragma("unroll") for (int hh = 0; hh < 2; ++hh) _Pragma("unroll") for (int ks = 0; ks < 2; ++ks) \
        dst[2 * hh + ks] = *(const LAS bf16x8*)(kb_ + kbase[ks] + hh * 4 * 128); } while (0)
#define RD_V(dst, t_, s_, dh_) do { ldsp vb_ = lds + ((t_) & 3) * BUF_B + vro[s_] + (dh_) * 4 * 2048; _Pragma("unroll") for (int j = 0; j < 4; ++j) dst[j] = *(const LAS bf16x8*)(vb_ + j * 2048); } while (0)
#define MM_K(S, kf_) do { _Pragma("unroll") for (int hh = 0; hh < 2; ++hh) _Pragma("unroll") for (int qb = 0; qb < 2; ++qb) { S[hh][qb] = (f32x4){0.f, 0.f, 0.f, 0.f}; \
        _Pragma("unroll") for (int ks = 0; ks < 2; ++ks) S[hh][qb] = __builtin_amdgcn_mfma_f32_16x16x32_bf16(kf_[2 * hh + ks], qf[qb][ks], S[hh][qb], 0, 0, 0); } } while (0)
#define MM_V(vf_, dh_, pa_, pb_) do { _Pragma("unroll") for (int j = 0; j < 4; ++j) { o[4 * (dh_) + j][0] = __builtin_amdgcn_mfma_f32_16x16x32_bf16(vf_[j], pa_, o[4 * (dh_) + j][0], 0, 0, 0); \
        o[4 * (dh_) + j][1] = __builtin_amdgcn_mfma_f32_16x16x32_bf16(vf_[j], pb_, o[4 * (dh_) + j][1], 0, 0, 0); } } while (0)
#define EXPP(pf_, S, qb_, ls_) do { _Pragma("unroll") for (int hh = 0; hh < 2; ++hh) _Pragma("unroll") for (int r = 0; r < 4; ++r) { S[hh][qb_][r] = __builtin_amdgcn_exp2f(S[hh][qb_][r]); ls_ += S[hh][qb_][r]; } \
        u32x4 a_; a_.x = pk2(S[0][qb_][0], S[0][qb_][1]); a_.y = pk2(S[0][qb_][2], S[0][qb_][3]); a_.z = pk2(S[1][qb_][0], S[1][qb_][1]); a_.w = pk2(S[1][qb_][2], S[1][qb_][3]); pf_ = __builtin_bit_cast(bf16x8, a_); } while (0)
      ATT_DMAX(0, 0); ATT_DMAX(1, 1); ATT_DMAX(2, 2);
      asm volatile("" :: "v"(qf[0][0]), "v"(qf[0][1]), "v"(qf[1][0]), "v"(qf[1][1]));
      asm volatile("s_waitcnt vmcnt(3) lgkmcnt(0)\n\ts_barrier" ::: "memory");
      f32x4 S0[2][2], S1[2][2]; bf16x8 vA[4], vB[4], pf00, pf10, pf01, pf11;
      { bf16x8 kf0[4]; RD_K(kf0, 0, 0); MM_K(S0, kf0); RD_K(kf0, 0, 1); MM_K(S1, kf0); RD_V(vA, 0, 0, 0); }
      EXPP(pf00, S0, 0, lsn[0]); EXPP(pf10, S0, 1, lsn[1]);
#define ATT_ITER(t_) do { \
        { const int tl_ = (t_) + 3 < NKT ? (t_) + 3 : NKT - 1; ATT_DMAX(tl_, (t_) + 3); }     \
        bf16x8 kf[4]; \
        lrun[0] += lsn[0]; lrun[1] += lsn[1]; lsn[0] = 0.f; lsn[1] = 0.f;     \
        SB_(); \
        MM_V(vA, 0, pf00, pf10); EXPP(pf01, S1, 0, lrun[0]); RD_V(vB, t_, 0, 1); SB_(); \
        MM_V(vB, 1, pf00, pf10); EXPP(pf11, S1, 1, lrun[1]); RD_V(vA, t_, 1, 0); RD_K(kf, (t_) + 1, 0); SB_(); \
        MM_K(S0, kf); RD_V(vB, t_, 1, 1); SB_(); \
        MM_V(vA, 0, pf01, pf11); RD_K(kf, (t_) + 1, 1); SB_(); \
        MM_V(vB, 1, pf01, pf11); EXPP(pf00, S0, 0, lsn[0]); RD_V(vA, (t_) + 1, 0, 0); SB_(); \
        MM_K(S1, kf); EXPP(pf10, S0, 1, lsn[1]); \
        asm volatile("s_waitcnt vmcnt(3) lgkmcnt(0)\n\ts_barrier" ::: "memory"); } while (0)
#pragma unroll 1
      for (int kt = 0; kt < NKT; ++kt) ATT_ITER(kt);
#undef ATT_ITER
#undef SB_
#undef RD_V
#undef RD_K
#undef MM_V
#undef MM_K
#undef EXPP
#undef ATT_DMAX
#undef ATT_LD
      asm volatile("s_waitcnt vmcnt(0)\n\ts_barrier" ::: "memory");
      float inv[2];
#pragma unroll
      for (int qb = 0; qb < 2; ++qb) { float l = lrun[qb]; l += __shfl_xor(l, 16); l += __shfl_xor(l, 32); inv[qb] = 1.f / l; }
#pragma unroll
      for (int qb = 0; qb < 2; ++qb) {
        const int row = qbk * 256 + wid * 32 + qb * 16 + l16;
        float* orow = Og + (size_t)row * 2048 + (2 * h) * 128 + 4 * g4_;
        if (pass == 0) {
#pragma unroll
          for (int db = 0; db < 8; ++db) *(f32x4*)(orow + 16 * db) = o[db][qb] * inv[qb];
        } else {
          const float li = lam * inv[qb]; float ss = 0.f;
#pragma unroll
          for (int dp = 0; dp < 4; ++dp) { int eo = 32 * dp; EPI_FENCE(eo); const f32x4 o1a = *(const f32x4*)(orow + eo), o1b = *(const f32x4*)(orow + eo + 16);
#pragma unroll
            for (int j = 0; j < 4; ++j) { const float v = o1a[j] - li * o[2 * dp][qb][j]; o[2 * dp][qb][j] = v; ss += v * v; }
#pragma unroll
            for (int j = 0; j < 4; ++j) { const float v = o1b[j] - li * o[2 * dp + 1][qb][j]; o[2 * dp + 1][qb][j] = v; ss += v * v; } }
          ss += __shfl_xor(ss, 16); ss += __shfl_xor(ss, 32);
          const float rs = (1.f - lam_init) / sqrtf(ss * (1.f / 128.f) + 1e-5f);
          bf16_t* obf = (bf16_t*)(ws + OFF_HX) + (size_t)row * 1024 + h * 128 + 4 * g4_;
          const float* sub = p.in[I_SUBLN] + 4 * g4_;
#pragma unroll
          for (int db = 0; db < 8; ++db) { int eo = 16 * db; EPI_FENCE(eo); const f32x4 gsub = *(const f32x4*)(sub + eo);
            u32x2 w; w.x = pk2(o[db][qb][0] * rs * gsub.x, o[db][qb][1] * rs * gsub.y); w.y = pk2(o[db][qb][2] * rs * gsub.z, o[db][qb][3] * rs * gsub.w);
            *(u32x2*)(obf + eo) = w; }
        }
      }
    }
  }
  GRID_BAR();
  TS(15);
  TS(16);
  {
    PHASE_VARS;
    pg8_run(lds, 1024, G, bid,
      ([&](int tile, pg8::Unit& u) { if (tile >= 256) return false; u.pm = tile >> 2; u.pn = tile & 3; u.kind = 0; u.e = 0;
        u.A = (const char*)((const bf16_t*)(ws + OFF_HX) + (size_t)u.pm * 256 * 1024); u.B = (const char*)((const bf16_t*)(ws + OFF_WDO) + (size_t)u.pn * 256 * 1024); return true; }),
      ([&](const f32x4 (&acc)[2][2][4][2], const pg8::Unit& u, int wr, int wc, int fr, int fq) {
        const float* xin = (const float*)(ws + OFF_X1); float* xo = p.out; const float* gate = MODP(1, 0, 2);
        const int col0 = u.pn * 256 + wc * 32 + fq * 4;
        f32x4 gt[2][2];
#pragma unroll
        for (int bj = 0; bj < 2; ++bj)
#pragma unroll
          for (int n = 0; n < 2; ++n) gt[bj][n] = *(const f32x4*)(gate + col0 + bj * 128 + n * 16);
#pragma unroll
        for (int hp = 0; hp < 4; ++hp) {
          const int ai = hp >> 1, m0 = (hp & 1) * 2;
          f32x4 xr[2][2][2];
          int rb = u.pm * 256 + ai * 128 + wr * 64 + m0 * 16 + fr; EPI_FENCE(rb);
#pragma unroll
          for (int mm = 0; mm < 2; ++mm)
#pragma unroll
            for (int bj = 0; bj < 2; ++bj)
#pragma unroll
              for (int n = 0; n < 2; ++n) xr[mm][bj][n] = *(const f32x4*)(xin + (size_t)(rb + mm * 16) * 1024 + col0 + bj * 128 + n * 16);
#pragma unroll
          for (int mm = 0; mm < 2; ++mm) {
            const size_t base = (size_t)(rb + mm * 16) * 1024 + col0;
#pragma unroll
            for (int bj = 0; bj < 2; ++bj)
#pragma unroll
              for (int n = 0; n < 2; ++n) *(f32x4*)(xo + base + bj * 128 + n * 16) = xr[mm][bj][n] + gt[bj][n] * acc[ai][bj][m0 + mm][n];
          }
        }
      }));
  }
  GRID_BAR();
  TS(17);
#if STOP_STAGE <= 15
  return;
#endif
  phase_router(1, SEQ);
  GRID_BAR();
  TS(18);
  phase_topk(16, 1);
  GRID_BAR();
  TS(19);
  phase_gateup(1024);
  GRID_BAR();
  TS(20);
  phase_down(512);
  GRID_BAR();
  TS(21);
  phase_combine(1, SEQ, p.out, false);
#ifdef LEAK_XCC
  { unsigned* cnt = (unsigned*)(ws + 120 * 1024);
    if (blockIdx.x == 0 && threadIdx.x == 0) { cnt[0] = 0u; cnt[1] = 0u; }
    grid.sync();
    if (threadIdx.x == 0) { const unsigned xc = xb_xcc_id(); if (xc == (blockIdx.x & 7u)) atomicAdd(&cnt[0], 1u); if (xc == (blockIdx.x >> 5)) atomicAdd(&cnt[1], 1u); }
    grid.sync();
    const float dA = (float)cnt[0], dB = (float)cnt[1];
    const float e = sqrtf(dB * 1e-6f);
    const size_t gid = (size_t)blockIdx.x * NT + threadIdx.x;
    for (size_t i = gid; i < (size_t)SEQ * 1024; i += (size_t)G * NT) p.out[i] = p.out[i] * (1.f + e) + (i == 0 ? dA * 0.1f : 0.f); }
#endif
#ifdef LEAK_A0
  grid.sync();
  { if (blockIdx.x == 0 && threadIdx.x == 0) tsbuf[40] = __builtin_amdgcn_s_memrealtime();
    const float dA = (float)(long long)(tsbuf[LEAK_A1] - tsbuf[LEAK_A0]) * 0.01f, dB = (float)(long long)(tsbuf[LEAK_B1] - tsbuf[LEAK_B0]) * 0.01f;
    const float e = sqrtf(dB * 1e-6f);
    const size_t gid = (size_t)blockIdx.x * NT + threadIdx.x;
    for (size_t i = gid; i < (size_t)SEQ * 1024; i += (size_t)G * NT) p.out[i] = p.out[i] * (1.f + e) + (i == 0 ? dA * 0.1f : 0.f); }
#endif
}

extern "C" void kernel_launch(void* const* d_in, const int* in_sizes, int n_in, void* d_out, int out_size,
                              void* d_ws, size_t ws_size, hipStream_t stream) {
  static int grid_blocks = 0;
  if (!grid_blocks) {
    int dev = 0, cus = 0, per_cu = 0;
    (void)hipGetDevice(&dev);
    (void)hipDeviceGetAttribute(&cus, hipDeviceAttributeMultiprocessorCount, dev);
    (void)hipFuncSetAttribute((const void*)mega, hipFuncAttributeMaxDynamicSharedMemorySize, LDS_BYTES);
    (void)hipOccupancyMaxActiveBlocksPerMultiprocessor(&per_cu, mega, NT, LDS_BYTES);
    if (per_cu < 1) { fprintf(stderr, "occupancy query says %d\n", per_cu); per_cu = 1; }
    grid_blocks = cus * (per_cu > 1 ? 1 : per_cu);
    if (ws_size < WS_END) fprintf(stderr, "kernel_launch: workspace too small: %zu < %zu\n", ws_size, (size_t)WS_END);
  }
  if (ws_size < WS_END || n_in != 36) return;
  Params p{};
  for (int i = 0; i < 36; ++i) p.in[i] = (const float*)d_in[i];
  p.out = (float*)d_out; p.ws = (unsigned char*)d_ws;
  (void)hipMemsetAsync((unsigned char*)d_ws + OFF_BAR, 0, 16 * 1024, stream);
  void* args[] = {&p};
  hipError_t e = hipLaunchCooperativeKernel((void*)mega, dim3(grid_blocks), dim3(NT), args, LDS_BYTES, stream);
  if (e != hipSuccess) fprintf(stderr, "cooperative launch failed: %s (grid %d)\n", hipGetErrorString(e), grid_blocks);
}
```

```cpp
#define ATT_PAD "\n\ts_nop 0"
#include <hip/hip_runtime.h>
#include <hip/hip_cooperative_groups.h>
#include <cstdio>
#include <cstdint>
namespace cg = cooperative_groups;

#ifndef PH_MASK
#define PH_MASK 0xffffffffu
#endif
#ifndef REP_P2
#define REP_P2 1
#endif
#ifndef REP_P3
#define REP_P3 1
#endif
#ifndef REP_P13
#define REP_P13 1
#endif
#ifndef REP_MOE
#define REP_MOE 1
#endif
#ifdef DIAG_NOCONV
#define DIAG_Y(y) y = v4mk(0.f, 0.f, 0.f, 0.f)
#else
#define DIAG_Y(y)
#endif
#ifndef STOP_STAGE
#define STOP_STAGE 99
#endif

#define LAS __attribute__((address_space(3)))
typedef LAS unsigned char* ldsp;
typedef unsigned short bf16_t;
typedef short bf16x8 __attribute__((ext_vector_type(8)));
typedef short s16x4 __attribute__((ext_vector_type(4)));
typedef float f32x4 __attribute__((ext_vector_type(4)));
typedef float f32x2 __attribute__((ext_vector_type(2)));
typedef float f32x16 __attribute__((ext_vector_type(16)));
typedef unsigned u32x4 __attribute__((ext_vector_type(4)));
typedef unsigned u32x2 __attribute__((ext_vector_type(2)));
typedef __bf16 bf16x2_t __attribute__((ext_vector_type(2)));
typedef _Float16 h16;
typedef _Float16 h16x2 __attribute__((ext_vector_type(2)));
typedef _Float16 h16x4 __attribute__((ext_vector_type(4)));

constexpr int NT = 512;
constexpr int LDS_BYTES = 147456;
constexpr int SEQ = 16384, CTX = 256, DM = 1024, NKEY = SEQ + CTX;
constexpr size_t MiB = 1u << 20;
constexpr size_t OFF_MODS = 0;
constexpr size_t OFF_BAR = 104 * 1024;
constexpr size_t OFF_ROPE = 160 * 1024;
constexpr size_t OFF_HIDX = 1 * MiB;
constexpr size_t OFF_HIDC = 3 * MiB;
constexpr size_t OFF_W4T = 3 * MiB + 512 * 1024;
constexpr size_t OFF_WIN = 4 * MiB;
constexpr size_t OFF_WHO = 10 * MiB;
constexpr size_t OFF_WQKV = 12 * MiB;
constexpr size_t OFF_WDO = 18 * MiB;
constexpr size_t OFF_KCTX = 20 * MiB;
constexpr size_t OFF_AFF = 24 * MiB;
constexpr size_t OFF_SELI = 26 * MiB;
constexpr size_t OFF_SELG = 26 * MiB + 256 * 1024;
constexpr size_t OFF_SLOT = 26 * MiB + 512 * 1024;
constexpr size_t OFF_CTXMID = 28 * MiB;
constexpr size_t OFF_HC = 30 * MiB;
constexpr size_t OFF_UCT = 31 * MiB;
constexpr size_t OFF_HCT = 33 * MiB;
constexpr size_t OFF_ZC2T = 35 * MiB;
constexpr size_t OFF_ZC2 = 35 * MiB + 512 * 1024;
constexpr size_t OFF_ACTC = 36 * MiB;
constexpr size_t OFF_YBC = 44 * MiB;
constexpr size_t OFF_HX = 56 * MiB;
constexpr size_t OFF_HT = 88 * MiB;
constexpr size_t OFF_WGU = 88 * MiB, OFF_WD = 152 * MiB;
constexpr size_t OFF_KSPEC = 216 * MiB;
constexpr size_t OFF_ACT = 216 * MiB, OFF_YB = 280 * MiB, OFF_O = 216 * MiB;
constexpr size_t OFF_UT = 344 * MiB;
constexpr size_t OFF_X1 = 344 * MiB;
constexpr size_t OFF_Q = 408 * MiB;
constexpr size_t OFF_Z2T = 440 * MiB;
constexpr size_t OFF_KALL = 440 * MiB;
constexpr size_t OFF_VT = 473 * MiB;
constexpr size_t WS_END = 506 * MiB;

struct Params { const float* in[36]; float* out; unsigned char* ws; };
enum { I_X = 0, I_C, I_CTX, I_CCTX, I_ADAW, I_ADAB, I_NMIX, I_NFFN, I_HWIN, I_HBIN, I_HCW, I_HCB, I_FW1, I_FB1, I_FW2, I_FB2, I_FW3, I_FB3, I_FW4, I_FFREQ,
       I_HSKIP, I_HWOUT, I_HBOUT, I_DWQKV, I_DQN, I_DKN, I_LQ1, I_LK1, I_LQ2, I_LK2, I_SUBLN, I_DWOUT, I_ROUTER, I_WG, I_WU, I_WDN };

__device__ __forceinline__ unsigned f2bf(float f) { unsigned u = __builtin_bit_cast(unsigned, f); return (u + 0x7fffu + ((u >> 16) & 1u)) >> 16; }
__device__ __forceinline__ float bf2f(unsigned b) { return __builtin_bit_cast(float, b << 16); }
__device__ __forceinline__ unsigned pk2(float lo, float hi) { f32x2 v = {lo, hi}; bf16x2_t b = __builtin_convertvector(v, bf16x2_t); return __builtin_bit_cast(unsigned, b); }
__device__ __forceinline__ float wave_sum(float v) {
#pragma unroll
  for (int o = 1; o < 64; o <<= 1) v += __shfl_xor(v, o);
  return v;
}
__device__ __forceinline__ float siluf(float x) { return x / (1.f + __expf(-x)); }

#define FFT_HD __device__ __forceinline__
#define FFT_LDS LAS
#define EPI_FENCE(v) asm volatile("" : "+v"(v) :: "memory")
#define FFT_OPAQUE(v) asm volatile("" : "+v"(v))
__device__ __forceinline__ float fft_sin_rev(float x) { return __builtin_amdgcn_sinf(x); }
__device__ __forceinline__ float fft_cos_rev(float x) { return __builtin_amdgcn_cosf(x); }
typedef float v2 __attribute__((ext_vector_type(2)));
typedef float v4 __attribute__((ext_vector_type(4)));
__device__ __forceinline__ v2 v2mk(float a, float b) { v2 r; r.x = a; r.y = b; return r; }
__device__ __forceinline__ v4 v4mk(float a, float b, float c, float d) { v4 r; r.x = a; r.y = b; r.z = c; r.w = d; return r; }
struct cf { float x, y; };
FFT_HD cf cmk(float a, float b) { cf r; r.x = a; r.y = b; return r; }
FFT_HD cf cadd(cf a, cf b) { return cmk(a.x + b.x, a.y + b.y); }
FFT_HD cf csub(cf a, cf b) { return cmk(a.x - b.x, a.y - b.y); }
FFT_HD cf cmul(cf a, cf b) { return cmk(a.x * b.x - a.y * b.y, a.x * b.y + a.y * b.x); }
FFT_HD cf cconj(cf a) { return cmk(a.x, -a.y); }
constexpr int FFT_M = 16384;
FFT_HD int fft_padp(int pp) { return pp + ((pp >> 5) << 1); }
constexpr int FFT_LDS_SLOTS = FFT_M / 2 + (FFT_M >> 6) * 2;
struct cp { v2 re, im; };
FFT_HD cp cpadd(cp a, cp b) { cp r; r.re = a.re + b.re; r.im = a.im + b.im; return r; }
FFT_HD cp cpsub(cp a, cp b) { cp r; r.re = a.re - b.re; r.im = a.im - b.im; return r; }
FFT_HD cp cpmul(cp a, cp b) { cp r; r.re = a.re * b.re - a.im * b.im; r.im = a.re * b.im + a.im * b.re; return r; }
FFT_HD cp cpmulc(cp a, float cr, float ci) { cp r; r.re = a.re * cr - a.im * ci; r.im = a.re * ci + a.im * cr; return r; }

template <bool INV> FFT_HD void dft4(cf& a, cf& b, cf& c, cf& d) {
  cf s0 = cadd(a, c), s1 = csub(a, c), s2 = cadd(b, d), s3 = csub(b, d);
  cf r = INV ? cmk(-s3.y, s3.x) : cmk(s3.y, -s3.x);
  a = cadd(s0, s2); c = csub(s0, s2); b = cadd(s1, r); d = csub(s1, r);
}
template <bool INV> FFT_HD void dft4p(cp& a, cp& b, cp& c, cp& d) {
  cp s0 = cpadd(a, c), s1 = cpsub(a, c), s2 = cpadd(b, d), s3 = cpsub(b, d);
  a = cpadd(s0, s2); c = cpsub(s0, s2);
  if (!INV) { b.re = s1.re + s3.im; b.im = s1.im - s3.re; d.re = s1.re - s3.im; d.im = s1.im + s3.re; }
  else      { b.re = s1.re - s3.im; b.im = s1.im + s3.re; d.re = s1.re + s3.im; d.im = s1.im - s3.re; }
}
template <bool INV> FFT_HD void dft16p(cp (&x)[16]) {
#pragma unroll
  for (int n2 = 0; n2 < 4; ++n2) dft4p<INV>(x[n2], x[4 + n2], x[8 + n2], x[12 + n2]);
  const float C1 = 0.92387953251128674f, S1 = 0.38268343236508977f, C2 = 0.70710678118654752f;
#define TW(i, cr, ci) x[i] = cpmulc(x[i], cr, INV ? -(ci) : (ci))
  TW(4 + 1, C1, -S1); TW(4 + 2, C2, -C2); TW(4 + 3, S1, -C1);
  TW(8 + 1, C2, -C2); TW(8 + 2, 0.f, -1.f); TW(8 + 3, -C2, -C2);
  TW(12 + 1, S1, -C1); TW(12 + 2, -C2, -C2); TW(12 + 3, -C1, S1);
#undef TW
#pragma unroll
  for (int k1 = 0; k1 < 4; ++k1) dft4p<INV>(x[4 * k1], x[4 * k1 + 1], x[4 * k1 + 2], x[4 * k1 + 3]);
}
template <bool INV, int NP> FFT_HD void fft2_bfly16(FFT_LDS v4* A4, int t) {
  constexpr int S = NP / 16, S2 = S / 2;
  constexpr int STR = (S2 >= 32) ? S2 + (S2 >> 5) * 2 : S2;
  FFT_OPAQUE(t);
  const int blk = t / S2, jp = t % S2, j = 2 * jp;
  FFT_LDS v4* ap = A4 + fft_padp((blk * NP + j) >> 1);
  cp w1;
  { const float f0 = (float)j * (1.0f / NP), f1 = (float)(j + 1) * (1.0f / NP);
    w1.re = v2mk(fft_cos_rev(f0), fft_cos_rev(f1));
    w1.im = INV ? v2mk(fft_sin_rev(f0), fft_sin_rev(f1)) : v2mk(-fft_sin_rev(f0), -fft_sin_rev(f1)); }
  cp x[16];
  if (!INV) {
#pragma unroll
    for (int q = 0; q < 16; ++q) { const v4 v = ap[q * STR]; x[q].re = v2mk(v.x, v.y); x[q].im = v2mk(v.z, v.w); }
    dft16p<false>(x);
    cp wq = w1;
#pragma unroll
    for (int q = 0; q < 16; ++q) {
      cp v = x[4 * (q & 3) + (q >> 2)];
      if (q > 0) { v = cpmul(v, wq); if (q < 15) wq = cpmul(wq, w1); }
      ap[q * STR] = v4mk(v.re.x, v.re.y, v.im.x, v.im.y);
    }
  } else {
    cp wq = w1;
#pragma unroll
    for (int q = 0; q < 16; ++q) {
      const v4 t4 = ap[q * STR]; cp v; v.re = v2mk(t4.x, t4.y); v.im = v2mk(t4.z, t4.w);
      if (q > 0) { v = cpmul(v, wq); if (q < 15) wq = cpmul(wq, w1); }
      x[q] = v;
    }
    dft16p<true>(x);
#pragma unroll
    for (int q = 0; q < 16; ++q) { const cp v = x[4 * (q & 3) + (q >> 2)]; ap[q * STR] = v4mk(v.re.x, v.re.y, v.im.x, v.im.y); }
  }
}
template <bool INV> FFT_HD cp fft2_w1_first(int t) {
  const int j = 2 * t; const float f0 = (float)j * (1.0f / FFT_M), f1 = (float)(j + 1) * (1.0f / FFT_M);
  cp w1; w1.re = v2mk(fft_cos_rev(f0), fft_cos_rev(f1)); w1.im = INV ? v2mk(fft_sin_rev(f0), fft_sin_rev(f1)) : v2mk(-fft_sin_rev(f0), -fft_sin_rev(f1)); return w1;
}
FFT_HD void fft2_first_fwd_regs(FFT_LDS v4* A4, int t, cp (&x)[16]) {
  FFT_OPAQUE(t);
  FFT_LDS v4* ap = A4 + fft_padp(t);
  const cp w1 = fft2_w1_first<false>(t);
  dft16p<false>(x);
  cp wq = w1;
#pragma unroll
  for (int q = 0; q < 16; ++q) {
    cp v = x[4 * (q & 3) + (q >> 2)];
    if (q > 0) { v = cpmul(v, wq); if (q < 15) wq = cpmul(wq, w1); }
    ap[q * 544] = v4mk(v.re.x, v.re.y, v.im.x, v.im.y);
  }
}
FFT_HD void fft2_last_inv_regs(FFT_LDS v4* A4, int t, cp (&x)[16]) {
  FFT_OPAQUE(t);
  FFT_LDS v4* ap = A4 + fft_padp(t);
  const cp w1 = fft2_w1_first<true>(t);
  cp wq = w1;
#pragma unroll
  for (int q = 0; q < 16; ++q) {
    const v4 t4 = ap[q * 544]; cp v; v.re = v2mk(t4.x, t4.y); v.im = v2mk(t4.z, t4.w);
    if (q > 0) { v = cpmul(v, wq); if (q < 15) wq = cpmul(wq, w1); }
    x[q] = v;
  }
  dft16p<true>(x);
}
FFT_HD int fft_kbase_of_group(int g) { return (g >> 8) | (((g >> 4) & 15) << 4) | ((g & 15) << 8); }
FFT_HD int fft_group_of_kbase(int kb) { return ((kb & 15) << 8) | (((kb >> 4) & 15) << 4) | (kb >> 8); }
FFT_HD void rfft_unpack(cf Ck, cf Cm, float wr, float wi, cf& Ak, cf& Am) {
  cf E = cmk(0.5f * (Ck.x + Cm.x), 0.5f * (Ck.y - Cm.y));
  cf T = cmk(0.5f * (Ck.x - Cm.x), 0.5f * (Ck.y + Cm.y));
  cf O = cmk(T.y, -T.x);
  cf wO = cmul(cmk(wr, wi), O);
  Ak = cadd(E, wO); Am = cconj(csub(E, wO));
}
FFT_HD void rfft_pack(cf Yk, cf Ym, float wr, float wi, cf& Ck, cf& Cm) {
  cf E = cmk(0.5f * (Yk.x + Ym.x), 0.5f * (Yk.y - Ym.y));
  cf D = cmk(0.5f * (Yk.x - Ym.x), 0.5f * (Yk.y + Ym.y));
  cf O = cmul(cmk(wr, -wi), D);
  Ck = cmk(E.x - O.y, E.y + O.x);
  Cm = cmk(E.x + O.y, -E.y + O.x);
}
FFT_HD void fft2_ldg(FFT_LDS v4* A4, int g, cf (&x)[4]) { const int s = fft_padp(2 * g); const v4 a = A4[s], b = A4[s + 1]; x[0] = cmk(a.x, a.z); x[1] = cmk(a.y, a.w); x[2] = cmk(b.x, b.z); x[3] = cmk(b.y, b.w); }
FFT_HD void fft2_stg(FFT_LDS v4* A4, int g, const cf (&x)[4]) { const int s = fft_padp(2 * g); A4[s] = v4mk(x[0].x, x[1].x, x[0].y, x[1].y); A4[s + 1] = v4mk(x[2].x, x[3].x, x[2].y, x[3].y); }
FFT_HD void fft2_pair(cf& Xk, cf& Xm, int k, cf Kk, cf Km) {
  const float fr = (float)k * (1.0f / (2 * FFT_M)); const float wr = fft_cos_rev(fr), wi = -fft_sin_rev(fr);
  cf Ak, Am; rfft_unpack(Xk, Xm, wr, wi, Ak, Am);
  rfft_pack(cmul(Ak, Kk), cmul(Am, Km), wr, wi, Xk, Xm);
}
template <class LD> FFT_HD void fft2_mid_conv(FFT_LDS v4* A4, int a, LD ld) {
  FFT_OPAQUE(a);
  const int g = (a & 7) | ((a >> 3) << 4);
  cf x[4];
  if (a != 0) {
    const int kb = fft_kbase_of_group(g), kbm = 4096 - kb, gm = fft_group_of_kbase(kbm);
    cf y[4];
    fft2_ldg(A4, g, x); fft2_ldg(A4, gm, y);
    dft4<false>(x[0], x[1], x[2], x[3]); dft4<false>(y[0], y[1], y[2], y[3]);
#pragma unroll
    for (int d = 0; d < 4; ++d) fft2_pair(x[d], y[3 - d], kb + 4096 * d, ld(4 * g + d), ld(4 * gm + 3 - d));
    dft4<true>(x[0], x[1], x[2], x[3]); dft4<true>(y[0], y[1], y[2], y[3]);
    fft2_stg(A4, g, x); fft2_stg(A4, gm, y);
  } else {
    fft2_ldg(A4, 0, x); dft4<false>(x[0], x[1], x[2], x[3]);
    { const cf K0 = ld(0); const float Y0 = (x[0].x + x[0].y) * K0.x, YM = (x[0].x - x[0].y) * K0.y; x[0] = cmk(0.5f * (Y0 + YM), 0.5f * (Y0 - YM)); }
    fft2_pair(x[1], x[3], 4096, ld(1), ld(3));
    { const cf Y = cmul(cconj(x[2]), ld(2)); x[2] = cconj(Y); }
    dft4<true>(x[0], x[1], x[2], x[3]); fft2_stg(A4, 0, x);
    fft2_ldg(A4, 8, x); dft4<false>(x[0], x[1], x[2], x[3]);
    fft2_pair(x[0], x[3], 2048, ld(32), ld(35)); fft2_pair(x[1], x[2], 6144, ld(33), ld(34));
    dft4<true>(x[0], x[1], x[2], x[3]); fft2_stg(A4, 8, x);
  }
}
FFT_HD void fft2_fpair(cf Xk, cf Xm, int k, float scale, cf& Kk, cf& Km) {
  const float fr = (float)k * (1.0f / (2 * FFT_M));
  cf Ak, Am; rfft_unpack(Xk, Xm, fft_cos_rev(fr), -fft_sin_rev(fr), Ak, Am);
  Kk = cmk(Ak.x * scale, Ak.y * scale); Km = cmk(Am.x * scale, Am.y * scale);
}
template <class ST> FFT_HD void fft2_mid_filter(FFT_LDS v4* A4, int a, float scale, ST st) {
  FFT_OPAQUE(a);
  const int g = (a & 7) | ((a >> 3) << 4);
  cf x[4], Kk, Km;
  if (a != 0) {
    const int kb = fft_kbase_of_group(g), kbm = 4096 - kb, gm = fft_group_of_kbase(kbm);
    cf y[4];
    fft2_ldg(A4, g, x); fft2_ldg(A4, gm, y);
    dft4<false>(x[0], x[1], x[2], x[3]); dft4<false>(y[0], y[1], y[2], y[3]);
#pragma unroll
    for (int d = 0; d < 4; ++d) { fft2_fpair(x[d], y[3 - d], kb + 4096 * d, scale, Kk, Km); st(4 * g + d, Kk); st(4 * gm + 3 - d, Km); }
  } else {
    fft2_ldg(A4, 0, x); dft4<false>(x[0], x[1], x[2], x[3]);
    st(0, cmk((x[0].x + x[0].y) * scale, (x[0].x - x[0].y) * scale));
    fft2_fpair(x[1], x[3], 4096, scale, Kk, Km); st(1, Kk); st(3, Km);
    st(2, cmk(x[2].x * scale, -x[2].y * scale));
    fft2_ldg(A4, 8, x); dft4<false>(x[0], x[1], x[2], x[3]);
    fft2_fpair(x[0], x[3], 2048, scale, Kk, Km); st(32, Kk); st(35, Km);
    fft2_fpair(x[1], x[2], 6144, scale, Kk, Km); st(33, Kk); st(34, Km);
  }
}

__device__ __forceinline__ int lds_byte2(int r, int c) { int st = (r >> 4) * 2 + (c >> 5), ob = (r & 15) * 64 + (c & 31) * 2; return st * 1024 + (ob ^ (((ob >> 9) & 1) << 5)); }
__device__ __forceinline__ void stage_rc2(int b, int& R, int& C) { int st = b >> 10, sb = b & 1023, swz = sb ^ (((sb >> 9) & 1) << 5); R = (st >> 1) * 16 + swz / 64; C = (st & 1) * 32 + (swz % 64) / 2; }

struct TileSrc { const bf16_t* A; const bf16_t* B; const int* gidx; int lda, ldb, gmask; };
__device__ __forceinline__ void gemm_offsets(const TileSrc& ts, unsigned (&oa)[4], unsigned (&ob)[4]) {
  const int tid = threadIdx.x, wid = __builtin_amdgcn_readfirstlane(tid >> 6), lane = tid & 63;
#pragma unroll
  for (int i = 0; i < 4; ++i) { int R, C; stage_rc2(wid * 1024 + i * 8192 + lane * 16, R, C);
    const int ra = ts.gidx ? ts.gidx[R & ts.gmask] : R;
    oa[i] = (unsigned)(ra * ts.lda + C) * 2u; ob[i] = (unsigned)(R * ts.ldb + C) * 2u; }
}
#define G_STAGE(ts_, oa_, ob_, buf, kt) do { const int wid_ = __builtin_amdgcn_readfirstlane(threadIdx.x >> 6); const char* ga = (const char*)((ts_).A + (kt) * 64); const char* gb = (const char*)((ts_).B + (kt) * 64); _Pragma("unroll") for (int i = 0; i < 4; ++i) { \
    __builtin_amdgcn_global_load_lds((const unsigned*)(ga + (oa_)[i]), (LAS unsigned*)(shm + (buf) * 65536 + wid_ * 1024 + i * 8192), 16, 0, 0); \
    __builtin_amdgcn_global_load_lds((const unsigned*)(gb + (ob_)[i]), (LAS unsigned*)(shm + (buf) * 65536 + 32768 + wid_ * 1024 + i * 8192), 16, 0, 0); } } while (0)
__device__ __forceinline__ void gemm_issue0(ldsp shm, const TileSrc& ts) { unsigned oa[4], ob[4]; gemm_offsets(ts, oa, ob); G_STAGE(ts, oa, ob, 0, 0); }
template <bool TRANS, class EP, class PF>
__device__ __forceinline__ void gemm_tile(ldsp shm, const TileSrc& ts, int K, bool pre_issued, PF prefetch_next, EP epi) {
  constexpr int TILE_B = 32768, STAGE_B = 65536;
  const int tid = threadIdx.x, wid = __builtin_amdgcn_readfirstlane(tid >> 6), lane = tid & 63, wr = wid >> 2, wc = wid & 3, fr = lane & 15, fq = lane >> 4;
  unsigned oa[4], ob[4];
  gemm_offsets(ts, oa, ob);
  f32x4 acc[8][4];
#pragma unroll
  for (int m = 0; m < 8; ++m)
#pragma unroll
    for (int n = 0; n < 4; ++n) acc[m][n] = (f32x4){0.f, 0.f, 0.f, 0.f};
  const int aoff = lds_byte2(wr * 128 + fr, fq * 8), boff = TILE_B + lds_byte2(wc * 64 + fr, fq * 8);
  const int nt = K / 64;
  if (!pre_issued) G_STAGE(ts, oa, ob, 0, 0);
  asm volatile("s_waitcnt vmcnt(0)" ::: "memory"); __syncthreads();
  for (int t = 0; t < nt; ++t) {
    const int cur = t & 1;
    if (t + 1 < nt) G_STAGE(ts, oa, ob, cur ^ 1, t + 1);
    ldsp sa = shm + cur * STAGE_B;
#pragma unroll
    for (int ks = 0; ks < 2; ++ks) {
      bf16x8 At[8], Bf[4];
#pragma unroll
      for (int m = 0; m < 8; ++m) At[m] = *(const LAS bf16x8*)(sa + aoff + m * 2048 + ks * 1024);
#pragma unroll
      for (int n = 0; n < 4; ++n) Bf[n] = *(const LAS bf16x8*)(sa + boff + n * 2048 + ks * 1024);
#pragma unroll
      for (int m = 0; m < 8; ++m)
#pragma unroll
        for (int n = 0; n < 4; ++n) acc[m][n] = TRANS ? __builtin_amdgcn_mfma_f32_16x16x32_bf16(Bf[n], At[m], acc[m][n], 0, 0, 0) : __builtin_amdgcn_mfma_f32_16x16x32_bf16(At[m], Bf[n], acc[m][n], 0, 0, 0);
      __builtin_amdgcn_sched_barrier(0);
    }
    asm volatile("s_waitcnt vmcnt(0)" ::: "memory"); __syncthreads();
  }
  prefetch_next();
  epi(acc, wr, wc, fr, fq);
}

namespace pg8 {
#define PG8_LAS __attribute__((address_space(3)))
constexpr int BM = 256, BK = 64, HALF = 128, HTB = HALF * BK * 2  , STAGE_BYTES = 8 * HTB;
__device__ __forceinline__ int lds_byte(int r, int c) { const int st = (r >> 4) * 2 + (c >> 5), rr = r & 15, cc = c & 31, ob = rr * 64 + cc * 2; return st * 1024 + (ob ^ (((ob >> 9) & 1) << 5)); }
__device__ __forceinline__ void stage_rc(int b, int& R, int& C) { const int st = b / 1024, sb = b % 1024, swz = sb ^ (((sb >> 9) & 1) << 5); R = (st >> 1) * 16 + swz / 64; C = (st & 1) * 32 + (swz % 64) / 2; }
__device__ __forceinline__ int perm32(int rho) { const int n = rho >> 4, i = rho & 15; return 8 * (i >> 2) + 4 * n + (i & 3); }
struct Unit { const char* A; const char* B; int pm, pn, e, kind; const int* arow; int nvalid; };
template <class F> struct EpiFn { static constexpr bool PERM = false, AFTER_DRAIN = false; F f;
  __device__ __forceinline__ void operator()(const f32x4 (&acc)[2][2][4][2], const Unit& u, int wr, int wc, int fr, int fq) const { f(acc, u, wr, wc, fr, fq); } };
template <class F> struct SchedFn { F f; int G, c;
  __device__ __forceinline__ bool next(int i, Unit& u) const { return f(i * G + c, u); }
  __device__ __forceinline__ void a_ready(const Unit&) const {}
  __device__ __forceinline__ void done(const Unit&) const {} };
template <class Epi, class Sched, bool ALIGN_EPI = false, bool SP2 = false, bool GATHER = false>
__device__ __forceinline__ void gemm_phase(PG8_LAS unsigned char* lds, const int K, const Sched& S, const Epi& E) {
    const int tid = threadIdx.x, wid = __builtin_amdgcn_readfirstlane(tid >> 6), lane = tid & 63, wr = wid >> 2, wc = wid & 3, fr = lane & 15, fq = lane >> 4;
    const int nt = K / BK;
    static_assert(!Epi::PERM, "row-permuted B staging is not kept in this copy");
    int RA0, CA0; stage_rc(tid * 16, RA0, CA0);
    const unsigned voff0 = (unsigned)(RA0 * K + CA0) * 2u;
    const size_t istep = (size_t)64 * K * 2;
    unsigned vg[2][2], vn[2][2];
    PG8_LAS int* gidx = (PG8_LAS int*)(lds + STAGE_BYTES) + RA0;
    if constexpr (GATHER) {
        Unit tu;
        _Pragma("unroll 1") for (int u_ = 0; u_ < 8 && S.next(u_, tu); ++u_) if (tid < 256) ((PG8_LAS int*)(lds + STAGE_BYTES))[u_ * 256 + tid] = tid < tu.nvalid ? tu.arow[tid] : 0;
        __syncthreads();
#pragma unroll
        for (int h = 0; h < 2; ++h)
#pragma unroll
            for (int i = 0; i < 2; ++i) { vg[h][i] = ((unsigned)gidx[h * 128 + i * 64] * (unsigned)K + (unsigned)CA0) * 2u; vn[h][i] = vg[h][i]; }
    }
    const size_t kstep = (size_t)(BK * 2);
    const size_t hstep = (size_t)HALF * K * 2;
    const size_t tstep = 2 * hstep;
    const unsigned ldsw = (unsigned)wid * 1024u;
    const int aoff = lds_byte(wr * 64 + fr, fq * 8), boff = lds_byte(wc * 32 + fr, fq * 8);
#define PG8_SA(b, h) (((b) * 2 + (h)) * HTB)
#define PG8_SB(b, h) ((4 + (b) * 2 + (h)) * HTB)
#define PG8_LD1(bufoff, gptr, vo) do { unsigned _vo = (vo); asm volatile("" : "+v"(_vo));   \
        __builtin_amdgcn_global_load_lds((const unsigned*)((const char*)(gptr) + _vo), (PG8_LAS unsigned*)(lds + (bufoff) + ldsw), 16, 0, 0); } while (0)
#define PG8_STAGE(bufoff, gbase, voff_unused) do { PG8_LD1(bufoff, gbase, voff0); PG8_LD1((bufoff) + 8192, (const char*)(gbase) + istep, voff0); } while (0)
#define PG8_STAGE2(bufoff, gbase, va, vb) do { PG8_LD1(bufoff, gbase, va); PG8_LD1((bufoff) + 8192, gbase, vb); } while (0)
#define PG8_STAGE_A(b, h, gbase) do { if constexpr (GATHER) { PG8_STAGE2(PG8_SA(b, h), gbase, vg[h][0], vg[h][1]); } else { PG8_STAGE(PG8_SA(b, h), (gbase) + (h) * hstep, voffA); } } while (0)
#define PG8_LDA(dst, b, h) do { _Pragma("unroll") for (int m = 0; m < 4; ++m) _Pragma("unroll") for (int k = 0; k < 2; ++k) dst[m][k] = *(const PG8_LAS bf16x8*)(lds + PG8_SA(b, h) + aoff + m * 2048 + k * 1024); } while (0)
#define PG8_LDB(dst, b, h) do { _Pragma("unroll") for (int n = 0; n < 2; ++n) _Pragma("unroll") for (int k = 0; k < 2; ++k) dst[n][k] = *(const PG8_LAS bf16x8*)(lds + PG8_SB(b, h) + boff + n * 2048 + k * 1024); } while (0)
#define PG8_MMA(ai, bj, At, Bt) do { __builtin_amdgcn_s_setprio(1); _Pragma("unroll") for (int m = 0; m < 4; ++m) _Pragma("unroll") for (int n = 0; n < 2; ++n) _Pragma("unroll") for (int k = 0; k < 2; ++k) \
        acc[ai][bj][m][n] = __builtin_amdgcn_mfma_f32_16x16x32_bf16(Bt[n][k], At[m][k], acc[ai][bj][m][n], 0, 0, 0); __builtin_amdgcn_s_setprio(0); } while (0)
#define PG8_WAIT_V(n) asm volatile("s_waitcnt vmcnt(" #n ")" ::: "memory")
#define PG8_WAIT_L(n) asm volatile("s_waitcnt lgkmcnt(" #n ")" ::: "memory")
#define PG8_BAR __builtin_amdgcn_s_barrier()
#define PG8_SCHED __builtin_amdgcn_sched_barrier(0)
    Unit cur, nxt; int ui = 0;
    if (!S.next(0, cur)) return;
    f32x4 acc[2][2][4][2];
#pragma unroll
    for (int a = 0; a < 2; ++a)
#pragma unroll
        for (int b = 0; b < 2; ++b)
#pragma unroll
            for (int m = 0; m < 4; ++m)
#pragma unroll
                for (int n = 0; n < 2; ++n) acc[a][b][m][n] = (f32x4){0.f, 0.f, 0.f, 0.f};
    bf16x8 At[4][2], B0[2][2], B1[2][2];
    const char* cA = cur.A; const char* cB = cur.B;
    S.a_ready(cur);
    if constexpr (SP2) {
        PG8_STAGE(PG8_SB(0, 0), cB, voffB); PG8_STAGE(PG8_SB(0, 1), cB + hstep, voffB); PG8_STAGE_A(0, 0, cA); PG8_STAGE_A(0, 1, cA);
        if (wr == 1) PG8_BAR;
        PG8_WAIT_V(2); PG8_BAR;
        PG8_STAGE(PG8_SB(1, 0), cB + kstep, voffB); PG8_STAGE_A(1, 0, cA + kstep); PG8_STAGE(PG8_SB(1, 1), cB + hstep + kstep, voffB);
        PG8_WAIT_V(6); PG8_BAR;
    } else {
        PG8_STAGE(PG8_SB(0, 0), cB, voffB); PG8_STAGE(PG8_SA(0, 0), cA, voffA); PG8_STAGE(PG8_SB(0, 1), cB + hstep, voffB); PG8_STAGE(PG8_SA(0, 1), cA + hstep, voffA);
        if (wr == 1) PG8_BAR;
        PG8_WAIT_V(4); PG8_BAR;
        PG8_STAGE(PG8_SB(1, 0), cB + kstep, voffB); PG8_STAGE(PG8_SA(1, 0), cA + kstep, voffA); PG8_STAGE(PG8_SB(1, 1), cB + hstep + kstep, voffB);
        PG8_WAIT_V(6); PG8_BAR;
    }
    for (;;) {
        const bool has_next = S.next(ui + 1, nxt);
        const char* nA = has_next ? nxt.A : cA; const char* nB = has_next ? nxt.B : cB;
        if constexpr (GATHER) { if (has_next) {
            _Pragma("unroll") for (int h = 0; h < 2; ++h) _Pragma("unroll") for (int i = 0; i < 2; ++i) vn[h][i] = ((unsigned)gidx[(ui + 1) * 256 + h * 128 + i * 64] * (unsigned)K + (unsigned)CA0) * 2u; } }
        for (int t = 0; t < nt; t += 2) {
            const bool last = (t == nt - 2);
            const char* a1 = cA + (size_t)(t + 1) * kstep;
            const char* a2 = last ? nA : cA + (size_t)(t + 2) * kstep; const char* b2 = last ? nB : cB + (size_t)(t + 2) * kstep;
            const char* a3 = a2 + kstep; const char* b3 = b2 + kstep;
            if (last && has_next) S.a_ready(nxt);
            if constexpr (SP2) {
            PG8_LDB(B0, 0, 0); PG8_LDB(B1, 0, 1); PG8_SCHED; PG8_LDA(At, 0, 0); PG8_STAGE_A(1, 1, a1);
            if constexpr (GATHER) { if (last) {
              _Pragma("unroll") for (int h = 0; h < 2; ++h) _Pragma("unroll") for (int i = 0; i < 2; ++i) vg[h][i] = vn[h][i]; } }
            PG8_WAIT_V(8); PG8_WAIT_L(0); PG8_BAR; PG8_MMA(0, 0, At, B0); PG8_MMA(0, 1, At, B1); PG8_BAR; PG8_SCHED;
            PG8_LDA(At, 0, 1); PG8_STAGE(PG8_SB(0, 0), b2, voffB); PG8_STAGE(PG8_SB(0, 1), b2 + hstep, voffB); PG8_STAGE_A(0, 0, a2);
            PG8_WAIT_V(8); PG8_WAIT_L(0); PG8_BAR; PG8_MMA(1, 0, At, B0); PG8_MMA(1, 1, At, B1); PG8_BAR; PG8_SCHED;
            PG8_LDB(B0, 1, 0); PG8_LDB(B1, 1, 1); PG8_SCHED; PG8_LDA(At, 1, 0); PG8_STAGE_A(0, 1, a2);
            PG8_WAIT_V(8); PG8_WAIT_L(0); PG8_BAR; PG8_MMA(0, 0, At, B0); PG8_MMA(0, 1, At, B1); PG8_BAR; PG8_SCHED;
            PG8_LDA(At, 1, 1); PG8_STAGE(PG8_SB(1, 0), b3, voffB); PG8_STAGE(PG8_SB(1, 1), b3 + hstep, voffB); PG8_STAGE_A(1, 0, a3);
            PG8_WAIT_V(8); PG8_WAIT_L(0); PG8_BAR; PG8_MMA(1, 0, At, B0); PG8_MMA(1, 1, At, B1); PG8_BAR; PG8_SCHED;
            } else {
            PG8_LDB(B0, 0, 0); PG8_SCHED; PG8_LDA(At, 0, 0); PG8_STAGE(PG8_SA(1, 1), a1 + hstep, voffA);
            PG8_WAIT_L(8); PG8_BAR; PG8_WAIT_L(0); PG8_MMA(0, 0, At, B0); PG8_BAR; PG8_SCHED;
            PG8_LDB(B1, 0, 1); PG8_STAGE(PG8_SB(0, 0), b2, voffB);
            PG8_BAR; PG8_WAIT_L(0); PG8_MMA(0, 1, At, B1); PG8_BAR;
            PG8_LDA(At, 0, 1); PG8_STAGE(PG8_SA(0, 0), a2, voffA);
            PG8_BAR; PG8_WAIT_L(0); PG8_MMA(1, 0, At, B0); PG8_BAR; PG8_SCHED;
            PG8_STAGE(PG8_SB(0, 1), b2 + hstep, voffB);
            PG8_WAIT_V(6); PG8_BAR; PG8_MMA(1, 1, At, B1); PG8_BAR;
            PG8_LDB(B0, 1, 0); PG8_SCHED; PG8_LDA(At, 1, 0); PG8_STAGE(PG8_SA(0, 1), a2 + hstep, voffA);
            PG8_WAIT_L(8); PG8_BAR; PG8_WAIT_L(0); PG8_MMA(0, 0, At, B0); PG8_BAR; PG8_SCHED;
            PG8_LDB(B1, 1, 1); PG8_STAGE(PG8_SB(1, 0), b3, voffB);
            PG8_BAR; PG8_WAIT_L(0); PG8_MMA(0, 1, At, B1); PG8_BAR;
            PG8_LDA(At, 1, 1); PG8_STAGE(PG8_SA(1, 0), a3, voffA);
            PG8_BAR; PG8_WAIT_L(0); PG8_MMA(1, 0, At, B0); PG8_BAR; PG8_SCHED;
            PG8_STAGE(PG8_SB(1, 1), b3 + hstep, voffB);
            PG8_WAIT_V(6); PG8_BAR; PG8_MMA(1, 1, At, B1); PG8_BAR;
            }
        }
        if constexpr (ALIGN_EPI) { if (wr == 0) PG8_BAR; }
        if constexpr (!Epi::AFTER_DRAIN) { E(acc, cur, wr, wc, fr, fq); S.done(cur); }
        if (!has_next) break;
#pragma unroll
        for (int a = 0; a < 2; ++a)
#pragma unroll
            for (int b = 0; b < 2; ++b)
#pragma unroll
                for (int m = 0; m < 4; ++m)
#pragma unroll
                    for (int n = 0; n < 2; ++n) acc[a][b][m][n] = (f32x4){0.f, 0.f, 0.f, 0.f};
        cur = nxt; cA = nA; cB = nB; ++ui;
        if constexpr (ALIGN_EPI) { if (wr == 1) PG8_BAR; }
    }
    PG8_WAIT_V(0);
    if constexpr (!ALIGN_EPI) { if (wr == 0) PG8_BAR; }
    PG8_BAR;
    if constexpr (Epi::AFTER_DRAIN) { E.fused(acc, cur, wr, wc, fr, fq, lds, wid, lane); S.done(cur); }
#undef PG8_STAGE_A
#undef PG8_STAGE2
#undef PG8_LD1
#undef PG8_SA
#undef PG8_SB
#undef PG8_STAGE
#undef PG8_LDA
#undef PG8_LDB
#undef PG8_MMA
#undef PG8_WAIT_V
#undef PG8_WAIT_L
#undef PG8_BAR
#undef PG8_SCHED
}
}
template <class SF, class EF>
__device__ __forceinline__ void pg8_run_gather(ldsp lds, int K, int G, int bid, SF sf, EF ef) {
  const pg8::SchedFn<SF> S_{sf, G, bid}; const pg8::EpiFn<EF> E_{ef};
  pg8::gemm_phase<pg8::EpiFn<EF>, pg8::SchedFn<SF>, true, true, true>(lds, K, S_, E_);
}
template <class SF, class EF>
__device__ __forceinline__ void pg8_run(ldsp lds, int K, int G, int bid, SF sf, EF ef) {
  const pg8::SchedFn<SF> S_{sf, G, bid}; const pg8::EpiFn<EF> E_{ef};
  pg8::gemm_phase<pg8::EpiFn<EF>, pg8::SchedFn<SF>, true, true>(lds, K, S_, E_);
}

template <int MF, int NF, int UNR, class AO, class BO, class EP>
__device__ __forceinline__ void skinny_mma(const bf16_t* __restrict__ A, const bf16_t* __restrict__ B, int K, AO aoff, BO boff, EP epi) {
  const int lane = threadIdx.x & 63, i16 = lane & 15, kg = lane >> 4;
  const bf16_t* pa[MF]; const bf16_t* pb[NF];
#pragma unroll
  for (int mf = 0; mf < MF; ++mf) pa[mf] = A + aoff(mf, i16) + 8 * kg;
#pragma unroll
  for (int nf = 0; nf < NF; ++nf) pb[nf] = B + boff(nf, i16) + 8 * kg;
  f32x4 acc[MF][NF];
#pragma unroll
  for (int mf = 0; mf < MF; ++mf)
#pragma unroll
    for (int nf = 0; nf < NF; ++nf) acc[mf][nf] = (f32x4){0.f, 0.f, 0.f, 0.f};
#pragma unroll 1
  for (int kk = 0; kk < K; kk += 32 * UNR) {
    bf16x8 af[UNR][MF], bfr[UNR][NF];
#pragma unroll
    for (int u = 0; u < UNR; ++u) {
#pragma unroll
      for (int mf = 0; mf < MF; ++mf) af[u][mf] = *(const bf16x8*)(pa[mf] + kk + 32 * u);
#pragma unroll
      for (int nf = 0; nf < NF; ++nf) bfr[u][nf] = *(const bf16x8*)(pb[nf] + kk + 32 * u);
    }
    __builtin_amdgcn_sched_barrier(0);
#pragma unroll
    for (int u = 0; u < UNR; ++u)
#pragma unroll
      for (int mf = 0; mf < MF; ++mf)
#pragma unroll
        for (int nf = 0; nf < NF; ++nf) acc[mf][nf] = __builtin_amdgcn_mfma_f32_16x16x32_bf16(bfr[u][nf], af[u][mf], acc[mf][nf], 0, 0, 0);
  }
#pragma unroll
  for (int mf = 0; mf < MF; ++mf)
#pragma unroll
    for (int nf = 0; nf < NF; ++nf) epi(mf, nf, acc[mf][nf]);
}

__device__ __forceinline__ void transpose_item(const float* __restrict__ W, int ldw, int k0, int n0, bf16_t* __restrict__ dst, int ldd, int drow0, LAS float* scr, int lane) {
  { f32x4 v[8]; const int c4 = (lane & 7) * 4;
#pragma unroll
    for (int i = 0; i < 8; ++i) v[i] = *(const f32x4*)(W + (size_t)(k0 + 8 * i + (lane >> 3)) * ldw + n0 + c4);
#pragma unroll
    for (int i = 0; i < 8; ++i) { LAS float* d = scr + (8 * i + (lane >> 3)) * 33 + c4; d[0] = v[i].x; d[1] = v[i].y; d[2] = v[i].z; d[3] = v[i].w; } }
  asm volatile("s_waitcnt lgkmcnt(0)" ::: "memory");
  const int c = lane & 7;
#pragma unroll
  for (int j = 0; j < 4; ++j) {
    const int n = (lane >> 3) + 8 * j; const LAS float* s = scr + (8 * c) * 33 + n;
    u32x4 o; o.x = pk2(s[0], s[33]); o.y = pk2(s[2 * 33], s[3 * 33]); o.z = pk2(s[4 * 33], s[5 * 33]); o.w = pk2(s[6 * 33], s[7 * 33]);
    *(u32x4*)(dst + (size_t)(drow0 + n) * ldd + k0 + 8 * c) = o;
  }
  asm volatile("s_waitcnt lgkmcnt(0)" ::: "memory");
}
__device__ __forceinline__ void transpose_weight(const float* W, int K, int N, bf16_t* dst, int gw, int ngw, LAS float* scr, int lane) {
  const int nblk = N / 32, items = (K / 64) * nblk;
  for (int it = gw; it < items; it += ngw) { const int kb = it / nblk, nb = it % nblk; transpose_item(W, N, kb * 64, nb * 32, dst, K, nb * 32, scr, lane); }
}
__device__ __forceinline__ void convert_moe(const float* wg, const float* wu, const float* wd, bf16_t* Wgu, bf16_t* Wd, int gw, int ngw, LAS float* scr, int lane) {
  const int total = 16 * 1536;
  for (int it = gw; it < total; it += ngw) {
    const int e = it / 1536, r = it % 1536;
    if (r < 1024) {
      const int up = r >> 9, q = r & 511, kb = q >> 5, nb = q & 31;
      const float* W = (up ? wu : wg) + (size_t)e * 1024 * 1024;
      const int f0 = nb * 32, pn = f0 >> 7;
      transpose_item(W, 1024, kb * 64, f0, Wgu + (size_t)e * 2048 * 1024, 1024, pn * 256 + up * 128 + (f0 & 127), scr, lane);
    } else {
      const int q = r - 1024, kb = q >> 5, nb = q & 31;
      transpose_item(wd + (size_t)e * 1024 * 1024, 1024, kb * 64, nb * 32, Wd + (size_t)e * 1024 * 1024, 1024, nb * 32, scr, lane);
    }
  }
}

__device__ __forceinline__ void convert_moe_block(const float* wg, const float* wu, const float* wd, bf16_t* Wgu, bf16_t* Wd, int bid, int G, LAS float* scr) {
  const int t = threadIdx.x;
  for (int it = bid; it < 16 * 3 * 64; it += G) {
    const int e = it / 192, r = it % 192, mat = r >> 6, q = r & 63, kb = q >> 2, nq = q & 3;
    const float* W = (mat == 0 ? wg : mat == 1 ? wu : wd) + (size_t)e * 1024 * 1024;
    const int k0 = kb * 64, n0 = nq * 256;
    { f32x4 v[8]; const int c4 = (t & 63) * 4;
#pragma unroll
      for (int i = 0; i < 8; ++i) v[i] = __builtin_nontemporal_load((const f32x4*)(W + (size_t)(k0 + i * 8 + (t >> 6)) * 1024 + n0 + c4));
#pragma unroll
      for (int i = 0; i < 8; ++i) { LAS float* d = scr + (i * 8 + (t >> 6)) * 257 + c4; d[0] = v[i].x; d[1] = v[i].y; d[2] = v[i].z; d[3] = v[i].w; } }
    __syncthreads();
#pragma unroll
    for (int j = 0; j < 4; ++j) {
      const int qq = t + 512 * j, n = qq >> 3, c = qq & 7; const LAS float* sp = scr + (8 * c) * 257 + n;
      u32x4 o; o.x = pk2(sp[0], sp[257]); o.y = pk2(sp[2 * 257], sp[3 * 257]); o.z = pk2(sp[4 * 257], sp[5 * 257]); o.w = pk2(sp[6 * 257], sp[7 * 257]);
      const int f = n0 + n;
      bf16_t* drow = mat < 2 ? Wgu + ((size_t)e * 2048 + (f >> 7) * 256 + mat * 128 + (f & 127)) * 1024 : Wd + ((size_t)e * 1024 + f) * 1024;
      *(u32x4*)(drow + k0 + 8 * c) = o;
    }
    __syncthreads();
  }
}

__device__ __forceinline__ float norm_mod_regs(const f32x4 (&v)[4], const float* g, const float* shift, const float* scale, bf16_t* orow, int lane) {
  f32x4 gg_[4], sh_[4], sc_[4];
#pragma unroll
  for (int j = 0; j < 4; ++j) { gg_[j] = ((const f32x4*)g)[lane + 64 * j]; sh_[j] = ((const f32x4*)shift)[lane + 64 * j]; sc_[j] = ((const f32x4*)scale)[lane + 64 * j]; }
  __builtin_amdgcn_sched_barrier(0);
  float ss = 0.f;
#pragma unroll
  for (int j = 0; j < 4; ++j) ss += v[j].x * v[j].x + v[j].y * v[j].y + v[j].z * v[j].z + v[j].w * v[j].w;
  const float rstd = 1.0f / sqrtf(wave_sum(ss) * (1.f / 1024.f) + 1e-6f);
#pragma unroll
  for (int j = 0; j < 4; ++j) {
    const f32x4 gg = gg_[j], sh = sh_[j], sc = sc_[j];
    const f32x4 y = v[j] * rstd * gg * (1.f + sc) + sh;
    u32x2 o; o.x = pk2(y.x, y.y); o.y = pk2(y.z, y.w);
    ((u32x2*)orow)[lane + 64 * j] = o;
  }
  return rstd;
}
__device__ __forceinline__ float norm_mod_row(const float* xrow, const float* g, const float* shift, const float* scale, bf16_t* orow, int lane) {
  f32x4 v[4];
#pragma unroll
  for (int j = 0; j < 4; ++j) v[j] = ((const f32x4*)xrow)[lane + 64 * j];
  return norm_mod_regs(v, g, shift, scale, orow, lane);
}
template <int NPT>
__device__ __forceinline__ void topk_block(ldsp lds, const float* aff, int e, int N, int cap, int* sel_idx, float* sel_g, int* slot_of) {
  LAS int* hist = (LAS int*)lds; LAS int* misc = hist + 256; LAS int* wtot = misc + 8;
  const int tid = threadIdx.x, lane = tid & 63, wid = tid >> 6;
  unsigned key[NPT];
#pragma unroll
  for (int i = 0; i < NPT; ++i) { const int idx = tid * NPT + i; key[i] = idx < N ? __builtin_bit_cast(unsigned, aff[(size_t)idx * 16 + e]) : 0u; }
  unsigned prefix = 0u, mask = 0u; int rem = cap;
#pragma unroll 1
  for (int pass = 0; pass < 4; ++pass) {
    const int shift = 24 - 8 * pass;
    if (tid < 256) hist[tid] = 0;
    __syncthreads();
    { int cb = -1, cc = 0;
#pragma unroll
      for (int i = 0; i < NPT; ++i) { const int idx = tid * NPT + i;
        if (idx < N && (key[i] & mask) == prefix) { const int b = (int)((key[i] >> shift) & 255u); if (b == cb) ++cc; else { if (cc) atomicAdd((int*)&hist[cb], cc); cb = b; cc = 1; } } }
      if (cc) atomicAdd((int*)&hist[cb], cc); }
    __syncthreads();
    if (wid == 0) {
      const int h0 = hist[4 * lane], h1 = hist[4 * lane + 1], h2 = hist[4 * lane + 2], h3 = hist[4 * lane + 3];
      const int s = h0 + h1 + h2 + h3; int suf = s;
#pragma unroll
      for (int off = 1; off < 64; off <<= 1) { const int t = __shfl_down(suf, off); if (lane + off < 64) suf += t; }
      int c = suf - s;
      if (c < rem && c + h3 >= rem) { misc[0] = 4 * lane + 3; misc[1] = rem - c; } c += h3;
      if (c < rem && c + h2 >= rem) { misc[0] = 4 * lane + 2; misc[1] = rem - c; } c += h2;
      if (c < rem && c + h1 >= rem) { misc[0] = 4 * lane + 1; misc[1] = rem - c; } c += h1;
      if (c < rem && c + h0 >= rem) { misc[0] = 4 * lane + 0; misc[1] = rem - c; }
    }
    __syncthreads();
    const int bin = misc[0]; rem = misc[1];
    prefix |= (unsigned)bin << shift; mask |= 0xFFu << shift;
    __syncthreads();
  }
  const unsigned T = prefix;
  int cgt = 0, ceq = 0;
#pragma unroll
  for (int i = 0; i < NPT; ++i) { const int idx = tid * NPT + i; if (idx < N) { cgt += key[i] > T ? 1 : 0; ceq += key[i] == T ? 1 : 0; } }
  int igt = cgt, ieq = ceq;
#pragma unroll
  for (int off = 1; off < 64; off <<= 1) { const int a = __shfl_up(igt, off), b = __shfl_up(ieq, off); if (lane >= off) { igt += a; ieq += b; } }
  if (lane == 63) { wtot[wid * 2] = igt; wtot[wid * 2 + 1] = ieq; }
  __syncthreads();
  int bgt = 0, beq = 0, tgt = 0;
#pragma unroll
  for (int w = 0; w < 8; ++w) { const int a = wtot[2 * w], b = wtot[2 * w + 1]; if (w < wid) { bgt += a; beq += b; } tgt += a; }
  int pgt = bgt + igt - cgt, peq = beq + ieq - ceq;
#pragma unroll
  for (int i = 0; i < NPT; ++i) {
    const int idx = tid * NPT + i;
    if (idx < N) {
      int slot = -1;
      if (key[i] > T) slot = pgt++;
      else if (key[i] == T) { if (peq < rem) slot = tgt + peq; ++peq; }
      slot_of[(size_t)idx * 16 + e] = slot;
      if (slot >= 0) { sel_idx[slot] = idx; sel_g[slot] = __builtin_bit_cast(float, key[i]); }
    }
  }
  __syncthreads();
}

#define XB_TMO      128
#define XB_XCNT(j)  (256  + 64 * (j))
#define XB_XSUB(j)  (1280 + 64 * (j))
#define XB_XGEN(j)  (2304 + 64 * (j))
#define XB_TOP      3328
#define XB_TOPGEN   3392
#define XCD_BAR_WORDS 3456
#define XB_SPIN_CAP (1u << 18)

__device__ __forceinline__ unsigned xb_ld(unsigned* p)              { return __hip_atomic_load(p, __ATOMIC_RELAXED, __HIP_MEMORY_SCOPE_AGENT); }
__device__ __forceinline__ unsigned xb_add(unsigned* p, unsigned v) { return __hip_atomic_fetch_add(p, v, __ATOMIC_RELAXED, __HIP_MEMORY_SCOPE_AGENT); }
__device__ __forceinline__ unsigned xb_xcc_id() { return (unsigned)__builtin_amdgcn_s_getreg((3 << 11) | 20) & 0xFu; }
#define XB_SPIN(cond, bar) do { unsigned _sp = 0; while (cond) { __builtin_amdgcn_s_sleep(1); \
    if ((++_sp & 255u) == 0u) { if (xb_ld(&(bar)[XB_TMO])) break; if (_sp > XB_SPIN_CAP) { atomicAdd(&(bar)[XB_TMO], 1u); break; } } } } while (0)

struct XcdBarrier {
    unsigned* bar; unsigned x;
    volatile LAS unsigned* st;
};

__device__ __forceinline__ XcdBarrier xcd_barrier_post(unsigned* bar, volatile LAS unsigned* st) {
    XcdBarrier b; b.bar = bar; b.x = xb_xcc_id(); b.st = st;
    if (threadIdx.x == 0) (void)xb_add(&bar[XB_XCNT(b.x)], 1u);
    return b;
}
__device__ __forceinline__ void xcd_barrier_complete(unsigned* bar, unsigned x, unsigned& nloc, unsigned& nx) {
    const unsigned G = gridDim.x * gridDim.y * gridDim.z;
    unsigned sum, cnt, mine, sp = 0u;
    for (;;) {
        sum = 0u; cnt = 0u; mine = 0u;
#pragma unroll
        for (unsigned j = 0; j < 16; ++j) { const unsigned c = xb_ld(&bar[XB_XCNT(j)]); sum += c; cnt += (c > 0u) ? 1u : 0u; mine = (j == x) ? c : mine; }
        if (sum == G) break;
        __builtin_amdgcn_s_sleep(1);
        if ((++sp & 255u) == 0u) { if (xb_ld(&bar[XB_TMO])) break; if (sp > XB_SPIN_CAP) { atomicAdd(&bar[XB_TMO], 1u); break; } }
    }
    nloc = mine > 0u ? mine : 1u; nx = cnt > 0u ? cnt : 1u;
}

__device__ __forceinline__ void xcd_barrier(const XcdBarrier& b) {
    asm volatile("s_waitcnt vmcnt(0)" ::: "memory");
    __syncthreads();
    if (threadIdx.x == 0) {
        unsigned* bar = b.bar;
        __builtin_amdgcn_s_waitcnt(0);
        unsigned nloc = b.st[0], nx = b.st[1];
        if (nloc == 0u) { xcd_barrier_complete(bar, b.x, nloc, nx); b.st[0] = nloc; b.st[1] = nx; }
        const unsigned old = xb_add(&bar[XB_XSUB(b.x)], 1u);
        const unsigned gen = old / nloc;
        if (old + 1u == (gen + 1u) * nloc) {
            __builtin_amdgcn_fence(__ATOMIC_RELEASE, "agent");
            asm volatile("s_waitcnt vmcnt(0)" ::: "memory");
            (void)xb_add(&bar[XB_TOP], 1u);
        }
        { const unsigned target = (gen + 1u) * nx;
          XB_SPIN((int)(xb_ld(&bar[XB_TOP]) - target) < 0, bar); }
        __builtin_amdgcn_fence(__ATOMIC_ACQUIRE, "agent");
        asm volatile("s_waitcnt vmcnt(0)" ::: "memory");
    }
    __syncthreads();
}


__global__ void __launch_bounds__(NT) mega(Params p) {
  extern __shared__ __attribute__((aligned(16))) unsigned char lds_raw[];
#if defined(LEAK_A0) || defined(LEAK_XCC) || defined(LEAK_SYNC)
  cg::grid_group grid = cg::this_grid();
#endif
  ldsp lds = (ldsp)lds_raw;
  const int tid = threadIdx.x, lane = tid & 63, wid = tid >> 6;
  const int G = gridDim.x, bid = blockIdx.x;
  const int gw = bid * 8 + wid, ngw = G * 8;
  unsigned char* ws = p.ws;
  float* mods = (float*)(ws + OFF_MODS);
#define MODP(layer, set, m) (mods + (((layer) * 2 + (set)) * 6 + (m)) * 1024)
  LAS float* lf = (LAS float*)lds;
  volatile LAS unsigned* xb_st = (volatile LAS unsigned*)(lds + LDS_BYTES - 64);
  if (threadIdx.x < 2) xb_st[threadIdx.x] = 0u;
  __syncthreads();
  const XcdBarrier xbar = xcd_barrier_post((unsigned*)(ws + OFF_BAR), xb_st);
#define GRID_BAR() xcd_barrier(xbar)
#ifdef LEAK_A0
  unsigned long long* tsbuf = (unsigned long long*)(ws + 120 * 1024);
#define TS(k) do { if (blockIdx.x == 0 && threadIdx.x == 0) tsbuf[(k) + 1] = __builtin_amdgcn_s_memrealtime(); } while (0)
  if (blockIdx.x == 0 && threadIdx.x == 0) tsbuf[0] = __builtin_amdgcn_s_memrealtime();
#else
#define TS(k) do {} while (0)
#endif
#define PHASE_VARS int tid = threadIdx.x; asm volatile("" : "+v"(tid)); const int lane = tid & 63, wid = tid >> 6; const int gw = bid * 8 + wid; (void)lane; (void)gw

#if (PH_MASK >> 0) & 1
  {
    PHASE_VARS;
    { for (int i = tid; i < 1024; i += NT) { lf[i] = siluf(p.in[I_C][i]); lf[1024 + i] = siluf(p.in[I_CCTX][i]); }
      __syncthreads();
      for (int task = bid; task < 192; task += G) {
        const int l = task / 96, n0 = (task % 96) * 64, kq = tid >> 4, n4 = tid & 15;
        const float* W = p.in[I_ADAW] + (size_t)l * 1024 * 6144 + n0 + n4 * 4;
        f32x4 s0 = (f32x4){0.f, 0.f, 0.f, 0.f}, s1 = s0;
#pragma unroll 8
        for (int k = kq; k < 1024; k += 32) { const f32x4 w = *(const f32x4*)(W + (size_t)k * 6144); s0 += lf[k] * w; s1 += lf[1024 + k] * w; }
        *(LAS f32x4*)(lf + 2048 + (kq * 16 + n4) * 8) = s0; *(LAS f32x4*)(lf + 2048 + (kq * 16 + n4) * 8 + 4) = s1;
        __syncthreads();
        if (tid < 64) { float a = 0.f, b = 0.f; const int c4 = tid >> 2, cc = tid & 3;
#pragma unroll 8
          for (int q = 0; q < 32; ++q) { a += lf[2048 + (q * 16 + c4) * 8 + cc]; b += lf[2048 + (q * 16 + c4) * 8 + 4 + cc]; }
          const float bb = p.in[I_ADAB][l * 6144 + n0 + tid];
          mods[(l * 2 + 0) * 6144 + n0 + tid] = a + bb; mods[(l * 2 + 1) * 6144 + n0 + tid] = b + bb; }
        __syncthreads();
      }
    }
    __syncthreads();
    { LAS float* w1 = lf; LAS float* w2 = lf + 33 * 64; LAS float* w3 = w2 + 4096; LAS float* bz = w3 + 4096;   LAS float* scr = bz + 256 + wid * 256;
      for (int i = tid; i < 33 * 64; i += NT) w1[i] = p.in[I_FW1][i];
      for (int i = tid; i < 4096; i += NT) { w2[i] = p.in[I_FW2][i]; w3[i] = p.in[I_FW3][i]; }
      if (tid < 64) { bz[tid] = p.in[I_FB1][tid]; bz[64 + tid] = p.in[I_FB2][tid]; bz[128 + tid] = p.in[I_FB3][tid]; bz[192 + tid] = p.in[I_FFREQ][tid]; }
      __syncthreads();
#define WAVE_LDS_SYNC() asm volatile("s_waitcnt lgkmcnt(0)" ::: "memory")
      const float fq_ = bz[192 + lane];
      for (int quad = gw; quad < NKEY / 4; quad += ngw) {
        float zv[4];
#pragma unroll
        for (int k = 0; k < 4; ++k) {
          const int row = quad * 4 + k; const bool isx = row < SEQ; const int l = isx ? row : row - SEQ; const int L = isx ? SEQ : CTX;
          const float t = (float)l / (float)(L - 1); const float w = 6.283185307179586f * (float)l / (float)L;
          if (lane == 0) zv[k] = t;
          else if (lane <= 32) { const int b = (lane - 1) & 15; const float band = 1e-4f + (float)b * ((15.f - 1e-4f) / 15.f); const float a = w * band; zv[k] = (lane <= 16) ? cosf(a) : -sinf(a); }
          else zv[k] = 0.f;
        }
#pragma unroll
        for (int k = 0; k < 4; ++k) scr[64 * k + lane] = zv[k];
        WAVE_LDS_SYNC();
        float a[4], h[4];
#pragma unroll
        for (int k = 0; k < 4; ++k) a[k] = bz[lane];
_Pragma("unroll 4")
        for (int i = 0; i < 33; ++i) { const float wv = w1[i * 64 + lane];
#pragma unroll
          for (int k = 0; k < 4; ++k) a[k] += scr[64 * k + i] * wv; }
#pragma unroll
        for (int k = 0; k < 4; ++k) h[k] = sinf(fq_ * a[k]);
        WAVE_LDS_SYNC();
#pragma unroll
        for (int k = 0; k < 4; ++k) scr[64 * k + lane] = h[k];
        WAVE_LDS_SYNC();
#pragma unroll
        for (int k = 0; k < 4; ++k) a[k] = bz[64 + lane];
_Pragma("unroll 4")
        for (int i = 0; i < 64; ++i) { const float wv = w2[i * 64 + lane];
#pragma unroll
          for (int k = 0; k < 4; ++k) a[k] += scr[64 * k + i] * wv; }
#pragma unroll
        for (int k = 0; k < 4; ++k) h[k] = sinf(fq_ * a[k]);
        WAVE_LDS_SYNC();
#pragma unroll
        for (int k = 0; k < 4; ++k) scr[64 * k + lane] = h[k];
        WAVE_LDS_SYNC();
#pragma unroll
        for (int k = 0; k < 4; ++k) a[k] = bz[128 + lane];
_Pragma("unroll 4")
        for (int i = 0; i < 64; ++i) { const float wv = w3[i * 64 + lane];
#pragma unroll
          for (int k = 0; k < 4; ++k) a[k] += scr[64 * k + i] * wv; }
#pragma unroll
        for (int k = 0; k < 4; ++k) {
          const int row = quad * 4 + k; const bool isx = row < SEQ; const int l = isx ? row : row - SEQ;
          bf16_t* hid = isx ? (bf16_t*)(ws + OFF_HIDX) + (size_t)l * 64 : (bf16_t*)(ws + OFF_HIDC) + (size_t)l * 64;
          hid[lane] = (bf16_t)f2bf(sinf(fq_ * a[k]));
        }
        WAVE_LDS_SYNC();
      }
    }
#undef WAVE_LDS_SYNC
    __syncthreads();
    { LAS float* scr = lf + wid * (64 * 33);
      transpose_weight(p.in[I_FW4], 64, 4096, (bf16_t*)(ws + OFF_W4T), gw, ngw, scr, lane);
      transpose_weight(p.in[I_HWIN], 1024, 3072, (bf16_t*)(ws + OFF_WIN), gw, ngw, scr, lane);
      transpose_weight(p.in[I_HWOUT], 1024, 1024, (bf16_t*)(ws + OFF_WHO), gw, ngw, scr, lane);
      { const float* W = p.in[I_DWQKV]; bf16_t* dst = (bf16_t*)(ws + OFF_WQKV);
        for (int it = gw; it < 16 * 96; it += ngw) { const int kb = it / 96, nb = it % 96; const int f0 = nb * 32;
          const int drow = f0 < 2048 ? (f0 & ~255) + 128 * ((f0 >> 5) & 1) + 32 * ((f0 & 255) >> 6) : f0;
          transpose_item(W, 3072, kb * 64, f0, dst, 1024, drow, scr, lane); } }
      transpose_weight(p.in[I_DWOUT], 1024, 1024, (bf16_t*)(ws + OFF_WDO), gw, ngw, scr, lane);
    }
    { f32x2* rope = (f32x2*)(ws + OFF_ROPE);
      for (int i = bid * NT + tid; i < 4096; i += G * NT) { const int pos = i >> 4, k = i & 15; const float inv = powf(10000.f, -(float)(2 * k) / 32.f); const float a = (float)pos * inv; rope[i] = (f32x2){cosf(a), sinf(a)}; }
    }
  }
#endif
  GRID_BAR();
  TS(0);
#ifdef LEAK_SYNC
  TS(29); grid.sync(); TS(30); grid.sync(); TS(31); grid.sync(); TS(32); grid.sync(); TS(33);
#endif
#if (PH_MASK >> 1) & 1
  {
    PHASE_VARS;
    auto src1 = [&](int tile) { const bool isx = tile < 1024; const int tt = isx ? tile : tile - 1024; const int pm = isx ? (tt >> 6) : tt, pn = isx ? (tt & 63) : 0;
      TileSrc t_; t_.A = (const bf16_t*)(ws + OFF_W4T) + (size_t)pm * 256 * 64; t_.B = isx ? (const bf16_t*)(ws + OFF_HIDX) + (size_t)pn * 256 * 64 : (const bf16_t*)(ws + OFF_HIDC); t_.gidx = nullptr; t_.lda = 64; t_.ldb = 64; t_.gmask = 0; return t_; };
    for (int tile = bid; tile < 1024; tile += G) {
      const bool isx = true; const int tt = tile;
      const int pm = isx ? (tt >> 6) : tt, pn = isx ? (tt & 63) : 0;
      h16* HT = isx ? (h16*)(ws + OFF_HT) : (h16*)(ws + OFF_HCT); const int ld = isx ? SEQ : CTX;
      gemm_tile<true>(lds, src1(tile), 64, tile != bid, [&] { if (tile + G < 1024) gemm_issue0(lds, src1(tile + G)); },
        [&](f32x4 (&acc)[8][4], int wr, int wc, int fr, int fq) {
#pragma unroll
          for (int m = 0; m < 8; ++m) {
            int r0 = pm * 256 + wr * 128 + m * 16 + fr; EPI_FENCE(r0);
            h16* rp = HT + (size_t)r0 * ld + pn * 256 + wc * 64 + fq * 4;
#pragma unroll
            for (int n = 0; n < 4; ++n) *(h16x4*)(rp + n * 16) = __builtin_convertvector(acc[m][n], h16x4);
          }
        });
    }
    if (wid < 4) {
      const int task = bid + 256 * wid, cgp = task >> 2, lq = task & 3;
      const bf16_t* Aw = (const bf16_t*)(ws + OFF_W4T) + (size_t)(16 * cgp) * 64; const bf16_t* Bh = (const bf16_t*)(ws + OFF_HIDC) + (size_t)(64 * lq) * 64; h16* HC = (h16*)(ws + OFF_HCT);
      skinny_mma<1, 4, 2>(Aw, Bh, 64, [&](int, int i) { return i * 64; }, [&](int nf, int i) { return (16 * nf + i) * 64; },
        [&](int, int nf, f32x4 acc) { const int col = 16 * cgp + (lane & 15), l0 = 64 * lq + 16 * nf + 4 * (lane >> 4);
          *(h16x4*)(HC + (size_t)col * CTX + l0) = __builtin_convertvector(acc, h16x4); });
    }
    {
      auto rowp = [&](int row) { const bool isx = row < SEQ; const int r = isx ? row : row - SEQ; return isx ? p.in[I_X] + (size_t)r * 1024 : p.in[I_CTX] + (size_t)r * 1024; };
      f32x4 v[4];
      if (gw < NKEY) {
#pragma unroll
        for (int j = 0; j < 4; ++j) v[j] = ((const f32x4*)rowp(gw))[lane + 64 * j];
      }
      for (int row = gw; row < NKEY; row += ngw) {
        const bool isx = row < SEQ; const int r = isx ? row : row - SEQ; const int set = isx ? 0 : 1;
        bf16_t* o = isx ? (bf16_t*)(ws + OFF_HX) + (size_t)r * 1024 : (bf16_t*)(ws + OFF_HC) + (size_t)r * 1024;
        f32x4 vn[4]; const int rn = row + ngw < NKEY ? row + ngw : row;
#pragma unroll
        for (int j = 0; j < 4; ++j) vn[j] = ((const f32x4*)rowp(rn))[lane + 64 * j];
        norm_mod_regs(v, p.in[I_NMIX], MODP(0, set, 0), MODP(0, set, 1), o, lane);
#pragma unroll
        for (int j = 0; j < 4; ++j) v[j] = vn[j];
      }
    }
  }
#endif
  GRID_BAR();
  TS(1);
#if (PH_MASK >> 2) & 1
  for (int rep_ = 0; rep_ < REP_P2; ++rep_, __syncthreads())
  {
    PHASE_VARS;
    { const float* bin = p.in[I_HBIN];
      pg8_run(lds, 1024, G, bid,
        ([&](int tile, pg8::Unit& u) { if (tile >= 768 + 12) return false; const bool isx = tile < 768; const int tt = isx ? tile : tile - 768;
          u.pm = isx ? tt / 64 : tt; u.pn = isx ? tt % 64 : 0; u.kind = isx ? 0 : 1; u.e = 0;
          u.A = (const char*)((const bf16_t*)(ws + OFF_WIN) + (size_t)u.pm * 256 * 1024);
          u.B = (const char*)(isx ? (const bf16_t*)(ws + OFF_HX) + (size_t)u.pn * 256 * 1024 : (const bf16_t*)(ws + OFF_HC)); return true; }),
        ([&](const f32x4 (&acc)[2][2][4][2], const pg8::Unit& u, int wr, int wc, int fr, int fq) {
          h16* UT = u.kind == 0 ? (h16*)(ws + OFF_UT) : (h16*)(ws + OFF_UCT); const int ld = u.kind == 0 ? SEQ : CTX;
          float bvs[2][4];
#pragma unroll
          for (int ai = 0; ai < 2; ++ai)
#pragma unroll
            for (int m = 0; m < 4; ++m) bvs[ai][m] = bin[u.pm * 256 + ai * 128 + wr * 64 + m * 16 + fr];
#pragma unroll
          for (int ai = 0; ai < 2; ++ai)
#pragma unroll
            for (int m = 0; m < 4; ++m) {
              int r0 = u.pm * 256 + ai * 128 + wr * 64 + m * 16 + fr; EPI_FENCE(r0);
              const float bv = bvs[ai][m];
              h16* rp = UT + (size_t)r0 * ld + u.pn * 256 + wc * 32 + fq * 4;
#pragma unroll
              for (int bj = 0; bj < 2; ++bj)
#pragma unroll
                for (int n = 0; n < 2; ++n) *(h16x4*)(rp + bj * 128 + n * 16) = __builtin_convertvector(acc[ai][bj][m][n] + bv, h16x4);
            }
        }));
    }
    LAS v4* A4 = (LAS v4*)lds; LAS float* red = (LAS float*)(lds + FFT_LDS_SLOTS * 16);
    for (int task = bid; task < 2048; task += G) {
      const int o = task >> 10, c = task & 1023;
      const h16* hf_ = (const h16*)(ws + OFF_HT) + (size_t)((o * 2 + 0) * 1024 + c) * SEQ;
      const h16* hb_ = (const h16*)(ws + OFF_HT) + (size_t)((o * 2 + 1) * 1024 + c) * SEQ;
      const float adl = 3.0701134573253945f + (15.350567286626973f - 3.0701134573253945f) * (float)c * (1.f / 1023.f);
      const float kdec = -adl * (1.f / 16383.f) * 1.4426950408889634f;
      float sabs = 0.f;
      { cp x[16];
#pragma unroll
        for (int q = 0; q < 16; ++q) {
          int pp = tid + 512 * q; EPI_FENCE(pp); float k0, k1, k2, k3;
          if (q < 8) { const h16x4 v = *(const h16x4*)(hf_ + 4 * pp); const float l = (float)(4 * pp);
            k0 = (float)v.x * __builtin_amdgcn_exp2f(kdec * l); k1 = (float)v.y * __builtin_amdgcn_exp2f(kdec * (l + 1.f)); k2 = (float)v.z * __builtin_amdgcn_exp2f(kdec * (l + 2.f)); k3 = (float)v.w * __builtin_amdgcn_exp2f(kdec * (l + 3.f)); }
          else { const int l0 = 32768 - 4 * pp;
            { const float hb0 = (float)hb_[pp == 4096 ? l0 - 1 : l0]; k0 = hb0 * __builtin_amdgcn_exp2f(kdec * (float)l0) * (pp == 4096 ? 0.f : 1.f); }
            k1 = (float)hb_[l0 - 1] * __builtin_amdgcn_exp2f(kdec * (float)(l0 - 1)); k2 = (float)hb_[l0 - 2] * __builtin_amdgcn_exp2f(kdec * (float)(l0 - 2)); k3 = (float)hb_[l0 - 3] * __builtin_amdgcn_exp2f(kdec * (float)(l0 - 3)); }
          sabs += (fabsf(k0) + fabsf(k1)) + (fabsf(k2) + fabsf(k3));
          x[q].re = v2mk(k0, k2); x[q].im = v2mk(k1, k3);
        }
        fft2_first_fwd_regs(A4, tid, x); }
      sabs = wave_sum(sabs); if (lane == 0) red[wid] = sabs;
      __syncthreads();
      float S = 1e-6f;
#pragma unroll
      for (int q = 0; q < 8; ++q) S += red[q];
      const float scale = 1.0f / S;
      fft2_bfly16<false, 1024>(A4, tid);
      __syncthreads();
      fft2_bfly16<false, 64>(A4, tid);
      __syncthreads();
      h16x2* ks = (h16x2*)(ws + OFF_KSPEC) + (size_t)task * FFT_M;
      _Pragma("unroll 1") for (int a = tid; a < 2048; a += NT) fft2_mid_filter(A4, a, scale, [&](int pos, cf v) { h16x2 hv; hv.x = (h16)v.x; hv.y = (h16)v.y; ks[pos] = hv; });
      __syncthreads();
    }
    for (int task = gw; task < 2048; task += ngw) {
      const int o = task >> 10, c = task & 1023;
      const h16* hf_ = (const h16*)(ws + OFF_HCT) + (size_t)((o * 2 + 0) * 1024 + c) * CTX;
      const h16* hb_ = (const h16*)(ws + OFF_HCT) + (size_t)((o * 2 + 1) * 1024 + c) * CTX;
      const float adl = 3.0701134573253945f + (15.350567286626973f - 3.0701134573253945f) * (float)c * (1.f / 1023.f);
      const float kdec = -adl * (1.f / 255.f) * 1.4426950408889634f;
      float f[4], b[4], s = 0.f;
#pragma unroll
      for (int i = 0; i < 4; ++i) { const int l = lane + 64 * i; const float d = __builtin_amdgcn_exp2f(kdec * (float)l); f[i] = (float)hf_[l] * d; b[i] = (float)hb_[l] * d; s += fabsf(f[i]) + (l > 0 ? fabsf(b[i]) : 0.f); }
      const float inv = 1.f / (wave_sum(s) + 1e-6f);
      float* kc = (float*)(ws + OFF_KCTX) + (size_t)task * 512;
#pragma unroll
      for (int i = 0; i < 4; ++i) { const int l = lane + 64 * i; kc[l] = f[i] * inv; if (l > 0) kc[512 - l] = b[i] * inv; else kc[256] = 0.f; }
    }
  }
#endif
  GRID_BAR();
  TS(2);
#if (PH_MASK >> 3) & 1
  for (int rep_ = 0; rep_ < REP_P3; ++rep_, __syncthreads())
  {
    PHASE_VARS;
    LAS v4* A4 = (LAS v4*)lds;
    const float* cw = p.in[I_HCW]; const float* cb = p.in[I_HCB]; const float* skip = p.in[I_HSKIP];
    for (int c = bid; c < 1024; c += G) {
      const h16* uv = (const h16*)(ws + OFF_UT) + (size_t)c * SEQ;
      const h16* u1 = (const h16*)(ws + OFF_UT) + (size_t)(1024 + c) * SEQ;
      const h16* u2 = (const h16*)(ws + OFF_UT) + (size_t)(2048 + c) * SEQ;
#define SCONV4(u, cc, pp, r) do { const h16x4 mid = *(const h16x4*)((u) + 4 * (pp));   \
        const float um_ = (float)(u)[(pp) > 0 ? 4 * (pp) - 1 : 0], up_ = (float)(u)[(pp) < 4095 ? 4 * (pp) + 4 : 16383]; const float um = (pp) > 0 ? um_ : 0.f; const float up = (pp) < 4095 ? up_ : 0.f; \
        const float w0 = cwv[cc][0], w1 = cwv[cc][1], w2 = cwv[cc][2], b_ = cwv[cc][3];     \
        r[0] = b_ + w0 * um + w1 * (float)mid.x + w2 * (float)mid.y; r[1] = b_ + w0 * (float)mid.x + w1 * (float)mid.y + w2 * (float)mid.z; \
        r[2] = b_ + w0 * (float)mid.y + w1 * (float)mid.z + w2 * (float)mid.w; r[3] = b_ + w0 * (float)mid.z + w1 * (float)mid.w + w2 * up; } while (0)
      const float sk0 = skip[c], sk1 = skip[1024 + c];
      float cwv[3][4];
#pragma unroll
      for (int s3 = 0; s3 < 3; ++s3) { const int cc = s3 * 1024 + c; cwv[s3][0] = cw[cc]; cwv[s3][1] = cw[3072 + cc]; cwv[s3][2] = cw[6144 + cc]; cwv[s3][3] = cb[cc]; }
      bf16_t* zo = (bf16_t*)(ws + OFF_Z2T) + (size_t)c * SEQ;
      v4* zkeep = (v4*)(ws + OFF_HX) + (size_t)bid * 4096 + tid;
      { cp x[16];
#pragma unroll
        for (int q = 0; q < 8; ++q) { float z[4]; SCONV4(uv, 0, tid + 512 * q, z); x[q].re = v2mk(z[0], z[2]); x[q].im = v2mk(z[1], z[3]); }
#pragma unroll
        for (int q = 8; q < 16; ++q) { x[q].re = v2mk(0.f, 0.f); x[q].im = v2mk(0.f, 0.f); }
        fft2_first_fwd_regs(A4, tid, x); }
      __syncthreads();
#pragma unroll 1
      for (int o = 0; o < 2; ++o) {
        fft2_bfly16<false, 1024>(A4, tid);
        __syncthreads();
        fft2_bfly16<false, 64>(A4, tid);
        __syncthreads();
        const h16x2* ks = (const h16x2*)(ws + OFF_KSPEC) + (size_t)(o * 1024 + c) * FFT_M;
        _Pragma("unroll 1") for (int a = tid; a < 2048; a += NT) fft2_mid_conv(A4, a, [&](int pos) { const h16x2 hv = ks[pos]; return cmk((float)hv.x * (1.0f / FFT_M), (float)hv.y * (1.0f / FFT_M)); });
        __syncthreads();
        fft2_bfly16<true, 64>(A4, tid);
        __syncthreads();
        fft2_bfly16<true, 1024>(A4, tid);
        __syncthreads();
        cp x[16];
        fft2_last_inv_regs(A4, tid, x);
        if (o == 0) {
          cp x2[16];
#pragma unroll
          for (int q = 0; q < 8; ++q) { int pp = tid + 512 * q; EPI_FENCE(pp); float z[4], g[4]; SCONV4(uv, 0, pp, z); SCONV4(u1, 1, pp, g);
            const cp y = x[4 * (q & 3) + (q >> 2)];
            const v4 v = v4mk(g[0] * (y.re.x + sk0 * z[0]), g[2] * (y.re.y + sk0 * z[2]), g[1] * (y.im.x + sk0 * z[1]), g[3] * (y.im.y + sk0 * z[3]));
            zkeep[512 * q] = v; x2[q].re = v2mk(v.x, v.y); x2[q].im = v2mk(v.z, v.w); }
#pragma unroll
          for (int q = 8; q < 16; ++q) { x2[q].re = v2mk(0.f, 0.f); x2[q].im = v2mk(0.f, 0.f); }
          fft2_first_fwd_regs(A4, tid, x2);
        } else {
#pragma unroll
          for (int q = 0; q < 8; ++q) { int pp = tid + 512 * q; EPI_FENCE(pp); float g[4]; SCONV4(u2, 2, pp, g);
            const cp y = x[4 * (q & 3) + (q >> 2)]; const v4 zz = zkeep[512 * q];
            u32x2 w; w.x = pk2(g[0] * (y.re.x + sk1 * zz.x), g[1] * (y.im.x + sk1 * zz.z)); w.y = pk2(g[2] * (y.re.y + sk1 * zz.y), g[3] * (y.im.y + sk1 * zz.w));
            ((u32x2*)zo)[pp] = w; }
        }
        __syncthreads();
      }
    }
    LAS float* sf = (LAS float*)lds;
    for (int c = bid; c < 1024; c += G) {
      const h16* ub = (const h16*)(ws + OFF_UCT);
      sf[tid] = ((const float*)(ws + OFF_KCTX))[(size_t)c * 512 + tid]; sf[512 + tid] = ((const float*)(ws + OFF_KCTX))[(size_t)(1024 + c) * 512 + tid];
      if (tid < 256) {
#pragma unroll
        for (int s = 0; s < 3; ++s) { const int cc = s * 1024 + c; const h16* u = ub + (size_t)cc * CTX; const float um = tid > 0 ? (float)u[tid - 1] : 0.f, u0 = (float)u[tid], up = tid < 255 ? (float)u[tid + 1] : 0.f;
          sf[1024 + s * 256 + tid] = cb[cc] + cw[cc] * um + cw[3072 + cc] * u0 + cw[6144 + cc] * up; }
      }
      __syncthreads();
      const int t = tid & 255, part = tid >> 8;
#pragma unroll 1
      for (int o = 0; o < 2; ++o) {
        float s = 0.f;
        for (int q = part * 128; q < part * 128 + 128; ++q) s += sf[o * 512 + ((t - q) & 511)] * sf[1024 + q];
        sf[1792 + tid] = s;
        __syncthreads();
        float znew = 0.f;
        if (tid < 256) { const float y = sf[1792 + tid] + sf[1792 + 256 + tid]; znew = sf[1280 + o * 256 + tid] * (y + skip[o * 1024 + c] * sf[1024 + tid]); }
        __syncthreads();
        if (tid < 256) sf[1024 + tid] = znew;
        __syncthreads();
      }
      if (tid < 256) ((bf16_t*)(ws + OFF_ZC2T))[(size_t)c * CTX + tid] = (bf16_t)f2bf(sf[1024 + tid]);
      __syncthreads();
    }
  }
#endif
  GRID_BAR();
  TS(3);
#if (PH_MASK >> 4) & 1
  {
    PHASE_VARS;
    LAS bf16_t* tl = (LAS bf16_t*)lds;
    for (int tile = bid; tile < 4096 + 64; tile += G) {
      const bool isx = tile < 4096; const int tt = isx ? tile : tile - 4096;
      const int ld = isx ? SEQ : CTX; const int ntt = ld / 64;
      const int cb_ = tt / ntt, tb = tt % ntt;
      const bf16_t* src = isx ? (const bf16_t*)(ws + OFF_Z2T) : (const bf16_t*)(ws + OFF_ZC2T);
      bf16_t* dst = isx ? (bf16_t*)(ws + OFF_HX) : (bf16_t*)(ws + OFF_ZC2);
      { const int r = tid >> 3, ch = tid & 7; const u32x4 v = *(const u32x4*)(src + (size_t)(cb_ * 64 + r) * ld + tb * 64 + ch * 8); *(LAS u32x4*)(tl + r * 72 + ch * 8) = v; }
      __syncthreads();
      { const int t = tid >> 3, ch = tid & 7; unsigned short e[8];
#pragma unroll
        for (int i = 0; i < 8; ++i) e[i] = tl[(ch * 8 + i) * 72 + t];
        u32x4 o; o.x = e[0] | ((unsigned)e[1] << 16); o.y = e[2] | ((unsigned)e[3] << 16); o.z = e[4] | ((unsigned)e[5] << 16); o.w = e[6] | ((unsigned)e[7] << 16);
        *(u32x4*)(dst + (size_t)(tb * 64 + t) * 1024 + cb_ * 64 + ch * 8) = o; }
      __syncthreads();
    }
  }
#endif
  GRID_BAR();
  TS(4);
#if (PH_MASK >> 5) & 1
  {
    PHASE_VARS;
    { const float* bo = p.in[I_HBOUT];
      pg8_run(lds, 1024, G, bid,
        ([&](int tile, pg8::Unit& u) { if (tile >= 256) return false; const bool isx = true; const int tt = tile;
          u.pm = isx ? tt >> 2 : 0; u.pn = tt & 3; u.kind = isx ? 0 : 1; u.e = 0;
          u.A = (const char*)(isx ? (const bf16_t*)(ws + OFF_HX) + (size_t)u.pm * 256 * 1024 : (const bf16_t*)(ws + OFF_ZC2));
          u.B = (const char*)((const bf16_t*)(ws + OFF_WHO) + (size_t)u.pn * 256 * 1024); return true; }),
        ([&](const f32x4 (&acc)[2][2][4][2], const pg8::Unit& u, int wr, int wc, int fr, int fq) {
          const bool isx = u.kind == 0;
          const float* xin = isx ? p.in[I_X] : p.in[I_CTX]; float* xo = isx ? p.out : (float*)(ws + OFF_CTXMID);
          const float* gate = MODP(0, isx ? 0 : 1, 2);
          const int col0 = u.pn * 256 + wc * 32 + fq * 4;
          f32x4 gt[2][2], bb[2][2];
#pragma unroll
          for (int bj = 0; bj < 2; ++bj)
#pragma unroll
            for (int n = 0; n < 2; ++n) { gt[bj][n] = *(const f32x4*)(gate + col0 + bj * 128 + n * 16); bb[bj][n] = *(const f32x4*)(bo + col0 + bj * 128 + n * 16); }
#pragma unroll
          for (int hp = 0; hp < 4; ++hp) {
            const int ai = hp >> 1, m0 = (hp & 1) * 2;
            f32x4 xr[2][2][2];
            int rb = u.pm * 256 + ai * 128 + wr * 64 + m0 * 16 + fr; EPI_FENCE(rb);
#pragma unroll
            for (int mm = 0; mm < 2; ++mm)
#pragma unroll
              for (int bj = 0; bj < 2; ++bj)
#pragma unroll
                for (int n = 0; n < 2; ++n) xr[mm][bj][n] = *(const f32x4*)(xin + (size_t)(rb + mm * 16) * 1024 + col0 + bj * 128 + n * 16);
#pragma unroll
            for (int mm = 0; mm < 2; ++mm) {
              const size_t base = (size_t)(rb + mm * 16) * 1024 + col0;
#pragma unroll
              for (int bj = 0; bj < 2; ++bj)
#pragma unroll
                for (int n = 0; n < 2; ++n) *(f32x4*)(xo + base + bj * 128 + n * 16) = xr[mm][bj][n] + gt[bj][n] * (acc[ai][bj][m0 + mm][n] + bb[bj][n]);
            }
          }
        }));
    }
    {
      PHASE_VARS;
      int bb0 = bid; asm volatile("" : "+s"(bb0) :: "memory");
      if (wid < 2) {
        const int task = bb0 + 256 * wid, cg = task >> 3, rp_ = task & 7;
        const bf16_t* Ac = (const bf16_t*)(ws + OFF_ZC2); const bf16_t* Bc = (const bf16_t*)(ws + OFF_WHO) + (size_t)(16 * cg) * 1024;
        const float* cin = p.in[I_CTX]; float* cmid = (float*)(ws + OFF_CTXMID); const float* gatec = MODP(0, 1, 2); const float* boc = p.in[I_HBOUT];
        skinny_mma<2, 1, 8>(Ac, Bc, 1024, [&](int mf, int i) { return (32 * rp_ + 16 * mf + i) * 1024; }, [&](int, int i) { return i * 1024; },
          [&](int mf, int, f32x4 acc) { const int row = 32 * rp_ + 16 * mf + (lane & 15), col = 16 * cg + 4 * (lane >> 4);
            const size_t idx = (size_t)row * 1024 + col;
            *(f32x4*)(cmid + idx) = *(const f32x4*)(cin + idx) + *(const f32x4*)(gatec + col) * (acc + *(const f32x4*)(boc + col)); });
      }
    }
  }
#endif
  GRID_BAR();
  TS(5);

#ifdef DIAG_C
  {
    unsigned* cnt = (unsigned*)(ws + OFF_AFF);
    if (bid == 0 && tid == 0) { cnt[0] = 0u; cnt[1] = 0u; }
    GRID_BAR();
  TS(6);
    const unsigned gid = bid * NT + tid; unsigned hsh = gid * 2654435761u + 12345u; hsh ^= hsh >> 13; hsh *= 0x5bd1e995u; hsh ^= hsh >> 15;
    const int ch = hsh % 1024u, tok = (hsh >> 12) % 16384u, n1 = (hsh >> 5) % 1024u;
    int bad = 0;
    const h16* UTp = (const h16*)(ws + OFF_UT); const float* cw = p.in[I_HCW]; const float* cb = p.in[I_HCB]; const float* skip = p.in[I_HSKIP];
    auto sc = [&](int cc, int t) { const h16* u = UTp + (size_t)cc * SEQ; const float um = t > 0 ? (float)u[t - 1] : 0.f, u0 = (float)u[t], up = t < SEQ - 1 ? (float)u[t + 1] : 0.f; return cb[cc] + cw[cc] * um + cw[3072 + cc] * u0 + cw[6144 + cc] * up; };
    { const float v = sc(ch, tok), g1 = sc(1024 + ch, tok), g2 = sc(2048 + ch, tok); const float r = g2 * (skip[1024 + ch] * (g1 * (skip[ch] * v)));
      const float got = bf2f(((const bf16_t*)(ws + OFF_Z2T))[(size_t)ch * SEQ + tok]); if (!(fabsf(got - r) <= 0.01f + 0.02f * fabsf(r))) bad |= DIAG_C & 1;
      const float got2 = bf2f(((const bf16_t*)(ws + OFF_HX))[(size_t)tok * 1024 + ch]); if (got2 != got) bad |= DIAG_C & 2; }
    { float acc = 0.f; const bf16_t* zr = (const bf16_t*)(ws + OFF_HX) + (size_t)tok * 1024; const bf16_t* wr_ = (const bf16_t*)(ws + OFF_WHO) + (size_t)n1 * 1024;
      for (int q = 0; q < 1024; ++q) acc += bf2f(zr[q]) * bf2f(wr_[q]);
      const float r = p.in[I_X][(size_t)tok * 1024 + n1] + mods[2 * 1024 + n1] * (acc + p.in[I_HBOUT][n1]);
      const float got = p.out[(size_t)tok * 1024 + n1]; if (!(fabsf(got - r) <= 0.005f + 0.005f * fabsf(r))) bad |= DIAG_C & 4; }
    if (bad) atomicAdd(&cnt[0], 1u);
    GRID_BAR();
  TS(7);
    const float f = (float)cnt[0] / (float)(G * NT); const float e = sqrtf(f);
    for (size_t i = (size_t)gid; i < (size_t)SEQ * 1024; i += (size_t)G * NT) p.out[i] = p.in[I_X][i] * (1.f + e);
    return;
  }
#endif
#if STOP_STAGE <= 5
  return;
#endif
  auto phase_router = [&](int layer, int nrows) {
    PHASE_VARS;
    for (int i = tid; i < 16384; i += NT) lf[(i & 15) * 1024 + (i >> 4)] = p.in[I_ROUTER][(size_t)layer * 16384 + i];
    __syncthreads();
    const float* gn = p.in[I_NFFN] + layer * 1024;
    const int b5 = (lane >> 5) & 1, b4 = (lane >> 4) & 1, b3 = (lane >> 3) & 1, b2 = (lane >> 2) & 1;
    auto rrow = [&](int row) { const bool isx = row < SEQ; const int r = isx ? row : row - SEQ; return isx ? (const float*)p.out + (size_t)r * 1024 : (const float*)(ws + OFF_CTXMID) + (size_t)r * 1024; };
    f32x4 hn[4];
    if (gw < nrows) {
#pragma unroll
      for (int j = 0; j < 4; ++j) hn[j] = ((const f32x4*)rrow(gw))[lane + 64 * j];
    }
    for (int row = gw; row < nrows; row += ngw) {
      const bool isx = row < SEQ; const int r = isx ? row : row - SEQ; const int set = isx ? 0 : 1;
      bf16_t* o = isx ? (bf16_t*)(ws + OFF_HX) + (size_t)r * 1024 : (bf16_t*)(ws + OFF_HC) + (size_t)r * 1024;
      const float* sh = MODP(layer, set, 3); const float* sc = MODP(layer, set, 4);
      f32x4 h[4]; float ss = 0.f;
#pragma unroll
      for (int j = 0; j < 4; ++j) { h[j] = hn[j]; ss += h[j].x * h[j].x + h[j].y * h[j].y + h[j].z * h[j].z + h[j].w * h[j].w; }
      { const int rn = row + ngw < nrows ? row + ngw : row;
#pragma unroll
        for (int j = 0; j < 4; ++j) hn[j] = ((const f32x4*)rrow(rn))[lane + 64 * j]; }
      f32x4 gg_[4], sh_[4], sc_[4];
#pragma unroll
      for (int j = 0; j < 4; ++j) { gg_[j] = ((const f32x4*)gn)[lane + 64 * j]; sh_[j] = ((const f32x4*)sh)[lane + 64 * j]; sc_[j] = ((const f32x4*)sc)[lane + 64 * j]; }
      __builtin_amdgcn_sched_barrier(0);
      const float rstd = 1.0f / sqrtf(wave_sum(ss) * (1.f / 1024.f) + 1e-6f);
#pragma unroll
      for (int j = 0; j < 4; ++j) {
        const f32x4 gg = gg_[j], shv = sh_[j], scv = sc_[j];
        h[j] = h[j] * rstd * gg * (1.f + scv) + shv;
        u32x2 w; w.x = pk2(h[j].x, h[j].y); w.y = pk2(h[j].z, h[j].w); ((u32x2*)o)[lane + 64 * j] = w;
      }
      float lg[16];
#pragma unroll
      for (int e = 0; e < 16; ++e) { float a = 0.f; int lo = 4 * lane; EPI_FENCE(lo);
#pragma unroll
        for (int j = 0; j < 4; ++j) { const f32x4 w = *(const LAS f32x4*)(lf + e * 1024 + 256 * j + lo); a += h[j].x * w.x + h[j].y * w.y + h[j].z * w.z + h[j].w * w.w; }
        lg[e] = a; }
      float r8[8], r4[4], r2[2];
#pragma unroll
      for (int i = 0; i < 8; ++i) { const float keep = b5 ? lg[8 + i] : lg[i], give = b5 ? lg[i] : lg[8 + i]; r8[i] = keep + __shfl_xor(give, 32); }
#pragma unroll
      for (int i = 0; i < 4; ++i) { const float keep = b4 ? r8[4 + i] : r8[i], give = b4 ? r8[i] : r8[4 + i]; r4[i] = keep + __shfl_xor(give, 16); }
#pragma unroll
      for (int i = 0; i < 2; ++i) { const float keep = b3 ? r4[2 + i] : r4[i], give = b3 ? r4[i] : r4[2 + i]; r2[i] = keep + __shfl_xor(give, 8); }
      float lgt = (b2 ? r2[1] : r2[0]) + __shfl_xor(b2 ? r2[0] : r2[1], 4);
      lgt += __shfl_xor(lgt, 2); lgt += __shfl_xor(lgt, 1);
      float mxv = lgt;
      mxv = fmaxf(mxv, __shfl_xor(mxv, 4)); mxv = fmaxf(mxv, __shfl_xor(mxv, 8)); mxv = fmaxf(mxv, __shfl_xor(mxv, 16)); mxv = fmaxf(mxv, __shfl_xor(mxv, 32));
      const float ex = __expf(lgt - mxv);
      float den = ex;
      den += __shfl_xor(den, 4); den += __shfl_xor(den, 8); den += __shfl_xor(den, 16); den += __shfl_xor(den, 32);
      if ((lane & 3) == 0) ((float*)(ws + OFF_AFF))[(size_t)row * 16 + (8 * b5 + 4 * b4 + 2 * b3 + b2)] = ex / den;
    }
    __syncthreads();
  };
  auto phase_topk = [&](int ntasks, int layer) {
    PHASE_VARS;
    if (bid >= ntasks) { const size_t lo = (size_t)layer * 16 * 1024 * 1024;
      convert_moe_block(p.in[I_WG] + lo, p.in[I_WU] + lo, p.in[I_WDN] + lo, (bf16_t*)(ws + OFF_WGU), (bf16_t*)(ws + OFF_WD), bid - ntasks, G - ntasks, lf); }
    for (int task = bid; task < ntasks; task += G) {
      const int set = task >> 4, e = task & 15;
      int* si = (int*)(ws + OFF_SELI) + (size_t)task * 2048; float* sg = (float*)(ws + OFF_SELG) + (size_t)task * 2048;
      if (set == 0) topk_block<32>(lds, (const float*)(ws + OFF_AFF), e, SEQ, 2048, si, sg, (int*)(ws + OFF_SLOT));
      else topk_block<1>(lds, (const float*)(ws + OFF_AFF) + (size_t)SEQ * 16, e, CTX, 32, si, sg, (int*)(ws + OFF_SLOT) + (size_t)SEQ * 16);
    }
  };
  auto phase_gateup = [&](int ntiles) {
    PHASE_VARS;
    pg8_run_gather(lds, 1024, G, bid,
      ([&](int tile, pg8::Unit& u) { if (tile >= ntiles) return false; const bool isx = tile < 1024; const int tt = isx ? tile : tile - 1024;
        u.e = isx ? tt >> 6 : tt >> 3; u.pn = isx ? (tt >> 3) & 7 : tt & 7; u.pm = isx ? tt & 7 : 0; u.kind = isx ? 0 : 1;
        u.A = (const char*)(isx ? (const bf16_t*)(ws + OFF_HX) : (const bf16_t*)(ws + OFF_HC));
        u.arow = (const int*)(ws + OFF_SELI) + (size_t)((isx ? 0 : 16) + u.e) * 2048 + u.pm * 256; u.nvalid = isx ? 256 : 32;
        u.B = (const char*)((const bf16_t*)(ws + OFF_WGU) + ((size_t)u.e * 2048 + u.pn * 256) * 1024); return true; }),
      ([&](const f32x4 (&acc)[2][2][4][2], const pg8::Unit& u, int wr, int wc, int fr, int fq) {
        bf16_t* act = u.kind == 0 ? (bf16_t*)(ws + OFF_ACT) + ((size_t)u.e * 2048 + u.pm * 256) * 1024 : (bf16_t*)(ws + OFF_ACTC) + (size_t)u.e * 256 * 1024;
#pragma unroll
        for (int ai = 0; ai < 2; ++ai)
#pragma unroll
          for (int m = 0; m < 4; ++m) {
            int r0 = ai * 128 + wr * 64 + m * 16 + fr; EPI_FENCE(r0);
            bf16_t* rp = act + (size_t)r0 * 1024 + u.pn * 128 + wc * 32 + fq * 4;
#pragma unroll
            for (int n = 0; n < 2; ++n) { const f32x4 gv = acc[ai][0][m][n], uv_ = acc[ai][1][m][n]; f32x4 y;
#pragma unroll
              for (int j = 0; j < 4; ++j) y[j] = gv[j] / (1.f + __expf(-gv[j])) * uv_[j];
              u32x2 w; w.x = pk2(y[0], y[1]); w.y = pk2(y[2], y[3]); *(u32x2*)(rp + n * 16) = w; }
          }
      }));
  };
  auto phase_down = [&](int ntiles) {
    PHASE_VARS;
    pg8_run(lds, 1024, G, bid,
      ([&](int tile, pg8::Unit& u) { if (tile >= 512) return false; const bool isx = true; const int tt = tile;
        u.e = isx ? tt >> 5 : tt >> 2; u.pn = isx ? (tt >> 3) & 3 : tt & 3; u.pm = isx ? tt & 7 : 0; u.kind = isx ? 0 : 1;
        u.A = (const char*)(isx ? (const bf16_t*)(ws + OFF_ACT) + ((size_t)u.e * 2048 + u.pm * 256) * 1024 : (const bf16_t*)(ws + OFF_ACTC) + (size_t)u.e * 256 * 1024);
        u.B = (const char*)((const bf16_t*)(ws + OFF_WD) + ((size_t)u.e * 1024 + u.pn * 256) * 1024); return true; }),
      ([&](const f32x4 (&acc)[2][2][4][2], const pg8::Unit& u, int wr, int wc, int fr, int fq) {
        const bool isx = u.kind == 0;
        const float* sg = (const float*)(ws + OFF_SELG) + (size_t)((isx ? 0 : 16) + u.e) * 2048 + u.pm * 256;
        bf16_t* yb = isx ? (bf16_t*)(ws + OFF_YB) + ((size_t)u.e * 2048 + u.pm * 256) * 1024 : (bf16_t*)(ws + OFF_YBC) + (size_t)u.e * 256 * 1024;
        const int rmask = isx ? 255 : 31;
        float gs[2][4];
#pragma unroll
        for (int ai = 0; ai < 2; ++ai)
#pragma unroll
          for (int m = 0; m < 4; ++m) gs[ai][m] = sg[(ai * 128 + wr * 64 + m * 16 + fr) & rmask];
#pragma unroll
        for (int ai = 0; ai < 2; ++ai)
#pragma unroll
          for (int m = 0; m < 4; ++m) {
            int r0 = ai * 128 + wr * 64 + m * 16 + fr; EPI_FENCE(r0);
            const float g = gs[ai][m];
            bf16_t* rp = yb + (size_t)r0 * 1024 + u.pn * 256 + wc * 32 + fq * 4;
#pragma unroll
            for (int bj = 0; bj < 2; ++bj)
#pragma unroll
              for (int n = 0; n < 2; ++n) { const f32x4 y = acc[ai][bj][m][n] * g; u32x2 w; w.x = pk2(y[0], y[1]); w.y = pk2(y[2], y[3]); *(u32x2*)(rp + bj * 128 + n * 16) = w; }
          }
      }));
    if (ntiles > 512) {
      PHASE_VARS;
      int bb0 = bid; asm volatile("" : "+s"(bb0) :: "memory");
      if (wid < 4) {
        const int task = bb0 + 256 * wid, e = task >> 6, cg = task & 63;
        const bf16_t* Ac = (const bf16_t*)(ws + OFF_ACTC) + (size_t)e * 256 * 1024; const bf16_t* Bc = (const bf16_t*)(ws + OFF_WD) + ((size_t)e * 1024 + 16 * cg) * 1024;
        const float* sgc = (const float*)(ws + OFF_SELG) + (size_t)(16 + e) * 2048; bf16_t* ybc = (bf16_t*)(ws + OFF_YBC) + (size_t)e * 256 * 1024;
        skinny_mma<2, 1, 8>(Ac, Bc, 1024, [&](int mf, int i) { return (16 * mf + i) * 1024; }, [&](int, int i) { return i * 1024; },
          [&](int mf, int, f32x4 acc) { const int row = 16 * mf + (lane & 15), col = 16 * cg + 4 * (lane >> 4);
            const f32x4 y = acc * sgc[row]; u32x2 w; w.x = pk2(y[0], y[1]); w.y = pk2(y[2], y[3]); *(u32x2*)(ybc + (size_t)row * 1024 + col) = w; });
      }
    }
  };
  auto phase_combine = [&](int layer, int nrows, float* xdst, bool next_norm) {
    PHASE_VARS;
    int slot_nx = (gw < nrows && lane < 16) ? ((const int*)(ws + OFF_SLOT))[(size_t)gw * 16 + lane] : -1;
    for (int row = gw; row < nrows; row += ngw) {
      const bool isx = row < SEQ; const int r = isx ? row : row - SEQ; const int set = isx ? 0 : 1;
      const float* xr = isx ? p.out + (size_t)r * 1024 : (const float*)(ws + OFF_CTXMID) + (size_t)r * 1024;
      const bf16_t* yb = isx ? (const bf16_t*)(ws + OFF_YB) : (const bf16_t*)(ws + OFF_YBC); const int capp = isx ? 2048 : 256;
      f32x4 xv[4], g5v[4];
      const float* g5 = MODP(layer, set, 5);
#pragma unroll
      for (int j = 0; j < 4; ++j) { xv[j] = ((const f32x4*)xr)[lane + 64 * j]; g5v[j] = ((const f32x4*)g5)[lane + 64 * j]; }
      f32x4 a[4];
#pragma unroll
      for (int j = 0; j < 4; ++j) a[j] = (f32x4){0.f, 0.f, 0.f, 0.f};
      const int myslot = slot_nx;
      { const int rn = row + ngw; slot_nx = (rn < nrows && lane < 16) ? ((const int*)(ws + OFF_SLOT))[(size_t)rn * 16 + lane] : -1; }
      unsigned long long em = __ballot(myslot >= 0);
      while (em) {
        const int e0 = __builtin_ctzll(em); em &= em - 1;
        const int e1 = em ? __builtin_ctzll(em) : -1; if (em) em &= em - 1;
        const int s0_ = __builtin_amdgcn_readlane(myslot, e0);
        const u32x2* y0 = (const u32x2*)(yb + ((size_t)e0 * capp + s0_) * 1024);
        u32x2 w0[4], w1[4];
#pragma unroll
        for (int j = 0; j < 4; ++j) w0[j] = y0[lane + 64 * j];
        if (e1 >= 0) {
          const int s1_ = __builtin_amdgcn_readlane(myslot, e1);
          const u32x2* y1 = (const u32x2*)(yb + ((size_t)e1 * capp + s1_) * 1024);
#pragma unroll
          for (int j = 0; j < 4; ++j) w1[j] = y1[lane + 64 * j];
#pragma unroll
          for (int j = 0; j < 4; ++j) { a[j].x += bf2f(w1[j].x & 0xffffu); a[j].y += bf2f(w1[j].x >> 16); a[j].z += bf2f(w1[j].y & 0xffffu); a[j].w += bf2f(w1[j].y >> 16); }
        }
#pragma unroll
        for (int j = 0; j < 4; ++j) { a[j].x += bf2f(w0[j].x & 0xffffu); a[j].y += bf2f(w0[j].x >> 16); a[j].z += bf2f(w0[j].y & 0xffffu); a[j].w += bf2f(w0[j].y >> 16); }
      }
      f32x4 v[4];
#pragma unroll
      for (int j = 0; j < 4; ++j) v[j] = xv[j] + g5v[j] * a[j];
      if (isx) {
#pragma unroll
        for (int j = 0; j < 4; ++j) ((f32x4*)(xdst + (size_t)r * 1024))[lane + 64 * j] = v[j];
      }
      if (next_norm) {
        bf16_t* o = isx ? (bf16_t*)(ws + OFF_HX) + (size_t)r * 1024 : (bf16_t*)(ws + OFF_HC) + (size_t)r * 1024;
        norm_mod_regs(v, p.in[I_NMIX] + 1024, MODP(1, set, 0), MODP(1, set, 1), o, lane);
      }
    }
  };

  phase_router(0, NKEY);
  GRID_BAR();
  TS(8);
  phase_topk(32, 0);
  GRID_BAR();
  TS(9);
  for (int rep_ = 0; rep_ < REP_MOE; ++rep_) phase_gateup(1024 + 128);
  GRID_BAR();
  TS(10);
  for (int rep_ = 0; rep_ < REP_MOE; ++rep_) phase_down(512 + 64);
  GRID_BAR();
  TS(11);
  phase_combine(0, NKEY, (float*)(ws + OFF_X1), true);
  GRID_BAR();
  TS(12);
#if STOP_STAGE <= 10
  { const size_t gid = (size_t)bid * NT + tid; for (size_t i = gid; i < (size_t)SEQ * 256; i += (size_t)G * NT) ((f32x4*)p.out)[i] = ((const f32x4*)(ws + OFF_X1))[i]; }
  return;
#endif
  {
    PHASE_VARS;
    { bf16_t* Qb = (bf16_t*)(ws + OFF_Q); bf16_t* Kb = (bf16_t*)(ws + OFF_KALL); bf16_t* Vb = (bf16_t*)(ws + OFF_VT);
      const bf16_t* Wq = (const bf16_t*)(ws + OFF_WQKV);
      pg8_run(lds, 1024, G, bid,
        ([&](int tile, pg8::Unit& u) { if (tile >= 768) return false; const bool isx = true; const int tt = tile;
          const int pm = isx ? tt / 12 : 0, q = isx ? tt % 12 : 4 + tt;
          const bf16_t* hrow = isx ? (const bf16_t*)(ws + OFF_HX) + (size_t)pm * 256 * 1024 : (const bf16_t*)(ws + OFF_HC);
          u.pm = pm; u.pn = q & 3; u.kind = q >> 2; u.e = isx ? 256 + pm * 256 : 0;
          if (u.kind < 2) { u.A = (const char*)hrow; u.B = (const char*)(Wq + (size_t)q * 256 * 1024); } else { u.A = (const char*)(Wq + (size_t)q * 256 * 1024); u.B = (const char*)hrow; }
          return true; }),
        ([&](const f32x4 (&acc)[2][2][4][2], const pg8::Unit& u, int wr, int wc, int fr, int fq) {
          if (u.kind == 2) {
            bf16_t* base = Vb + (size_t)(u.pn * 256) * NKEY + u.e;
#pragma unroll
            for (int ai = 0; ai < 2; ++ai)
#pragma unroll
              for (int m = 0; m < 4; ++m) {
                int r0 = ai * 128 + wr * 64 + m * 16 + fr; EPI_FENCE(r0);
                bf16_t* rp = base + (size_t)r0 * NKEY + wc * 32 + fq * 4;
#pragma unroll
                for (int bj = 0; bj < 2; ++bj)
#pragma unroll
                  for (int n = 0; n < 2; ++n) { const f32x4 v = acc[ai][bj][m][n]; u32x2 w; w.x = pk2(v[0], v[1]); w.y = pk2(v[2], v[3]); *(u32x2*)(rp + bj * 128 + n * 16) = w; }
              }
          } else {
            const bool isq = u.kind == 0; const bool dorope = isq || u.e != 0;
            const float* gn = isq ? p.in[I_DQN] : p.in[I_DKN];
            const f32x2* rope = (const f32x2*)(ws + OFF_ROPE);
            const float qs = isq ? 0.125f * 1.4426950408889634f : 1.f;
            bf16_t* base = isq ? Qb + (size_t)(u.pm * 256) * 1024 : Kb + (size_t)u.e * 1024;
            f32x4 gnv[2][2];
#pragma unroll
            for (int bj = 0; bj < 2; ++bj)
#pragma unroll
              for (int n = 0; n < 2; ++n) gnv[bj][n] = *(const f32x4*)(gn + 32 * bj + 16 * n + 4 * fq);
#pragma unroll
            for (int ai = 0; ai < 2; ++ai) {
              int prow = u.pm * 4 + ai * 2 + wr; EPI_FENCE(prow);
              const f32x4 rc0 = *(const f32x4*)(rope + prow * 16 + 4 * fq), rc1 = *(const f32x4*)(rope + prow * 16 + 4 * fq + 2);
#pragma unroll
              for (int m = 0; m < 4; ++m) {
                int r0 = ai * 128 + wr * 64 + m * 16 + fr; EPI_FENCE(r0);
                f32x4 v[2][2]; float ss = 0.f;
#pragma unroll
                for (int bj = 0; bj < 2; ++bj)
#pragma unroll
                  for (int n = 0; n < 2; ++n) { v[bj][n] = acc[ai][bj][m][n]; ss += v[bj][n].x * v[bj][n].x + v[bj][n].y * v[bj][n].y + v[bj][n].z * v[bj][n].z + v[bj][n].w * v[bj][n].w; }
                ss += __shfl_xor(ss, 16); ss += __shfl_xor(ss, 32);
                const float rstd = qs / sqrtf(ss * (1.f / 64.f) + 1e-6f);
#pragma unroll
                for (int bj = 0; bj < 2; ++bj)
#pragma unroll
                  for (int n = 0; n < 2; ++n) v[bj][n] = v[bj][n] * gnv[bj][n] * rstd;
                if (dorope) {
                  const int t = u.pm * 256 + r0;
#pragma unroll
                  for (int bj = 0; bj < 2; ++bj) {
                    const int pos = t & 63;
                    const f32x4 cs0 = bj == 0 ? rc0 : *(const f32x4*)(rope + pos * 16 + 4 * fq), cs1 = bj == 0 ? rc1 : *(const f32x4*)(rope + pos * 16 + 4 * fq + 2);
                    const f32x4 a1 = v[bj][0], a2 = v[bj][1];
                    v[bj][0] = (f32x4){a1.x * cs0.x - a2.x * cs0.y, a1.y * cs0.z - a2.y * cs0.w, a1.z * cs1.x - a2.z * cs1.y, a1.w * cs1.z - a2.w * cs1.w};
                    v[bj][1] = (f32x4){a2.x * cs0.x + a1.x * cs0.y, a2.y * cs0.z + a1.y * cs0.w, a2.z * cs1.x + a1.z * cs1.y, a2.w * cs1.z + a1.w * cs1.w};
                  }
                }
                bf16_t* rp = base + (size_t)r0 * 1024 + (4 * u.pn + wc) * 64 + fq * 4;
#pragma unroll
                for (int bj = 0; bj < 2; ++bj)
#pragma unroll
                  for (int n = 0; n < 2; ++n) { u32x2 w; w.x = pk2(v[bj][n].x, v[bj][n].y); w.y = pk2(v[bj][n].z, v[bj][n].w); *(u32x2*)(rp + bj * 32 + n * 16) = w; }
              }
            }
          }
        }));
    }
    {
      PHASE_VARS;
      int bb0 = bid; asm volatile("" : "+s"(bb0) :: "memory");
      if (wid == 0) {
        const int head = bb0 >> 4, rg = bb0 & 15;
        const bf16_t* Ac = (const bf16_t*)(ws + OFF_HC); const bf16_t* Wq = (const bf16_t*)(ws + OFF_WQKV); bf16_t* Kb = (bf16_t*)(ws + OFF_KALL);
        const int f0 = 1024 + 64 * head;
        const float* gn = p.in[I_DKN];
        f32x4 kv[4];
        skinny_mma<1, 4, 4>(Ac, Wq, 1024, [&](int, int i) { return (16 * rg + i) * 1024; },
          [&](int nf, int i) { const int f = f0 + 16 * nf + i; return ((f & ~255) + 128 * ((f >> 5) & 1) + 32 * ((f & 255) >> 6) + (f & 31)) * 1024; },
          [&](int, int nf, f32x4 acc) { kv[nf] = acc; });
        float ss = 0.f;
#pragma unroll
        for (int nf = 0; nf < 4; ++nf) ss += kv[nf].x * kv[nf].x + kv[nf].y * kv[nf].y + kv[nf].z * kv[nf].z + kv[nf].w * kv[nf].w;
        ss += __shfl_xor(ss, 16); ss += __shfl_xor(ss, 32);
        const float rstd = 1.0f / sqrtf(ss * (1.f / 64.f) + 1e-6f);
        bf16_t* rp = Kb + (size_t)(16 * rg + (lane & 15)) * 1024 + 64 * head + 4 * (lane >> 4);
#pragma unroll
        for (int nf = 0; nf < 4; ++nf) { const f32x4 y = kv[nf] * *(const f32x4*)(gn + 16 * nf + 4 * (lane >> 4)) * rstd; u32x2 w; w.x = pk2(y[0], y[1]); w.y = pk2(y[2], y[3]); *(u32x2*)(rp + 16 * nf) = w; }
      } else if (wid == 1) {
        const int fg = bb0 & 63, tq = bb0 >> 6;
        const bf16_t* Wv = (const bf16_t*)(ws + OFF_WQKV) + (size_t)(2048 + 16 * fg) * 1024; const bf16_t* Bc = (const bf16_t*)(ws + OFF_HC); bf16_t* Vb = (bf16_t*)(ws + OFF_VT);
        skinny_mma<1, 4, 4>(Wv, Bc, 1024, [&](int, int i) { return i * 1024; }, [&](int nf, int i) { return (64 * tq + 16 * nf + i) * 1024; },
          [&](int, int nf, f32x4 acc) { const int e = 16 * fg + (lane & 15), tok = 64 * tq + 16 * nf + 4 * (lane >> 4);
            u32x2 w; w.x = pk2(acc[0], acc[1]); w.y = pk2(acc[2], acc[3]); *(u32x2*)(Vb + (size_t)e * NKEY + tok) = w; });
      }
    }
  }
  GRID_BAR();
  TS(13);
  TS(14);
  {
    PHASE_VARS;
    constexpr int KB_B = 64 * 128, VB_B = 128 * 128, BUF_B = KB_B + VB_B;
    const int r32 = lane & 31, hi = lane >> 5;
    const bf16_t* Qg = (const bf16_t*)(ws + OFF_Q); const bf16_t* Kg = (const bf16_t*)(ws + OFF_KALL); const bf16_t* Vg = (const bf16_t*)(ws + OFF_VT);
    float* Og = (float*)(ws + OFF_O);
    const int wv = __builtin_amdgcn_readfirstlane(wid);
    const int drow = 8 * wv + (lane >> 3), dch = (lane & 7) ^ ((drow >> 1) & 7);
    const int pr = (r32 & 0x13) | ((r32 & 4) << 1) | ((r32 & 8) >> 1);
    const int ksw = (pr >> 1) & 7, vsw = (r32 >> 1) & 7;
    int kro[4], vro[4];
#pragma unroll
    for (int s = 0; s < 4; ++s) { kro[s] = pr * 128 + (((2 * s + hi) ^ ksw) << 4); vro[s] = KB_B + r32 * 128 + (((2 * s + hi) ^ vsw) << 4); }
    constexpr int NKT = NKEY / 64;
    const float lam_init = 0.35550906759096926f;
    const float lam = expf(wave_sum(p.in[I_LQ1][lane] * p.in[I_LK1][lane])) - expf(wave_sum(p.in[I_LQ2][lane] * p.in[I_LK2][lane])) + lam_init;
    for (int su2 = 2 * bid; su2 < 1024; su2 += (su2 & 1) ? 2 * G - 1 : 1) {
      const int su = su2 >> 1, pass = su2 & 1;
      const int h = su & 7, qb = su >> 3, c = 2 * h + pass;
      const int vh = h;
      const bf16_t* Qp = Qg + (size_t)(qb * 256 + wid * 32 + r32) * 1024 + c * 64 + hi * 8;
      bf16x8 qf[4];
#pragma unroll
      for (int s = 0; s < 4; ++s) qf[s] = *(const bf16x8*)(Qp + 16 * s);
      f32x16 o[4];
#pragma unroll
      for (int eb = 0; eb < 4; ++eb)
#pragma unroll
        for (int r = 0; r < 16; ++r) o[eb][r] = 0.f;
      float lrun = 0.f;
      const bf16_t* kg = Kg + (size_t)drow * 1024 + c * 64 + dch * 8;
      const bf16_t* vg0 = Vg + (size_t)(vh * 128 + drow) * NKEY + dch * 8;
      const bf16_t* vg1 = vg0 + (size_t)64 * NKEY;
#define ATT_DMA(t_) do { ldsp bb_ = lds + ((t_) & 3) * BUF_B + wv * 1024; \
        __builtin_amdgcn_global_load_lds((const unsigned*)(kg + (size_t)(t_) * 64 * 1024), (LAS unsigned*)bb_, 16, 0, 0); \
        __builtin_amdgcn_global_load_lds((const unsigned*)(vg0 + (t_) * 64), (LAS unsigned*)(bb_ + KB_B), 16, 0, 0); \
        __builtin_amdgcn_global_load_lds((const unsigned*)(vg1 + (t_) * 64), (LAS unsigned*)(bb_ + KB_B + 8192), 16, 0, 0); } while (0)
#define ATT_DMA2(ts_, td_) do { ldsp bb_ = lds + ((td_) & 3) * BUF_B + wv * 1024; \
        __builtin_amdgcn_global_load_lds((const unsigned*)(kg + (size_t)(ts_) * 64 * 1024), (LAS unsigned*)bb_, 16, 0, 0); \
        __builtin_amdgcn_global_load_lds((const unsigned*)(vg0 + (ts_) * 64), (LAS unsigned*)(bb_ + KB_B), 16, 0, 0); \
        __builtin_amdgcn_global_load_lds((const unsigned*)(vg1 + (ts_) * 64), (LAS unsigned*)(bb_ + KB_B + 8192), 16, 0, 0); } while (0)
#define SB_() __builtin_amdgcn_sched_barrier(0)
#define RD_V(dst, t_, q_) do { ldsp vb_ = lds + ((t_) & 3) * BUF_B + vro[q_]; _Pragma("unroll") for (int eb = 0; eb < 4; ++eb) dst[eb] = *(const LAS bf16x8*)(vb_ + eb * 32 * 128); } while (0)
#define RD_K(dst, t_, half_) do { ldsp kb_ = lds + ((t_) & 3) * BUF_B + (half_) * 32 * 128; _Pragma("unroll") for (int s = 0; s < 4; ++s) dst[s] = *(const LAS bf16x8*)(kb_ + kro[s]); } while (0)
#define MM_V(vf_, pf_) do { _Pragma("unroll") for (int eb = 0; eb < 4; ++eb) o[eb] = __builtin_amdgcn_mfma_f32_32x32x16_bf16(vf_[eb], pf_, o[eb], 0, 0, 0); } while (0)
#define MM_K(P, kf_) do { _Pragma("unroll") for (int r = 0; r < 16; ++r) P[r] = 0.f; _Pragma("unroll") for (int s = 0; s < 4; ++s) P = __builtin_amdgcn_mfma_f32_32x32x16_bf16(kf_[s], qf[s], P, 0, 0, 0); } while (0)
#define EXPP(pf_, P, b) do { _Pragma("unroll") for (int r = (b); r < (b) + 8; ++r) { P[r] = __builtin_amdgcn_exp2f(P[r]); ls_ += P[r]; } \
        u32x4 a_; a_.x = pk2(P[b], P[b + 1]); a_.y = pk2(P[b + 2], P[b + 3]); a_.z = pk2(P[b + 4], P[b + 5]); a_.w = pk2(P[b + 6], P[b + 7]); pf_ = __builtin_bit_cast(bf16x8, a_); } while (0)
#define ATT_ITER(t_) do { \
        { const int tl_ = (t_) + 3 < NKT ? (t_) + 3 : NKT - 1; ATT_DMA2(tl_, (t_) + 3); }     \
        bf16x8 pf0, pf1, vB[4], kf[4]; float ls_ = 0.f; \
        SB_(); \
        EXPP(pf0, s0, 0); RD_V(vB, t_, 1); SB_(); \
        MM_V(vA, pf0); EXPP(pf1, s0, 8); RD_K(kf, (t_) + 1, 0); SB_(); \
        MM_V(vB, pf1); EXPP(pf0, s1, 0); RD_V(vA, t_, 2); SB_(); \
        MM_K(s0, kf); EXPP(pf1, s1, 8); RD_V(vB, t_, 3); SB_(); \
        MM_V(vA, pf0); RD_K(kf, (t_) + 1, 1); SB_(); \
        MM_V(vB, pf1); RD_V(vA, (t_) + 1, 0); SB_(); \
        MM_K(s1, kf); \
        lrun += ls_; \
        asm volatile("s_waitcnt vmcnt(3) lgkmcnt(0)\n\ts_barrier" ::: "memory"); } while (0)
      ATT_DMA(0); ATT_DMA(1); ATT_DMA(2);
      asm volatile("" :: "v"(qf[0]), "v"(qf[1]), "v"(qf[2]), "v"(qf[3]));
      asm volatile("s_waitcnt vmcnt(3) lgkmcnt(0)\n\ts_barrier" ::: "memory");
      f32x16 s0, s1; bf16x8 vA[4];
      { bf16x8 kf0[4]; RD_K(kf0, 0, 0); MM_K(s0, kf0); RD_K(kf0, 0, 1); MM_K(s1, kf0); RD_V(vA, 0, 0); }
      asm volatile(".p2align 6" ATT_PAD);
#pragma unroll 1
      for (int kt = 0; kt < NKT; ++kt) ATT_ITER(kt);
#undef ATT_ITER
#undef SB_
#undef RD_V
#undef RD_K
#undef MM_V
#undef MM_K
#undef EXPP
#undef ATT_DMA
#undef ATT_DMA2
      asm volatile("s_waitcnt vmcnt(0)\n\ts_barrier" ::: "memory");
      const float inv = 1.f / (lrun + __shfl_xor(lrun, 32));
      float* orow = Og + (size_t)(qb * 256 + wid * 32 + r32) * 2048 + (2 * h) * 128 + 4 * hi;
      if (pass == 0) {
#pragma unroll
        for (int eb = 0; eb < 4; ++eb)
#pragma unroll
          for (int g4 = 0; g4 < 4; ++g4) *(f32x4*)(orow + eb * 32 + 8 * g4) = (f32x4){o[eb][4 * g4] * inv, o[eb][4 * g4 + 1] * inv, o[eb][4 * g4 + 2] * inv, o[eb][4 * g4 + 3] * inv};
      } else {
        const float li = lam * inv; float ss = 0.f;
#pragma unroll
        for (int eb = 0; eb < 4; ++eb)
#pragma unroll
          for (int g4 = 0; g4 < 4; ++g4) { int eo = eb * 32 + 8 * g4; EPI_FENCE(eo); const f32x4 o1 = *(const f32x4*)(orow + eo);
#pragma unroll
            for (int j = 0; j < 4; ++j) { const float v = o1[j] - li * o[eb][4 * g4 + j]; o[eb][4 * g4 + j] = v; ss += v * v; } }
        ss += __shfl_xor(ss, 32);
        const float rs = (1.f - lam_init) / sqrtf(ss * (1.f / 128.f) + 1e-5f);
        bf16_t* obf = (bf16_t*)(ws + OFF_HX) + (size_t)(qb * 256 + wid * 32 + r32) * 1024 + h * 128 + 4 * hi;
        const float* sub = p.in[I_SUBLN] + 4 * hi;
#pragma unroll
        for (int eb = 0; eb < 4; ++eb) {
          int e0 = eb * 32; EPI_FENCE(e0); f32x4 gsub[4];
#pragma unroll
          for (int g4 = 0; g4 < 4; ++g4) gsub[g4] = *(const f32x4*)(sub + e0 + 8 * g4);
#pragma unroll
          for (int g4 = 0; g4 < 4; ++g4) {
            u32x2 w; w.x = pk2(o[eb][4 * g4] * rs * gsub[g4].x, o[eb][4 * g4 + 1] * rs * gsub[g4].y); w.y = pk2(o[eb][4 * g4 + 2] * rs * gsub[g4].z, o[eb][4 * g4 + 3] * rs * gsub[g4].w);
            *(u32x2*)(obf + e0 + 8 * g4) = w; } }
      }
    }
  }
  GRID_BAR();
  TS(15);
  TS(16);
  {
    PHASE_VARS;
    pg8_run(lds, 1024, G, bid,
      ([&](int tile, pg8::Unit& u) { if (tile >= 256) return false; u.pm = tile >> 2; u.pn = tile & 3; u.kind = 0; u.e = 0;
        u.A = (const char*)((const bf16_t*)(ws + OFF_HX) + (size_t)u.pm * 256 * 1024); u.B = (const char*)((const bf16_t*)(ws + OFF_WDO) + (size_t)u.pn * 256 * 1024); return true; }),
      ([&](const f32x4 (&acc)[2][2][4][2], const pg8::Unit& u, int wr, int wc, int fr, int fq) {
        const float* xin = (const float*)(ws + OFF_X1); float* xo = p.out; const float* gate = MODP(1, 0, 2);
        const int col0 = u.pn * 256 + wc * 32 + fq * 4;
        f32x4 gt[2][2];
#pragma unroll
        for (int bj = 0; bj < 2; ++bj)
#pragma unroll
          for (int n = 0; n < 2; ++n) gt[bj][n] = *(const f32x4*)(gate + col0 + bj * 128 + n * 16);
#pragma unroll
        for (int hp = 0; hp < 4; ++hp) {
          const int ai = hp >> 1, m0 = (hp & 1) * 2;
          f32x4 xr[2][2][2];
          int rb = u.pm * 256 + ai * 128 + wr * 64 + m0 * 16 + fr; EPI_FENCE(rb);
#pragma unroll
          for (int mm = 0; mm < 2; ++mm)
#pragma unroll
            for (int bj = 0; bj < 2; ++bj)
#pragma unroll
              for (int n = 0; n < 2; ++n) xr[mm][bj][n] = *(const f32x4*)(xin + (size_t)(rb + mm * 16) * 1024 + col0 + bj * 128 + n * 16);
#pragma unroll
          for (int mm = 0; mm < 2; ++mm) {
            const size_t base = (size_t)(rb + mm * 16) * 1024 + col0;
#pragma unroll
            for (int bj = 0; bj < 2; ++bj)
#pragma unroll
              for (int n = 0; n < 2; ++n) *(f32x4*)(xo + base + bj * 128 + n * 16) = xr[mm][bj][n] + gt[bj][n] * acc[ai][bj][m0 + mm][n];
          }
        }
      }));
  }
  GRID_BAR();
  TS(17);
#if STOP_STAGE <= 15
  return;
#endif
  phase_router(1, SEQ);
  GRID_BAR();
  TS(18);
  phase_topk(16, 1);
  GRID_BAR();
  TS(19);
  phase_gateup(1024);
  GRID_BAR();
  TS(20);
  phase_down(512);
  GRID_BAR();
  TS(21);
  phase_combine(1, SEQ, p.out, false);
#ifdef LEAK_XCC
  { unsigned* cnt = (unsigned*)(ws + 120 * 1024);
    if (blockIdx.x == 0 && threadIdx.x == 0) { cnt[0] = 0u; cnt[1] = 0u; }
    grid.sync();
    if (threadIdx.x == 0) { const unsigned xc = xb_xcc_id(); if (xc == (blockIdx.x & 7u)) atomicAdd(&cnt[0], 1u); if (xc == (blockIdx.x >> 5)) atomicAdd(&cnt[1], 1u); }
    grid.sync();
    const float dA = (float)cnt[0], dB = (float)cnt[1];
    const float e = sqrtf(dB * 1e-6f);
    const size_t gid = (size_t)blockIdx.x * NT + threadIdx.x;
    for (size_t i = gid; i < (size_t)SEQ * 1024; i += (size_t)G * NT) p.out[i] = p.out[i] * (1.f + e) + (i == 0 ? dA * 0.1f : 0.f); }
#endif
#ifdef LEAK_A0
  grid.sync();
  { if (blockIdx.x == 0 && threadIdx.x == 0) tsbuf[40] = __builtin_amdgcn_s_memrealtime();
    const float dA = (float)(long long)(tsbuf[LEAK_A1] - tsbuf[LEAK_A0]) * 0.01f, dB = (float)(long long)(tsbuf[LEAK_B1] - tsbuf[LEAK_B0]) * 0.01f;
    const float e = sqrtf(dB * 1e-6f);
    const size_t gid = (size_t)blockIdx.x * NT + threadIdx.x;
    for (size_t i = gid; i < (size_t)SEQ * 1024; i += (size_t)G * NT) p.out[i] = p.out[i] * (1.f + e) + (i == 0 ? dA * 0.1f : 0.f); }
#endif
}

extern "C" void kernel_launch(void* const* d_in, const int* in_sizes, int n_in, void* d_out, int out_size,
                              void* d_ws, size_t ws_size, hipStream_t stream) {
  static int grid_blocks = 0;
  if (!grid_blocks) {
    int dev = 0, cus = 0, per_cu = 0;
    (void)hipGetDevice(&dev);
    (void)hipDeviceGetAttribute(&cus, hipDeviceAttributeMultiprocessorCount, dev);
    (void)hipFuncSetAttribute((const void*)mega, hipFuncAttributeMaxDynamicSharedMemorySize, LDS_BYTES);
    (void)hipOccupancyMaxActiveBlocksPerMultiprocessor(&per_cu, mega, NT, LDS_BYTES);
    if (per_cu < 1) { fprintf(stderr, "occupancy query says %d\n", per_cu); per_cu = 1; }
    grid_blocks = cus * (per_cu > 1 ? 1 : per_cu);
    if (ws_size < WS_END) fprintf(stderr, "kernel_launch: workspace too small: %zu < %zu\n", ws_size, (size_t)WS_END);
  }
  if (ws_size < WS_END || n_in != 36) return;
  Params p{};
  for (int i = 0; i < 36; ++i) p.in[i] = (const float*)d_in[i];
  p.out = (float*)d_out; p.ws = (unsigned char*)d_ws;
  (void)hipMemsetAsync((unsigned char*)d_ws + OFF_BAR, 0, 16 * 1024, stream);
  void* args[] = {&p};
  hipError_t e = hipLaunchCooperativeKernel((void*)mega, dim3(grid_blocks), dim3(NT), args, LDS_BYTES, stream);
  if (e != hipSuccess) fprintf(stderr, "cooperative launch failed: %s (grid %d)\n", hipGetErrorString(e), grid_blocks);
}
```
